# Optimizing an MI355X kernel written in HIP

```python
import jax, jax.numpy as jnp
from jax import lax
import numpy as np

D_MODEL = 1024
BATCH = 8
SEQ = 2048
DEPTH = 1
DEC_BATCH = 128
DEC_SEQ = 4
PAST_LEN = 16384
PAGE_SIZE = 128

D_MIX = D_MODEL
D_POOL = D_MIX // 2
D_CONV = D_MIX - D_POOL
POOL_WINDOWS = (2, 4, 8, 16)
N_POOL_GROUPS = len(POOL_WINDOWS)
POOL_GC = D_POOL // N_POOL_GROUPS
POOL_BUF = max(POOL_WINDOWS) - 1
N_CONV_HEADS = 8
CONV_HEAD_DIM = D_CONV // N_CONV_HEADS
CONV_W = 3
D_FF = 2816
D_IN_PROJ = D_POOL + 3 * D_CONV
RMS_EPS = 1e-6

kernel_name = 'hybrid_pool_shortconv_convffn_step'


def rmsnorm(x, g):
    xf = x.astype(jnp.float32)
    r = xf * lax.rsqrt(jnp.mean(xf * xf, axis=-1, keepdims=True) + RMS_EPS)
    return (r * g.astype(jnp.float32)).astype(x.dtype)


def causal_dwconv(p, w):
    T = p.shape[1] - (CONV_W - 1)
    out = p[:, 0:T] * w[0]
    for k in range(1, CONV_W):
        out = out + p[:, k:k + T] * w[k]
    return out


def pool_mixer(p, pos0, pool_w, pool_scale):
    T = p.shape[1] - POOL_BUF
    pf = p.astype(jnp.float32)
    cs = jnp.concatenate([jnp.zeros_like(pf[:, :1]), jnp.cumsum(pf, axis=1)], axis=1)
    cur = pf[:, POOL_BUF:]
    t = jnp.arange(T, dtype=jnp.int32)
    outs = []
    for g, w in enumerate(POOL_WINDOWS):
        sl = slice(g * POOL_GC, (g + 1) * POOL_GC)
        s = cs[:, POOL_BUF + 1:POOL_BUF + 1 + T, sl] - cs[:, POOL_BUF + 1 - w:POOL_BUF + 1 - w + T, sl]
        cnt = jnp.minimum(w, pos0 + t + 1).astype(jnp.float32)[None, :, None]
        outs.append(s / cnt - cur[..., sl])
    d = jnp.stack(outs, axis=2).astype(p.dtype)
    y = jnp.einsum('btgc,gcd->btgd', d, pool_w)
    return y.reshape(y.shape[0], T, D_POOL) * pool_scale


def trunk_layer(x, c, pool_buf, conv_buf, ffn_buf, pos0, w_ada, b_ada, g_pre_mix, g_post_mix,
                g_pre_ffn, g_post_ffn, w_in, pool_w, pool_scale, conv_w, w_out,
                ffn_w_up, ffn_conv_w, ffn_w_down):
    mod = (jax.nn.silu(c) @ w_ada + b_ada)[:, None, :]
    sh1, sc1, gt1, sh2, sc2, gt2 = jnp.split(mod, 6, axis=-1)
    h = rmsnorm(x, g_pre_mix) * (1 + sc1) + sh1
    proj = h @ w_in
    v_pool, x_conv, gate_b, gate_c = jnp.split(
        proj, [D_POOL, D_POOL + D_CONV, D_POOL + 2 * D_CONV], axis=-1)
    pool_in = jnp.concatenate([pool_buf, v_pool], axis=1)
    y_pool = pool_mixer(pool_in, pos0, pool_w, pool_scale)
    conv_in = jnp.concatenate([conv_buf, gate_c * x_conv], axis=1)
    y_conv = gate_b * causal_dwconv(conv_in, conv_w)
    mix = jnp.concatenate([y_pool, y_conv], axis=-1) @ w_out
    x = x + gt1 * rmsnorm(mix, g_post_mix)
    h2 = rmsnorm(x, g_pre_ffn) * (1 + sc2) + sh2
    up = h2 @ ffn_w_up
    ffn_in = jnp.concatenate([ffn_buf, up], axis=1)
    a, b = jnp.split(causal_dwconv(ffn_in, ffn_conv_w), 2, axis=-1)
    f = (jax.nn.silu(a) * b) @ ffn_w_down
    x = x + gt2 * rmsnorm(f, g_post_ffn)
    return x, pool_in[:, -POOL_BUF:], conv_in[:, -(CONV_W - 1):], ffn_in[:, -(CONV_W - 1):]


def setup_inputs(seed: int = 0) -> dict:
    key = jax.random.key(seed)
    ks = jax.random.split(key, 24)
    f32 = jnp.float32
    nrm = lambda k, s, sc: jax.random.normal(k, s, f32) * sc
    return {
        'x_prompt': nrm(ks[0], (BATCH, SEQ, D_MODEL), 1.0),
        'x_sample': nrm(ks[1], (DEC_BATCH, DEC_SEQ, D_MODEL), 1.0),
        'state_pool': nrm(ks[2], (DEPTH, DEC_BATCH, POOL_BUF, D_POOL), 1.0),
        'state_conv': nrm(ks[3], (DEPTH, DEC_BATCH, CONV_W - 1, D_CONV), 1.0),
        'state_ffn': nrm(ks[4], (DEPTH, DEC_BATCH, CONV_W - 1, 2 * D_FF), 1.0),
        'c_prompt': nrm(ks[5], (BATCH, D_MODEL), 1.0),
        'c_sample': nrm(ks[6], (DEC_BATCH, D_MODEL), 1.0),
        'w_ada': nrm(ks[7], (DEPTH, D_MODEL, 6 * D_MODEL), 0.02),
        'b_ada': nrm(ks[8], (DEPTH, 6 * D_MODEL), 0.02),
        'g_pre_mix': 1.0 + nrm(ks[9], (DEPTH, D_MODEL), 0.05),
        'g_post_mix': 1.0 + nrm(ks[10], (DEPTH, D_MODEL), 0.05),
        'g_pre_ffn': 1.0 + nrm(ks[11], (DEPTH, D_MODEL), 0.05),
        'g_post_ffn': 1.0 + nrm(ks[12], (DEPTH, D_MODEL), 0.05),
        'w_in': nrm(ks[13], (DEPTH, D_MODEL, D_IN_PROJ), D_MODEL ** -0.5),
        'pool_w': nrm(ks[14], (DEPTH, N_POOL_GROUPS, POOL_GC, POOL_GC), POOL_GC ** -0.5),
        'pool_scale': 1.0 + nrm(ks[15], (DEPTH, D_POOL), 0.1),
        'conv_w': nrm(ks[16], (DEPTH, CONV_W, D_CONV), CONV_W ** -0.5),
        'w_out': nrm(ks[17], (DEPTH, D_MIX, D_MODEL), D_MIX ** -0.5),
        'ffn_w_up': nrm(ks[18], (DEPTH, D_MODEL, 2 * D_FF), D_MODEL ** -0.5),
        'ffn_conv_w': nrm(ks[19], (DEPTH, CONV_W, 2 * D_FF), CONV_W ** -0.5),
        'ffn_w_down': nrm(ks[20], (DEPTH, D_FF, D_MODEL), D_FF ** -0.5),
    }


def reference(x_prompt, x_sample, state_pool, state_conv, state_ffn, c_prompt, c_sample,
              w_ada, b_ada, g_pre_mix, g_post_mix, g_pre_ffn, g_post_ffn, w_in, pool_w,
              pool_scale, conv_w, w_out, ffn_w_up, ffn_conv_w, ffn_w_down):
    xp, xs = x_prompt, x_sample
    npp, ncp, nfp, nps, ncs, nfs = [], [], [], [], [], []
    for l in range(DEPTH):
        wl = (w_ada[l], b_ada[l], g_pre_mix[l], g_post_mix[l], g_pre_ffn[l], g_post_ffn[l],
              w_in[l], pool_w[l], pool_scale[l], conv_w[l], w_out[l],
              ffn_w_up[l], ffn_conv_w[l], ffn_w_down[l])
        zp = jnp.zeros((xp.shape[0], POOL_BUF, D_POOL), xp.dtype)
        zc = jnp.zeros((xp.shape[0], CONV_W - 1, D_CONV), xp.dtype)
        zf = jnp.zeros((xp.shape[0], CONV_W - 1, 2 * D_FF), xp.dtype)
        xp, sp, sc, sf = trunk_layer(xp, c_prompt, zp, zc, zf, 0, *wl)
        npp.append(sp); ncp.append(sc); nfp.append(sf)
        xs, sp2, sc2, sf2 = trunk_layer(xs, c_sample, state_pool[l], state_conv[l], state_ffn[l],
                                        PAST_LEN, *wl)
        nps.append(sp2); ncs.append(sc2); nfs.append(sf2)
    return (xp, xs, jnp.stack(npp), jnp.stack(ncp), jnp.stack(nfp),
            jnp.stack(nps), jnp.stack(ncs), jnp.stack(nfs))
```

```cpp
#include <hip/hip_runtime.h>
#include <hip/hip_cooperative_groups.h>
#include <cstdio>
#include <cstdint>
namespace cg = cooperative_groups;
namespace pg8 {
#define PG8_LAS __attribute__((address_space(3)))
typedef unsigned short bf16_t;
typedef short bf16x8 __attribute__((ext_vector_type(8)));
typedef float f32x4 __attribute__((ext_vector_type(4)));
typedef unsigned u32x4 __attribute__((ext_vector_type(4)));
constexpr int BM = 256, BK = 64, HALF = 128, HTB = HALF * BK * 2  , STAGE_BYTES = 8 * HTB, NXCD = 8, WGM = 8;

__host__ __device__ __forceinline__ int lds_byte(int r, int c) { const int st = (r >> 4) * 2 + (c >> 5), rr = r & 15, cc = c & 31, ob = rr * 64 + cc * 2; return st * 1024 + (ob ^ (((ob >> 9) & 1) << 5)); }
__host__ __device__ __forceinline__ void stage_rc(int b, int& R, int& C) { const int st = b / 1024, sb = b % 1024, swz = sb ^ (((sb >> 9) & 1) << 5); R = (st >> 1) * 16 + swz / 64; C = (st & 1) * 32 + (swz % 64) / 2; }
__host__ __device__ __forceinline__ int perm32(int rho) { const int n = rho >> 4, i = rho & 15; return 8 * (i >> 2) + 4 * n + (i & 3); }

struct Unit { int pm, pn; };
struct Gemm { const bf16_t* A; const bf16_t* Bt; int M, N, K; };

struct StaticOrder {
    int nM, nN, nwg, G, c;
    __host__ __device__ void init(int M, int N, int G_, int c_) { nM = M / BM; nN = N / BM; nwg = nM * nN; G = G_; c = c_; }
    __host__ __device__ bool next(int i, Unit& u) const {
        const long L = (long)i * G + c; if (L >= nwg) return false;
        int wgid = (int)L; { const int q = nwg / NXCD, r = nwg % NXCD, xcd = wgid % NXCD, off = wgid / NXCD; wgid = (xcd < r ? xcd * (q + 1) : r * (q + 1) + (xcd - r) * q) + off; }
        const int nig = WGM * nN, gid = wgid / nig, fm = gid * WGM, gsz = (nM - fm) < WGM ? (nM - fm) : WGM;
        u.pm = fm + ((wgid % nig) % gsz); u.pn = (wgid % nig) / gsz; return true;
    }
    __device__ __forceinline__ void a_ready(const Unit&) const {}
    __device__ __forceinline__ void done(const Unit&) const {}
};

__device__ __forceinline__ unsigned cvt_pk_bf16(float lo, float hi) { unsigned r; asm volatile("v_cvt_pk_bf16_f32 %0, %1, %2" : "=v"(r) : "v"(lo), "v"(hi)); return r; }
typedef float f32x2 __attribute__((ext_vector_type(2)));
__device__ __forceinline__ f32x2 gelu_pk(f32x2 v) {
    const f32x2 av = __builtin_elementwise_abs(v), d = av * 0.2316418882f + 1.0f;
    f32x2 t; t.x = __builtin_amdgcn_rcpf(d.x); t.y = __builtin_amdgcn_rcpf(d.y);
    f32x2 q = t * 0.5307027145f + (-0.7265760135f); q = q * t + 0.7107068705f; q = q * t + (-0.142248368f); q = q * t + 0.127414796f; q = q * t;
    const f32x2 s = (v * v) * (-0.72134752044f);
    f32x2 e; e.x = __builtin_amdgcn_exp2f(s.x); e.y = __builtin_amdgcn_exp2f(s.y);
    const f32x2 m = v * (q * e), r = v - m;
    f32x2 o; o.x = v.x < 0.f ? m.x : r.x; o.y = v.y < 0.f ? m.y : r.y; return o;
}

template <int ACT  > struct EpiBf16 {
    static constexpr bool PERM = true, AFTER_DRAIN = false; static_assert(ACT == 0 || ACT == 1, "EpiBf16: ACT is 0 (none) or 1 (gelu_pk)");
    bf16_t* O; int ldc; const float* bias; int split_cols; size_t split_stride; float scale0;
    __device__ __forceinline__ void operator()(const f32x4 (&acc)[2][2][4][2], const Unit& u, int wr, int wc, int fr, int fq) const {
        const int row0 = u.pm * BM + wr * 64 + fr; int colt = u.pn * BM; bf16_t* base = O;
        float sc = 1.f; if (split_cols) { const int t = colt / split_cols; base += (size_t)t * split_stride; colt -= t * split_cols; if (t == 0) sc = scale0; }
        const int col0 = colt + wc * 32 + 8 * fq, bcol0 = u.pn * BM + wc * 32 + 8 * fq;
        f32x4 bv[2][2];
#pragma unroll
        for (int bj = 0; bj < 2; ++bj)
#pragma unroll
            for (int n = 0; n < 2; ++n) bv[bj][n] = bias ? *(const f32x4*)(bias + bcol0 + bj * HALF + 4 * n) : (f32x4){0.f, 0.f, 0.f, 0.f};
#pragma unroll
        for (int ai = 0; ai < 2; ++ai)
#pragma unroll
            for (int m = 0; m < 4; ++m) { bf16_t* rowp = base + (size_t)(row0 + ai * HALF + m * 16) * ldc + col0;
#pragma unroll
                for (int bj = 0; bj < 2; ++bj) { f32x4 v0 = acc[ai][bj][m][0] + bv[bj][0], v1 = acc[ai][bj][m][1] + bv[bj][1];
                    if (ACT == 1) { f32x2 a = gelu_pk((f32x2){v0[0], v0[1]}), b = gelu_pk((f32x2){v0[2], v0[3]}), c = gelu_pk((f32x2){v1[0], v1[1]}), d = gelu_pk((f32x2){v1[2], v1[3]});
                        v0 = (f32x4){a.x, a.y, b.x, b.y}; v1 = (f32x4){c.x, c.y, d.x, d.y}; }
                    v0 = v0 * sc; v1 = v1 * sc; u32x4 w; w.x = cvt_pk_bf16(v0[0], v0[1]); w.y = cvt_pk_bf16(v0[2], v0[3]); w.z = cvt_pk_bf16(v1[0], v1[1]); w.w = cvt_pk_bf16(v1[2], v1[3]);
                    *(u32x4*)(rowp + bj * HALF) = w; } }
    }
};
struct EpiF32 {
    static constexpr bool PERM = false, AFTER_DRAIN = false;
    float* O; int ldc;
    __device__ __forceinline__ void operator()(const f32x4 (&acc)[2][2][4][2], const Unit& u, int wr, int wc, int fr, int fq) const {
        const int row0 = u.pm * BM + wr * 64 + fr, col0 = u.pn * BM + wc * 32 + 4 * fq;
#pragma unroll
        for (int ai = 0; ai < 2; ++ai)
#pragma unroll
            for (int m = 0; m < 4; ++m) { float* rowp = O + (size_t)(row0 + ai * HALF + m * 16) * ldc + col0;
#pragma unroll
                for (int bj = 0; bj < 2; ++bj)
#pragma unroll
                    for (int n = 0; n < 2; ++n) *(f32x4*)(rowp + bj * HALF + n * 16) = acc[ai][bj][m][n]; }
    }
};
__device__ __forceinline__ f32x4 shfl4(f32x4 v, int src) { f32x4 r; r.x = __shfl(v.x, src); r.y = __shfl(v.y, src); r.z = __shfl(v.z, src); r.w = __shfl(v.w, src); return r; }
struct EpiUpGate {
    static constexpr bool PERM = true, AFTER_DRAIN = false;
    bf16_t* G; const float* cw; const float* st; float* nfp; float* nfs; float* edge; PG8_LAS float* eb;
    __device__ __forceinline__ void operator()(const f32x4 (&acc)[2][2][4][2], const Unit& u, int wr, int wc, int fr, int fq) const {
        const int lane = fq * 16 + fr;
        const int tc0 = wc * 32 + 8 * fq, j0 = u.pn * 128 + tc0;
        const int src1 = (lane & 48) | ((fr + 15) & 15), src2 = (lane & 48) | ((fr + 14) & 15);
        const bool sample = u.pm >= 64;
        PG8_LAS float* wl = eb + 2048;
        { const int t_ = (int)threadIdx.x; if (t_ < 256) { const int c_ = (t_ < 128 ? 0 : 2816 - 128) + u.pn * 128 + t_;
#pragma unroll
            for (int k = 0; k < 3; ++k) wl[k * 256 + t_] = cw[k * 5632 + c_]; } }
        if (!sample && fr >= 14) {
#pragma unroll
            for (int ai = 0; ai < 2; ++ai)
#pragma unroll
                for (int bj = 0; bj < 2; ++bj)
#pragma unroll
                    for (int n = 0; n < 2; ++n) *(PG8_LAS f32x4*)(eb + ((2 * ai + wr) * 2 + (fr - 14)) * 256 + 128 * bj + tc0 + 4 * n) = acc[ai][bj][3][n];
        }
        asm volatile("s_waitcnt lgkmcnt(0)" ::: "memory"); __builtin_amdgcn_s_barrier(); asm volatile("" ::: "memory");
#pragma unroll
        for (int ai = 0; ai < 2; ++ai) {
            const int blk = 2 * ai + wr;
#pragma unroll
            for (int m = 0; m < 4; ++m) {
                const int r = 128 * ai + 64 * wr + 16 * m + fr;
                int wo = tc0; asm volatile("" : "+v"(wo));
                f32x4 uu[2][2];
#pragma unroll
                for (int bj = 0; bj < 2; ++bj)
#pragma unroll
                    for (int n = 0; n < 2; ++n) {
                        const f32x4 x = acc[ai][bj][m][n];
                        f32x4 p1, p2;
                        if (!sample) {
                            if (m > 0) {
                                const f32x4 xp = acc[ai][bj][m > 0 ? m - 1 : 0][n];
                                const f32x4 v1 = (fr == 15) ? xp : x, v2 = (fr >= 14) ? xp : x;
                                p1 = shfl4(v1, src1); p2 = shfl4(v2, src2);
                            } else {
                                p1 = shfl4(x, src1); p2 = shfl4(x, src2);
                                f32x4 b1 = (f32x4){0.f, 0.f, 0.f, 0.f}, b2 = b1;
                                if (blk > 0) { b1 = *(const PG8_LAS f32x4*)(eb + ((blk - 1) * 2 + 1) * 256 + 128 * bj + tc0 + 4 * n);
                                               b2 = *(const PG8_LAS f32x4*)(eb + ((blk - 1) * 2 + (fr == 0 ? 0 : 1)) * 256 + 128 * bj + tc0 + 4 * n); }
                                if (fr == 0) p1 = b1;
                                if (fr < 2) p2 = b2;
                            }
                        } else {
                            const int srow = (u.pm - 64) * 256 + r, b = srow >> 2, t = fr & 3;
                            p1 = shfl4(x, src1); p2 = shfl4(x, src2);
                            const size_t so = (size_t)b * 2 * 5632 + bj * 2816 + j0 + 4 * n;
                            if (t < 2) { const f32x4 s0 = *(const f32x4*)(st + so), s1 = *(const f32x4*)(st + so + 5632);
                                if (t == 0) { p1 = s1; p2 = s0; } else { p2 = s1; } }
                            else *(f32x4*)(nfs + so + (size_t)(t - 2) * 5632) = x;
                        }
                        const PG8_LAS float* wp = wl + 128 * bj + wo + 4 * n;
                        uu[bj][n] = *(const PG8_LAS f32x4*)wp * p2 + *(const PG8_LAS f32x4*)(wp + 256) * p1 + *(const PG8_LAS f32x4*)(wp + 512) * x;
                    }
                float gv[8];
#pragma unroll
                for (int n = 0; n < 2; ++n)
#pragma unroll
                    for (int c = 0; c < 4; ++c) { const float a = uu[0][n][c], b = uu[1][n][c]; gv[n * 4 + c] = a * __builtin_amdgcn_rcpf(1.0f + __expf(-a)) * b; }
                u32x4 o; o.x = cvt_pk_bf16(gv[0], gv[1]); o.y = cvt_pk_bf16(gv[2], gv[3]); o.z = cvt_pk_bf16(gv[4], gv[5]); o.w = cvt_pk_bf16(gv[6], gv[7]);
                const bool deferred = (!sample) && (blk == 0) && (m == 0) && (fr < 2) && ((u.pm & 7) != 0);
                if (!deferred) *(u32x4*)(G + (size_t)(u.pm * BM + r) * 2816 + j0) = o;
            }
        }
        if (!sample) {
            float* eg = edge + (size_t)(u.pm * 22 + u.pn) * 1024;
            if (wr == 0 && fr < 2) {
#pragma unroll
                for (int bj = 0; bj < 2; ++bj)
#pragma unroll
                    for (int n = 0; n < 2; ++n) *(f32x4*)(eg + fr * 256 + 128 * bj + tc0 + 4 * n) = acc[0][bj][0][n];
            }
            if (wr == 1 && fr >= 14) {
#pragma unroll
                for (int bj = 0; bj < 2; ++bj)
#pragma unroll
                    for (int n = 0; n < 2; ++n) { *(f32x4*)(eg + (2 + fr - 14) * 256 + 128 * bj + tc0 + 4 * n) = acc[1][bj][3][n];
                        if ((u.pm & 7) == 7) *(f32x4*)(nfp + (size_t)((u.pm >> 3) * 2 + (fr - 14)) * 5632 + bj * 2816 + j0 + 4 * n) = acc[1][bj][3][n]; }
            }
        }
    }
};
template <class Epi, class Sched, bool ALIGN_EPI = false, bool SP2 = false>
__device__ __forceinline__ void gemm_phase(PG8_LAS unsigned char* lds, const Gemm g, const Sched& S, const Epi& E) {
    const int tid = threadIdx.x, wid = __builtin_amdgcn_readfirstlane(tid >> 6), lane = tid & 63, wr = wid >> 2, wc = wid & 3, fr = lane & 15, fq = lane >> 4;
    const int K = g.K, nt = K / BK;
    unsigned voffA[2], voffB[2];
#pragma unroll
    for (int i = 0; i < 2; ++i) { int R, C; stage_rc(tid * 16 + i * 8192, R, C); const int Rb = Epi::PERM ? ((R & ~31) + perm32(R & 31)) : R;
        voffA[i] = (unsigned)(R * K + C) * 2u; voffB[i] = (unsigned)(Rb * K + C) * 2u; }
    const size_t kstep = (size_t)(BK * 2);
    const size_t hstep = (size_t)HALF * K * 2;
    const size_t tstep = 2 * hstep;
    const unsigned ldsw = (unsigned)wid * 1024u;
    const int aoff = lds_byte(wr * 64 + fr, fq * 8), boff = lds_byte(wc * 32 + fr, fq * 8);
#define PG8_SA(b, h) (((b) * 2 + (h)) * HTB)
#define PG8_SB(b, h) ((4 + (b) * 2 + (h)) * HTB)
#define PG8_STAGE(bufoff, gbase, voff) do { _Pragma("unroll") for (int _i = 0; _i < 2; ++_i) \
        __builtin_amdgcn_global_load_lds((const unsigned*)((const char*)(gbase) + (voff)[_i]), (PG8_LAS unsigned*)(lds + (bufoff) + ldsw + _i * 8192), 16, 0, 0); } while (0)
#define PG8_LDA(dst, b, h) do { _Pragma("unroll") for (int m = 0; m < 4; ++m) _Pragma("unroll") for (int k = 0; k < 2; ++k) dst[m][k] = *(const PG8_LAS bf16x8*)(lds + PG8_SA(b, h) + aoff + m * 2048 + k * 1024); } while (0)
#define PG8_LDB(dst, b, h) do { _Pragma("unroll") for (int n = 0; n < 2; ++n) _Pragma("unroll") for (int k = 0; k < 2; ++k) dst[n][k] = *(const PG8_LAS bf16x8*)(lds + PG8_SB(b, h) + boff + n * 2048 + k * 1024); } while (0)
#define PG8_MMA(ai, bj, At, Bt) do { __builtin_amdgcn_s_setprio(1); _Pragma("unroll") for (int m = 0; m < 4; ++m) _Pragma("unroll") for (int n = 0; n < 2; ++n) _Pragma("unroll") for (int k = 0; k < 2; ++k) \
        acc[ai][bj][m][n] = __builtin_amdgcn_mfma_f32_16x16x32_bf16(Bt[n][k], At[m][k], acc[ai][bj][m][n], 0, 0, 0); __builtin_amdgcn_s_setprio(0); } while (0)
#define PG8_WAIT_V(n) asm volatile("s_waitcnt vmcnt(" #n ")" ::: "memory")
#define PG8_WAIT_L(n) asm volatile("s_waitcnt lgkmcnt(" #n ")" ::: "memory")
#define PG8_BAR __builtin_amdgcn_s_barrier()
#define PG8_SCHED __builtin_amdgcn_sched_barrier(0)
    Unit cur, nxt; int ui = 0;
    if (!S.next(0, cur)) return;
    f32x4 acc[2][2][4][2];
#pragma unroll
    for (int a = 0; a < 2; ++a)
#pragma unroll
        for (int b = 0; b < 2; ++b)
#pragma unroll
            for (int m = 0; m < 4; ++m)
#pragma unroll
                for (int n = 0; n < 2; ++n) acc[a][b][m][n] = (f32x4){0.f, 0.f, 0.f, 0.f};
    bf16x8 At[4][2], B0[2][2], B1[2][2];
    const char* cA = (const char*)g.A + (size_t)cur.pm * tstep; const char* cB = (const char*)g.Bt + (size_t)cur.pn * tstep;
    S.a_ready(cur);
    if constexpr (SP2) {
        PG8_STAGE(PG8_SB(0, 0), cB, voffB); PG8_STAGE(PG8_SB(0, 1), cB + hstep, voffB); PG8_STAGE(PG8_SA(0, 0), cA, voffA); PG8_STAGE(PG8_SA(0, 1), cA + hstep, voffA);
        if (wr == 1) PG8_BAR;
        PG8_WAIT_V(2); PG8_BAR;
        PG8_STAGE(PG8_SB(1, 0), cB + kstep, voffB); PG8_STAGE(PG8_SA(1, 0), cA + kstep, voffA); PG8_STAGE(PG8_SB(1, 1), cB + hstep + kstep, voffB);
        PG8_WAIT_V(6); PG8_BAR;
    } else {
        PG8_STAGE(PG8_SB(0, 0), cB, voffB); PG8_STAGE(PG8_SA(0, 0), cA, voffA); PG8_STAGE(PG8_SB(0, 1), cB + hstep, voffB); PG8_STAGE(PG8_SA(0, 1), cA + hstep, voffA);
        if (wr == 1) PG8_BAR;
        PG8_WAIT_V(4); PG8_BAR;
        PG8_STAGE(PG8_SB(1, 0), cB + kstep, voffB); PG8_STAGE(PG8_SA(1, 0), cA + kstep, voffA); PG8_STAGE(PG8_SB(1, 1), cB + hstep + kstep, voffB);
        PG8_WAIT_V(6); PG8_BAR;
    }
    for (;;) {
        const bool has_next = S.next(ui + 1, nxt);
        const char* nA = has_next ? (const char*)g.A + (size_t)nxt.pm * tstep : cA; const char* nB = has_next ? (const char*)g.Bt + (size_t)nxt.pn * tstep : cB;
        for (int t = 0; t < nt; t += 2) {
            const bool last = (t == nt - 2);
            const char* a1 = cA + (size_t)(t + 1) * kstep;
            const char* a2 = last ? nA : cA + (size_t)(t + 2) * kstep; const char* b2 = last ? nB : cB + (size_t)(t + 2) * kstep;
            const char* a3 = a2 + kstep; const char* b3 = b2 + kstep;
            if (last && has_next) S.a_ready(nxt);
            if constexpr (SP2) {
            PG8_LDB(B0, 0, 0); PG8_LDB(B1, 0, 1); PG8_SCHED; PG8_LDA(At, 0, 0); PG8_STAGE(PG8_SA(1, 1), a1 + hstep, voffA);
            PG8_WAIT_V(8); PG8_WAIT_L(0); PG8_BAR; PG8_MMA(0, 0, At, B0); PG8_MMA(0, 1, At, B1); PG8_BAR; PG8_SCHED;
            PG8_LDA(At, 0, 1); PG8_STAGE(PG8_SB(0, 0), b2, voffB); PG8_STAGE(PG8_SB(0, 1), b2 + hstep, voffB); PG8_STAGE(PG8_SA(0, 0), a2, voffA);
            PG8_WAIT_V(8); PG8_WAIT_L(0); PG8_BAR; PG8_MMA(1, 0, At, B0); PG8_MMA(1, 1, At, B1); PG8_BAR; PG8_SCHED;
            PG8_LDB(B0, 1, 0); PG8_LDB(B1, 1, 1); PG8_SCHED; PG8_LDA(At, 1, 0); PG8_STAGE(PG8_SA(0, 1), a2 + hstep, voffA);
            PG8_WAIT_V(8); PG8_WAIT_L(0); PG8_BAR; PG8_MMA(0, 0, At, B0); PG8_MMA(0, 1, At, B1); PG8_BAR; PG8_SCHED;
            PG8_LDA(At, 1, 1); PG8_STAGE(PG8_SB(1, 0), b3, voffB); PG8_STAGE(PG8_SB(1, 1), b3 + hstep, voffB); PG8_STAGE(PG8_SA(1, 0), a3, voffA);
            PG8_WAIT_V(8); PG8_WAIT_L(0); PG8_BAR; PG8_MMA(1, 0, At, B0); PG8_MMA(1, 1, At, B1); PG8_BAR; PG8_SCHED;
            } else {
            PG8_LDB(B0, 0, 0); PG8_SCHED; PG8_LDA(At, 0, 0); PG8_STAGE(PG8_SA(1, 1), a1 + hstep, voffA);
            PG8_WAIT_L(8); PG8_BAR; PG8_WAIT_L(0); PG8_MMA(0, 0, At, B0); PG8_BAR; PG8_SCHED;
            PG8_LDB(B1, 0, 1); PG8_STAGE(PG8_SB(0, 0), b2, voffB);
            PG8_BAR; PG8_WAIT_L(0); PG8_MMA(0, 1, At, B1); PG8_BAR;
            PG8_LDA(At, 0, 1); PG8_STAGE(PG8_SA(0, 0), a2, voffA);
            PG8_BAR; PG8_WAIT_L(0); PG8_MMA(1, 0, At, B0); PG8_BAR; PG8_SCHED;
            PG8_STAGE(PG8_SB(0, 1), b2 + hstep, voffB);
            PG8_WAIT_V(6); PG8_BAR; PG8_MMA(1, 1, At, B1); PG8_BAR;
            PG8_LDB(B0, 1, 0); PG8_SCHED; PG8_LDA(At, 1, 0); PG8_STAGE(PG8_SA(0, 1), a2 + hstep, voffA);
            PG8_WAIT_L(8); PG8_BAR; PG8_WAIT_L(0); PG8_MMA(0, 0, At, B0); PG8_BAR; PG8_SCHED;
            PG8_LDB(B1, 1, 1); PG8_STAGE(PG8_SB(1, 0), b3, voffB);
            PG8_BAR; PG8_WAIT_L(0); PG8_MMA(0, 1, At, B1); PG8_BAR;
            PG8_LDA(At, 1, 1); PG8_STAGE(PG8_SA(1, 0), a3, voffA);
            PG8_BAR; PG8_WAIT_L(0); PG8_MMA(1, 0, At, B0); PG8_BAR; PG8_SCHED;
            PG8_STAGE(PG8_SB(1, 1), b3 + hstep, voffB);
            PG8_WAIT_V(6); PG8_BAR; PG8_MMA(1, 1, At, B1); PG8_BAR;
            }
        }
        if constexpr (ALIGN_EPI) { if (wr == 0) PG8_BAR; }
        if constexpr (!Epi::AFTER_DRAIN) { E(acc, cur, wr, wc, fr, fq); S.done(cur); }
        if (!has_next) break;
#pragma unroll
        for (int a = 0; a < 2; ++a)
#pragma unroll
            for (int b = 0; b < 2; ++b)
#pragma unroll
                for (int m = 0; m < 4; ++m)
#pragma unroll
                    for (int n = 0; n < 2; ++n) acc[a][b][m][n] = (f32x4){0.f, 0.f, 0.f, 0.f};
        cur = nxt; cA = nA; cB = nB; ++ui;
        if constexpr (ALIGN_EPI) { if (wr == 1) PG8_BAR; }
    }
    PG8_WAIT_V(0);
    if constexpr (!ALIGN_EPI) { if (wr == 0) PG8_BAR; }
    PG8_BAR;
    if constexpr (Epi::AFTER_DRAIN) { E.fused(acc, cur, wr, wc, fr, fq, lds, wid, lane); S.done(cur); }
#undef PG8_SA
#undef PG8_SB
#undef PG8_STAGE
#undef PG8_LDA
#undef PG8_LDB
#undef PG8_MMA
#undef PG8_WAIT_V
#undef PG8_WAIT_L
#undef PG8_BAR
#undef PG8_SCHED
}
}
#define LAS __attribute__((address_space(3)))
typedef unsigned short bf16;
typedef unsigned v4u __attribute__((ext_vector_type(4)));
typedef unsigned v2u __attribute__((ext_vector_type(2)));
typedef float f32x4 __attribute__((ext_vector_type(4)));
typedef short bf16x8 __attribute__((ext_vector_type(8)));
#ifndef MK_COOP
#define MK_COOP 0
#endif
constexpr int NWAVES = 8, NPHASE = 10;
constexpr int MP = 16384, MS = 512, M = MP + MS, D = 1024, DIN = 2048, DFF = 2816, DUP = 5632, NBATCH = 136, NMOD = 6144;
constexpr float EPS = 1e-6f;
constexpr size_t MiB = 1u << 20;
constexpr size_t WS_CTL = 0, CTL_ZERO_BYTES = 1 * MiB, WS_MOD = 1 * MiB, WS_WIN = 5 * MiB, WS_WOUT = 9 * MiB, WS_WUP = 11 * MiB, WS_WDN = 22 * MiB, WS_EDGE = 28 * MiB,
                 WS_H = 34 * MiB, WS_DY = 67 * MiB, WS_PROJ = 100 * MiB, WS_MIX = 100 * MiB, WS_G = 67 * MiB, WS_F = 160 * MiB, WS_END = 256 * MiB;
constexpr size_t O_Y = 0, O_NPP = 17301504, O_NCP = 17362944, O_NFP = 17371136, O_NPS = 17461248, O_NCS = 18444288, O_NFS = 18575360, O_END = 20017152;
constexpr int RING_BYTES = 131072, EB_OFF = 131072, LDS_BYTES = 147456;
#define LDS_WAIT() asm volatile("s_waitcnt lgkmcnt(0)" ::: "memory")

__device__ __forceinline__ unsigned f2bf(float f) { unsigned u = __builtin_bit_cast(unsigned, f); return (u + 0x7fffu + ((u >> 16) & 1u)) >> 16; }
__device__ __forceinline__ unsigned pk2(float lo, float hi) { return f2bf(lo) | (f2bf(hi) << 16); }
__device__ __forceinline__ void unpack8(v4u v, float (&f)[8]) {
    f[0] = __builtin_bit_cast(float, v.x << 16); f[1] = __builtin_bit_cast(float, v.x & 0xffff0000u);
    f[2] = __builtin_bit_cast(float, v.y << 16); f[3] = __builtin_bit_cast(float, v.y & 0xffff0000u);
    f[4] = __builtin_bit_cast(float, v.z << 16); f[5] = __builtin_bit_cast(float, v.z & 0xffff0000u);
    f[6] = __builtin_bit_cast(float, v.w << 16); f[7] = __builtin_bit_cast(float, v.w & 0xffff0000u);
}
__device__ __forceinline__ v4u pack8(const float (&f)[8]) { v4u o; o.x = pk2(f[0], f[1]); o.y = pk2(f[2], f[3]); o.z = pk2(f[4], f[5]); o.w = pk2(f[6], f[7]); return o; }
__device__ __forceinline__ float wave_sum(float v) {
#pragma unroll
    for (int o = 1; o < 64; o <<= 1) v += __shfl_xor(v, o);
    return v;
}
__device__ __forceinline__ float silu_f(float a) { return a / (1.0f + __expf(-a)); }

struct Args { const float* in[21]; float* out; unsigned char* ws; int ph_lo, ph_hi; };
enum { I_XP = 0, I_XS, I_SPOOL, I_SCONV, I_SFFN, I_CP, I_CS, I_WADA, I_BADA, I_GPREMIX, I_GPOSTMIX, I_GPREFFN, I_GPOSTFFN, I_WIN, I_POOLW, I_POOLS, I_CONVW, I_WOUT, I_WUP, I_FCONVW, I_WDN };

__device__ __forceinline__ const float* xrow(const Args& a, int m) { return m < MP ? a.in[I_XP] + (size_t)m * D : a.in[I_XS] + (size_t)(m - MP) * D; }
__device__ __forceinline__ int batch_of(int m) { return m < MP ? (m >> 11) : 8 + ((m - MP) >> 2); }

__device__ __forceinline__ void tr_item(const float* W, int ldw, int k0, int n0, bf16* WT, int ldt, int drow0, int dk0, LAS float* scr, int lane) {
#pragma unroll 8
    for (int i = 0; i < 32; ++i) { const int kk = 2 * i + (lane >> 5); scr[kk * 33 + (lane & 31)] = W[(size_t)(k0 + kk) * ldw + n0 + (lane & 31)]; }
    LDS_WAIT(); asm volatile("" ::: "memory");
    const int c = lane & 7;
#pragma unroll
    for (int j = 0; j < 4; ++j) { const int n = (lane >> 3) + 8 * j; const LAS float* s = scr + (8 * c) * 33 + n;
        v4u o; o.x = pk2(s[0 * 33], s[1 * 33]); o.y = pk2(s[2 * 33], s[3 * 33]); o.z = pk2(s[4 * 33], s[5 * 33]); o.w = pk2(s[6 * 33], s[7 * 33]);
        *(v4u*)(WT + (size_t)(drow0 + n) * ldt + dk0 + 8 * c) = o; }
    LDS_WAIT(); asm volatile("" ::: "memory");
}

__device__ __forceinline__ void p0_prologue(const Args& a, LAS unsigned char* lds, int tid, int lane, int wave) {
    unsigned char* ws = a.ws;
    bf16* Win_t = (bf16*)(ws + WS_WIN); bf16* Wout_t = (bf16*)(ws + WS_WOUT); bf16* Wup_t = (bf16*)(ws + WS_WUP); bf16* Wdn_t = (bf16*)(ws + WS_WDN);
    float* mod = (float*)(ws + WS_MOD);
    const int G = gridDim.x, gw = blockIdx.x * NWAVES + wave, NGW = G * NWAVES;
    {
        LAS f32x4* red = (LAS f32x4*)lds;
        const int fr = lane & 15, fq = lane >> 4;
        for (int wi = blockIdx.x; wi < NMOD / 32; wi += G) {
            const int n0 = wi * 32 + (wave >> 2) * 16, kq = wave & 3;
            f32x4 acc[9];
#pragma unroll
            for (int rb = 0; rb < 9; ++rb) acc[rb] = (f32x4){0.f, 0.f, 0.f, 0.f};
            for (int ks = 0; ks < 8; ++ks) {
                const int k0 = kq * 256 + ks * 32 + fq * 8;
                float wv[8];
#pragma unroll
                for (int i = 0; i < 8; ++i) wv[i] = a.in[I_WADA][(size_t)(k0 + i) * NMOD + n0 + fr];
                const bf16x8 bfrag = __builtin_bit_cast(bf16x8, pack8(wv));
#pragma unroll
                for (int rb = 0; rb < 9; ++rb) {
                    const int row = rb * 16 + fr; float cv[8];
                    if (row < NBATCH) { const float* cp = (row < 8 ? a.in[I_CP] + (size_t)row * D : a.in[I_CS] + (size_t)(row - 8) * D) + k0;
                        const f32x4 c0 = *(const f32x4*)cp, c1 = *(const f32x4*)(cp + 4);
                        cv[0] = silu_f(c0.x); cv[1] = silu_f(c0.y); cv[2] = silu_f(c0.z); cv[3] = silu_f(c0.w); cv[4] = silu_f(c1.x); cv[5] = silu_f(c1.y); cv[6] = silu_f(c1.z); cv[7] = silu_f(c1.w);
                    } else {
#pragma unroll
                        for (int i = 0; i < 8; ++i) cv[i] = 0.f; }
                    const bf16x8 afrag = __builtin_bit_cast(bf16x8, pack8(cv));
                    acc[rb] = __builtin_amdgcn_mfma_f32_16x16x32_bf16(bfrag, afrag, acc[rb], 0, 0, 0);
                }
            }
#pragma unroll
            for (int rb = 0; rb < 9; ++rb) red[(wave * 9 + rb) * 64 + lane] = acc[rb];
            __syncthreads();
            if (kq == 0) {
#pragma unroll
                for (int rb = 0; rb < 9; ++rb) {
                    const int row = rb * 16 + fr, col = n0 + 4 * fq;
                    f32x4 s = red[(wave * 9 + rb) * 64 + lane] + red[((wave + 1) * 9 + rb) * 64 + lane] + red[((wave + 2) * 9 + rb) * 64 + lane] + red[((wave + 3) * 9 + rb) * 64 + lane];
                    s += *(const f32x4*)(a.in[I_BADA] + col);
                    if (row < NBATCH) *(f32x4*)(mod + (size_t)row * NMOD + col) = s;
                }
            }
            __syncthreads();
        }
    }
    {
        LAS float* scr = (LAS float*)(lds + wave * 16384);
        constexpr int I_IN = 16 * 64, I_OUT = 8 * 32, I_UP = 16 * 176, I_DN = 44 * 32, NITEMS = I_IN + I_OUT + I_UP + I_DN;
        for (int it = gw; it < NITEMS; it += NGW) {
            int r = it;
            if (r < I_IN) { const int kb = r / 64, nb = r % 64; tr_item(a.in[I_WIN], DIN, 64 * kb, 32 * nb, Win_t, D, 32 * nb, 64 * kb, scr, lane); continue; } r -= I_IN;
            if (r < I_OUT) { const int kb = r / 32, nb = r % 32; tr_item(a.in[I_WOUT] + (size_t)512 * D, D, 64 * kb, 32 * nb, Wout_t, D, 32 * nb, 512 + 64 * kb, scr, lane); continue; } r -= I_OUT;
            if (r < I_UP) { const int kb = r / 176, nb = r % 176, n0 = 32 * nb;
                const int drow0 = n0 < DFF ? (n0 / 128) * 256 + (n0 % 128) : ((n0 - DFF) / 128) * 256 + 128 + ((n0 - DFF) % 128);
                tr_item(a.in[I_WUP], DUP, 64 * kb, n0, Wup_t, D, drow0, 64 * kb, scr, lane); continue; } r -= I_UP;
            { const int kb = r / 32, nb = r % 32; tr_item(a.in[I_WDN], D, 64 * kb, 32 * nb, Wdn_t, DFF, 32 * nb, 64 * kb, scr, lane); }
        }
    }
    {
        const int NT = G * NWAVES * 64;
        for (int it = blockIdx.x * 512 + tid; it < 64 * 1024; it += NT) {
            const int kb = it >> 10, n = it & 1023, k0 = kb * 8, gb = (k0 >> 7) * 128;
            float acc[8];
#pragma unroll
            for (int i = 0; i < 8; ++i) acc[i] = 0.f;
            for (int j = 0; j < 128; ++j) {
                const float s = a.in[I_POOLS][gb + j] * a.in[I_WOUT][(size_t)(gb + j) * D + n];
#pragma unroll
                for (int i = 0; i < 8; ++i) acc[i] += a.in[I_POOLW][(size_t)(k0 + i) * 128 + j] * s;
            }
            *(v4u*)(Wout_t + (size_t)n * D + k0) = pack8(acc);
        }
    }
}

__device__ __forceinline__ void p1_norm(const Args& a, int lane, int wave) {
    bf16* H = (bf16*)(a.ws + WS_H); const float* mod = (const float*)(a.ws + WS_MOD);
    const int gw = blockIdx.x * NWAVES + wave, NGW = gridDim.x * NWAVES;
    for (int m = gw; m < M; m += NGW) {
        const float* xr = xrow(a, m); const float* md = mod + (size_t)batch_of(m) * NMOD;
        f32x4 v[4]; float ss = 0.f;
#pragma unroll
        for (int j = 0; j < 4; ++j) { v[j] = *(const f32x4*)(xr + 4 * lane + 256 * j); ss += (v[j].x * v[j].x + v[j].y * v[j].y) + (v[j].z * v[j].z + v[j].w * v[j].w); }
        const float rstd = 1.0f / sqrtf(wave_sum(ss) * (1.0f / D) + EPS);
#pragma unroll
        for (int j = 0; j < 4; ++j) { const int col = 4 * lane + 256 * j;
            const f32x4 g = *(const f32x4*)(a.in[I_GPREMIX] + col), sc = *(const f32x4*)(md + 1024 + col), sh = *(const f32x4*)(md + col);
            const f32x4 o = v[j] * rstd * g * (1.0f + sc) + sh;
            v2u w; w.x = pk2(o.x, o.y); w.y = pk2(o.z, o.w); *(v2u*)(H + (size_t)m * D + col) = w; }
    }
}

__device__ __forceinline__ void p3_mixer(const Args& a, int tid) {
    const bf16* PROJ = (const bf16*)(a.ws + WS_PROJ); bf16* DY = (bf16*)(a.ws + WS_DY);
    float* npp = a.out + O_NPP; float* ncp = a.out + O_NCP; float* nps = a.out + O_NPS; float* ncs = a.out + O_NCS;
    const long NT = (long)gridDim.x * 512;
    for (long it = (long)blockIdx.x * 512 + tid; it < (long)M * 128; it += NT) {
        const int m = (int)(it >> 7), q = (int)(it & 127);
        const bool smp = m >= MP;
        const int b = smp ? ((m - MP) >> 2) : (m >> 11), t = smp ? ((m - MP) & 3) : (m & 2047);
        if (q < 64) {
            const int j0 = 8 * q, w = 2 << (j0 >> 7);
            const bf16* pr = PROJ + (size_t)m * DIN + j0;
            float cur[8], s[8], tmp[8];
            unpack8(*(const v4u*)pr, cur);
#pragma unroll
            for (int i = 0; i < 8; ++i) s[i] = cur[i];
            float cnt;
            if (!smp) {
                const int nv = (t + 1) < w ? (t + 1) : w;
                for (int i = 1; i < nv; ++i) { unpack8(*(const v4u*)(pr - (size_t)i * DIN), tmp);
#pragma unroll
                    for (int e = 0; e < 8; ++e) s[e] += tmp[e]; }
                cnt = (float)nv;
                if (t >= 2033) { float* o = npp + (size_t)(b * 15 + (t - 2033)) * 512 + j0; *(f32x4*)o = (f32x4){cur[0], cur[1], cur[2], cur[3]}; *(f32x4*)(o + 4) = (f32x4){cur[4], cur[5], cur[6], cur[7]}; }
            } else {
                for (int i = 1; i < w; ++i) {
                    if (t - i >= 0) unpack8(*(const v4u*)(pr - (size_t)i * DIN), tmp);
                    else { const float* sp = a.in[I_SPOOL] + (size_t)(b * 15 + 15 + t - i) * 512 + j0; const f32x4 s0 = *(const f32x4*)sp, s1 = *(const f32x4*)(sp + 4);
                        tmp[0] = s0.x; tmp[1] = s0.y; tmp[2] = s0.z; tmp[3] = s0.w; tmp[4] = s1.x; tmp[5] = s1.y; tmp[6] = s1.z; tmp[7] = s1.w; }
#pragma unroll
                    for (int e = 0; e < 8; ++e) s[e] += tmp[e]; }
                cnt = (float)w;
                { float* o = nps + (size_t)(b * 15 + 11 + t) * 512 + j0; *(f32x4*)o = (f32x4){cur[0], cur[1], cur[2], cur[3]}; *(f32x4*)(o + 4) = (f32x4){cur[4], cur[5], cur[6], cur[7]}; }
                for (int i = t; i < 11; i += 4) { const float* sp = a.in[I_SPOOL] + (size_t)(b * 15 + i + 4) * 512 + j0; float* o = nps + (size_t)(b * 15 + i) * 512 + j0;
                    *(f32x4*)o = *(const f32x4*)sp; *(f32x4*)(o + 4) = *(const f32x4*)(sp + 4); }
            }
            const float inv = 1.0f / cnt; float d[8];
#pragma unroll
            for (int e = 0; e < 8; ++e) d[e] = s[e] * inv - cur[e];
            *(v4u*)(DY + (size_t)m * D + j0) = pack8(d);
        } else {
            const int j0 = 8 * (q - 64);
            const bf16* pr = PROJ + (size_t)m * DIN + j0;
            float xv[8], bv[8], cv[8], cx0[8], cx1[8], cx2[8];
            unpack8(*(const v4u*)(pr + 512), xv); unpack8(*(const v4u*)(pr + 1024), bv); unpack8(*(const v4u*)(pr + 1536), cv);
#pragma unroll
            for (int e = 0; e < 8; ++e) cx0[e] = cv[e] * xv[e];
#pragma unroll
            for (int k = 1; k <= 2; ++k) {
                float (&dst)[8] = (k == 1) ? cx1 : cx2;
                if (t - k >= 0) { float x2[8], c2[8]; unpack8(*(const v4u*)(pr - (size_t)k * DIN + 512), x2); unpack8(*(const v4u*)(pr - (size_t)k * DIN + 1536), c2);
#pragma unroll
                    for (int e = 0; e < 8; ++e) dst[e] = c2[e] * x2[e]; }
                else if (smp) { const float* sp = a.in[I_SCONV] + (size_t)(b * 2 + 2 + t - k) * 512 + j0; const f32x4 s0 = *(const f32x4*)sp, s1 = *(const f32x4*)(sp + 4);
                    dst[0] = s0.x; dst[1] = s0.y; dst[2] = s0.z; dst[3] = s0.w; dst[4] = s1.x; dst[5] = s1.y; dst[6] = s1.z; dst[7] = s1.w; }
                else {
#pragma unroll
                    for (int e = 0; e < 8; ++e) dst[e] = 0.f; }
            }
            const float* cwp = a.in[I_CONVW] + j0; float y[8];
#pragma unroll
            for (int e = 0; e < 8; ++e) y[e] = bv[e] * (cwp[e] * cx2[e] + cwp[512 + e] * cx1[e] + cwp[1024 + e] * cx0[e]);
            *(v4u*)(DY + (size_t)m * D + 512 + j0) = pack8(y);
            float* so = nullptr;
            if (!smp) { if (t >= 2046) so = ncp + (size_t)(b * 2 + t - 2046) * 512 + j0; } else { if (t >= 2) so = ncs + (size_t)(b * 2 + t - 2) * 512 + j0; }
            if (so) { *(f32x4*)so = (f32x4){cx0[0], cx0[1], cx0[2], cx0[3]}; *(f32x4*)(so + 4) = (f32x4){cx0[4], cx0[5], cx0[6], cx0[7]}; }
        }
    }
}

__device__ __forceinline__ void p5_rowwise1(const Args& a, int lane, int wave) {
    const float* MIX = (const float*)(a.ws + WS_MIX); bf16* H = (bf16*)(a.ws + WS_H); const float* mod = (const float*)(a.ws + WS_MOD); float* Y = a.out + O_Y;
    const int gw = blockIdx.x * NWAVES + wave, NGW = gridDim.x * NWAVES;
    for (int m = gw; m < M; m += NGW) {
        const float* xr = xrow(a, m); const float* md = mod + (size_t)batch_of(m) * NMOD; const float* mr = MIX + (size_t)m * D;
        f32x4 v[4]; float ss = 0.f;
#pragma unroll
        for (int j = 0; j < 4; ++j) { v[j] = *(const f32x4*)(mr + 4 * lane + 256 * j); ss += (v[j].x * v[j].x + v[j].y * v[j].y) + (v[j].z * v[j].z + v[j].w * v[j].w); }
        const float r1 = 1.0f / sqrtf(wave_sum(ss) * (1.0f / D) + EPS);
        float s2 = 0.f;
#pragma unroll
        for (int j = 0; j < 4; ++j) { const int col = 4 * lane + 256 * j;
            const f32x4 x = *(const f32x4*)(xr + col), g = *(const f32x4*)(a.in[I_GPOSTMIX] + col), gt = *(const f32x4*)(md + 2048 + col);
            v[j] = x + gt * (v[j] * r1 * g);
            *(f32x4*)(Y + (size_t)m * D + col) = v[j];
            s2 += (v[j].x * v[j].x + v[j].y * v[j].y) + (v[j].z * v[j].z + v[j].w * v[j].w); }
        const float r2 = 1.0f / sqrtf(wave_sum(s2) * (1.0f / D) + EPS);
#pragma unroll
        for (int j = 0; j < 4; ++j) { const int col = 4 * lane + 256 * j;
            const f32x4 g = *(const f32x4*)(a.in[I_GPREFFN] + col), sc = *(const f32x4*)(md + 4096 + col), sh = *(const f32x4*)(md + 3072 + col);
            const f32x4 o = v[j] * r2 * g * (1.0f + sc) + sh;
            v2u w; w.x = pk2(o.x, o.y); w.y = pk2(o.z, o.w); *(v2u*)(H + (size_t)m * D + col) = w; }
    }
}

__device__ __forceinline__ void p7_fixup(const Args& a, int tid) {
    const float* edge = (const float*)(a.ws + WS_EDGE); bf16* Gb = (bf16*)(a.ws + WS_G); const float* cw = a.in[I_FCONVW];
    const int NT = gridDim.x * 512;
    for (int it = blockIdx.x * 512 + tid; it < 56 * 22 * 128; it += NT) {
        const int rho = it & 127, pn = (it >> 7) % 22, pi = (it >> 7) / 22, pm = (pi / 7) * 8 + 1 + (pi % 7);
        const float* et = edge + (size_t)(pm * 22 + pn) * 1024; const float* eb = edge + (size_t)((pm - 1) * 22 + pn) * 1024 + 512;
        float u0[2], u1[2];
#pragma unroll
        for (int h = 0; h < 2; ++h) { const int tc = rho + 128 * h, c = h * DFF + pn * 128 + rho;
            const float pb0 = eb[tc], pb1 = eb[256 + tc], t0 = et[tc], t1 = et[256 + tc];
            const float w0 = cw[c], w1 = cw[DUP + c], w2 = cw[2 * DUP + c];
            u0[h] = w0 * pb0 + w1 * pb1 + w2 * t0; u1[h] = w0 * pb1 + w1 * t0 + w2 * t1; }
        Gb[(size_t)(pm * 256) * DFF + pn * 128 + rho] = (bf16)f2bf(silu_f(u0[0]) * u0[1]);
        Gb[(size_t)(pm * 256 + 1) * DFF + pn * 128 + rho] = (bf16)f2bf(silu_f(u1[0]) * u1[1]);
    }
}

__device__ __forceinline__ void p9_rowwise2(const Args& a, int lane, int wave) {
    const float* Fb = (const float*)(a.ws + WS_F); const float* mod = (const float*)(a.ws + WS_MOD); float* Y = a.out + O_Y;
    const int gw = blockIdx.x * NWAVES + wave, NGW = gridDim.x * NWAVES;
    for (int m = gw; m < M; m += NGW) {
        const float* md = mod + (size_t)batch_of(m) * NMOD; const float* fr = Fb + (size_t)m * D;
        f32x4 v[4]; float ss = 0.f;
#pragma unroll
        for (int j = 0; j < 4; ++j) { v[j] = *(const f32x4*)(fr + 4 * lane + 256 * j); ss += (v[j].x * v[j].x + v[j].y * v[j].y) + (v[j].z * v[j].z + v[j].w * v[j].w); }
        const float r1 = 1.0f / sqrtf(wave_sum(ss) * (1.0f / D) + EPS);
#pragma unroll
        for (int j = 0; j < 4; ++j) { const int col = 4 * lane + 256 * j;
            const f32x4 x = *(const f32x4*)(Y + (size_t)m * D + col), g = *(const f32x4*)(a.in[I_GPOSTFFN] + col), gt = *(const f32x4*)(md + 5120 + col);
            *(f32x4*)(Y + (size_t)m * D + col) = x + gt * (v[j] * r1 * g); }
    }
}

__global__ void __launch_bounds__(NWAVES * 64, 2) fwd_mk(Args args) {
    extern __shared__ __attribute__((aligned(16))) unsigned char lds_raw[];
    LAS unsigned char* lds = (LAS unsigned char*)lds_raw;
    const int tid = threadIdx.x, lane = tid & 63, wave = __builtin_amdgcn_readfirstlane(tid >> 6);
    const int lo = args.ph_lo, hi = args.ph_hi, G = gridDim.x;
    unsigned char* ws = args.ws;
#define IN(k) (lo <= (k) && (k) < hi)
#define SEAM(k) do { if (IN(k) && IN((k) + 1)) cg::this_grid().sync(); } while (0)
    if (IN(0)) { p0_prologue(args, lds, tid, lane, wave); } SEAM(0);
    if (IN(1)) { p1_norm(args, lane, wave); } SEAM(1);
    if (IN(2)) {
        pg8::Gemm g{(const bf16*)(ws + WS_H), (const bf16*)(ws + WS_WIN), M, DIN, D}; pg8::StaticOrder S; S.init(M, DIN, G, (int)blockIdx.x);
        pg8::EpiBf16<0> E{(bf16*)(ws + WS_PROJ), DIN, nullptr, 0, 0, 1.f};
        pg8::gemm_phase<pg8::EpiBf16<0>, pg8::StaticOrder, true, true>(lds, g, S, E);
    } SEAM(2);
    if (IN(3)) { p3_mixer(args, tid); } SEAM(3);
    if (IN(4)) {
        pg8::Gemm g{(const bf16*)(ws + WS_DY), (const bf16*)(ws + WS_WOUT), M, D, D}; pg8::StaticOrder S; S.init(M, D, G, (int)blockIdx.x);
        pg8::EpiF32 E{(float*)(ws + WS_MIX), D};
        pg8::gemm_phase<pg8::EpiF32, pg8::StaticOrder, true, true>(lds, g, S, E);
    } SEAM(4);
    if (IN(5)) { p5_rowwise1(args, lane, wave); } SEAM(5);
    if (IN(6)) {
        pg8::Gemm g{(const bf16*)(ws + WS_H), (const bf16*)(ws + WS_WUP), M, DUP, D}; pg8::StaticOrder S; S.init(M, DUP, G, (int)blockIdx.x);
        pg8::EpiUpGate E{(bf16*)(ws + WS_G), args.in[I_FCONVW], args.in[I_SFFN], args.out + O_NFP, args.out + O_NFS, (float*)(ws + WS_EDGE), (LAS float*)(lds + EB_OFF)};
        pg8::gemm_phase<pg8::EpiUpGate, pg8::StaticOrder, true, true>(lds, g, S, E);
    } SEAM(6);
    if (IN(7)) { p7_fixup(args, tid); } SEAM(7);
    if (IN(8)) {
        pg8::Gemm g{(const bf16*)(ws + WS_G), (const bf16*)(ws + WS_WDN), M, D, DFF}; pg8::StaticOrder S; S.init(M, D, G, (int)blockIdx.x);
        pg8::EpiF32 E{(float*)(ws + WS_F), D};
        pg8::gemm_phase<pg8::EpiF32, pg8::StaticOrder, true, true>(lds, g, S, E);
    } SEAM(8);
    if (IN(9)) { p9_rowwise2(args, lane, wave); }
#undef IN
#undef SEAM
}

extern "C" void kernel_launch(void* const* d_in, const int* in_sizes, int n_in, void* d_out, int out_size, void* d_ws, size_t ws_size, hipStream_t stream) {
    static int grid = 0;
    if (grid == 0) {
        if (n_in != 21 || out_size != (int)O_END || ws_size < WS_END) { fprintf(stderr, "kernel_launch: unexpected shapes (n_in %d out %d ws %zu)\n", n_in, out_size, ws_size); grid = -1; return; }
        int dev = 0, cus = 0, per_cu = 0;
        hipGetDevice(&dev); hipDeviceGetAttribute(&cus, hipDeviceAttributeMultiprocessorCount, dev);
        if (hipFuncSetAttribute((const void*)fwd_mk, hipFuncAttributeMaxDynamicSharedMemorySize, LDS_BYTES) != hipSuccess) { fprintf(stderr, "kernel_launch: hipFuncSetAttribute failed\n"); grid = -1; return; }
        if (hipOccupancyMaxActiveBlocksPerMultiprocessor(&per_cu, (const void*)fwd_mk, NWAVES * 64, LDS_BYTES) != hipSuccess || per_cu < 1) { fprintf(stderr, "kernel_launch: occupancy query says %d\n", per_cu); per_cu = 1; }
        (void)hipGetLastError();
        grid = cus > 0 ? cus : 256;
    }
    if (grid < 0) return;
    Args a{};
    for (int i = 0; i < 21; ++i) a.in[i] = (const float*)d_in[i];
    a.out = (float*)d_out; a.ws = (unsigned char*)d_ws;
#if MK_COOP
    a.ph_lo = 0; a.ph_hi = NPHASE;
    void* kargs[] = {&a};
    hipError_t e = hipLaunchCooperativeKernel((const void*)fwd_mk, dim3(grid), dim3(NWAVES * 64), kargs, LDS_BYTES, stream);
    if (e != hipSuccess) fprintf(stderr, "kernel_launch: cooperative launch failed: %s (grid %d)\n", hipGetErrorString(e), grid);
#else
    for (int p = 0; p < NPHASE; ++p) { a.ph_lo = p; a.ph_hi = p + 1; hipLaunchKernelGGL(fwd_mk, dim3(grid), dim3(NWAVES * 64), LDS_BYTES, stream, a); }
#endif
}
```

```cpp
#include <hip/hip_runtime.h>
#include <hip/hip_cooperative_groups.h>
#include <cstdio>
#include <cstdint>
namespace cg = cooperative_groups;
namespace pg8 {
#define PG8_LAS __attribute__((address_space(3)))
typedef unsigned short bf16_t;
typedef short bf16x8 __attribute__((ext_vector_type(8)));
typedef float f32x4 __attribute__((ext_vector_type(4)));
typedef unsigned u32x4 __attribute__((ext_vector_type(4)));
constexpr int BM = 256, BK = 64, HALF = 128, HTB = HALF * BK * 2  , STAGE_BYTES = 8 * HTB, NXCD = 8, WGM = 8;

__host__ __device__ __forceinline__ int lds_byte(int r, int c) { const int st = (r >> 4) * 2 + (c >> 5), rr = r & 15, cc = c & 31, ob = rr * 64 + cc * 2; return st * 1024 + (ob ^ (((ob >> 9) & 1) << 5)); }
__host__ __device__ __forceinline__ void stage_rc(int b, int& R, int& C) { const int st = b / 1024, sb = b % 1024, swz = sb ^ (((sb >> 9) & 1) << 5); R = (st >> 1) * 16 + swz / 64; C = (st & 1) * 32 + (swz % 64) / 2; }
__host__ __device__ __forceinline__ int perm32(int rho) { const int n = rho >> 4, i = rho & 15; return 8 * (i >> 2) + 4 * n + (i & 3); }

struct Unit { int pm, pn, ks; };
struct Gemm { const bf16_t* A; const bf16_t* Bt; int M, N, K; int P = 0; };

struct StaticOrder {
    int nM, nN, nwg, G, c;
    __host__ __device__ void init(int M, int N, int G_, int c_) { nM = M / BM; nN = N / BM; nwg = nM * nN; G = G_; c = c_; }
    __host__ __device__ bool next(int i, Unit& u) const {
        const long L = (long)i * G + c; if (L >= nwg) return false;
        int wgid = (int)L; { const int q = nwg / NXCD, r = nwg % NXCD, xcd = wgid % NXCD, off = wgid / NXCD; wgid = (xcd < r ? xcd * (q + 1) : r * (q + 1) + (xcd - r) * q) + off; }
        const int nig = WGM * nN, gid = wgid / nig, fm = gid * WGM, gsz = (nM - fm) < WGM ? (nM - fm) : WGM;
        u.pm = fm + ((wgid % nig) % gsz); u.pn = (wgid % nig) / gsz; u.ks = 0; return true;
    }
    __device__ __forceinline__ void a_ready(const Unit&) const {}
    __device__ __forceinline__ void done(const Unit&) const {}
};

__device__ __forceinline__ unsigned cvt_pk_bf16(float lo, float hi) { unsigned r; asm volatile("v_cvt_pk_bf16_f32 %0, %1, %2" : "=v"(r) : "v"(lo), "v"(hi)); return r; }
typedef float f32x2 __attribute__((ext_vector_type(2)));
__device__ __forceinline__ f32x2 gelu_pk(f32x2 v) {
    const f32x2 av = __builtin_elementwise_abs(v), d = av * 0.2316418882f + 1.0f;
    f32x2 t; t.x = __builtin_amdgcn_rcpf(d.x); t.y = __builtin_amdgcn_rcpf(d.y);
    f32x2 q = t * 0.5307027145f + (-0.7265760135f); q = q * t + 0.7107068705f; q = q * t + (-0.142248368f); q = q * t + 0.127414796f; q = q * t;
    const f32x2 s = (v * v) * (-0.72134752044f);
    f32x2 e; e.x = __builtin_amdgcn_exp2f(s.x); e.y = __builtin_amdgcn_exp2f(s.y);
    const f32x2 m = v * (q * e), r = v - m;
    f32x2 o; o.x = v.x < 0.f ? m.x : r.x; o.y = v.y < 0.f ? m.y : r.y; return o;
}

template <int ACT  > struct EpiBf16 {
    static constexpr bool PERM = true, AFTER_DRAIN = false; static_assert(ACT == 0 || ACT == 1, "EpiBf16: ACT is 0 (none) or 1 (gelu_pk)");
    bf16_t* O; int ldc; const float* bias; int split_cols; size_t split_stride; float scale0;
    __device__ __forceinline__ void operator()(const f32x4 (&acc)[2][2][4][2], const Unit& u, int wr, int wc, int fr, int fq) const {
        const int row0 = u.pm * BM + wr * 64 + fr; int colt = u.pn * BM; bf16_t* base = O;
        float sc = 1.f; if (split_cols) { const int t = colt / split_cols; base += (size_t)t * split_stride; colt -= t * split_cols; if (t == 0) sc = scale0; }
        const int col0 = colt + wc * 32 + 8 * fq, bcol0 = u.pn * BM + wc * 32 + 8 * fq;
        f32x4 bv[2][2];
#pragma unroll
        for (int bj = 0; bj < 2; ++bj)
#pragma unroll
            for (int n = 0; n < 2; ++n) bv[bj][n] = bias ? *(const f32x4*)(bias + bcol0 + bj * HALF + 4 * n) : (f32x4){0.f, 0.f, 0.f, 0.f};
#pragma unroll
        for (int ai = 0; ai < 2; ++ai)
#pragma unroll
            for (int m = 0; m < 4; ++m) { bf16_t* rowp = base + (size_t)(row0 + ai * HALF + m * 16) * ldc + col0;
#pragma unroll
                for (int bj = 0; bj < 2; ++bj) { f32x4 v0 = acc[ai][bj][m][0] + bv[bj][0], v1 = acc[ai][bj][m][1] + bv[bj][1];
                    if (ACT == 1) { f32x2 a = gelu_pk((f32x2){v0[0], v0[1]}), b = gelu_pk((f32x2){v0[2], v0[3]}), c = gelu_pk((f32x2){v1[0], v1[1]}), d = gelu_pk((f32x2){v1[2], v1[3]});
                        v0 = (f32x4){a.x, a.y, b.x, b.y}; v1 = (f32x4){c.x, c.y, d.x, d.y}; }
                    v0 = v0 * sc; v1 = v1 * sc; u32x4 w; w.x = cvt_pk_bf16(v0[0], v0[1]); w.y = cvt_pk_bf16(v0[2], v0[3]); w.z = cvt_pk_bf16(v1[0], v1[1]); w.w = cvt_pk_bf16(v1[2], v1[3]);
                    *(u32x4*)(rowp + bj * HALF) = w; } }
    }
};
struct EpiF32 {
    static constexpr bool PERM = false, AFTER_DRAIN = false;
    float* O; int ldc;
    __device__ __forceinline__ void operator()(const f32x4 (&acc)[2][2][4][2], const Unit& u, int wr, int wc, int fr, int fq) const {
        const int row0 = u.pm * BM + wr * 64 + fr, col0 = u.pn * BM + wc * 32 + 4 * fq;
#pragma unroll
        for (int ai = 0; ai < 2; ++ai)
#pragma unroll
            for (int m = 0; m < 4; ++m) { float* rowp = O + (size_t)(row0 + ai * HALF + m * 16) * ldc + col0;
#pragma unroll
                for (int bj = 0; bj < 2; ++bj)
#pragma unroll
                    for (int n = 0; n < 2; ++n) *(f32x4*)(rowp + bj * HALF + n * 16) = acc[ai][bj][m][n]; }
    }
};
__device__ __forceinline__ f32x4 shfl4(f32x4 v, int src) { f32x4 r; r.x = __shfl(v.x, src); r.y = __shfl(v.y, src); r.z = __shfl(v.z, src); r.w = __shfl(v.w, src); return r; }
template <int N> __device__ __forceinline__ float dpp_ror(float v) { return __builtin_bit_cast(float, __builtin_amdgcn_mov_dpp(__builtin_bit_cast(int, v), 0x120 + N, 0xf, 0xf, true)); }
template <int N> __device__ __forceinline__ f32x4 ror4(f32x4 v) { f32x4 r; r.x = dpp_ror<N>(v.x); r.y = dpp_ror<N>(v.y); r.z = dpp_ror<N>(v.z); r.w = dpp_ror<N>(v.w); return r; }
template <int N> __device__ __forceinline__ float dpp_shr_old(float old, float v) { return __builtin_bit_cast(float, __builtin_amdgcn_update_dpp(__builtin_bit_cast(int, old), __builtin_bit_cast(int, v), 0x110 + N, 0xf, 0xf, false)); }
template <int N> __device__ __forceinline__ f32x4 shr4(f32x4 old, f32x4 v) { f32x4 r; r.x = dpp_shr_old<N>(old.x, v.x); r.y = dpp_shr_old<N>(old.y, v.y); r.z = dpp_shr_old<N>(old.z, v.z); r.w = dpp_shr_old<N>(old.w, v.w); return r; }
struct EpiUpGate {
    static constexpr bool PERM = true, AFTER_DRAIN = false;
    bf16_t* G; const float* cw; const float* st; float* nfp; float* nfs; float* edge; PG8_LAS float* eb;
    __device__ __forceinline__ void operator()(const f32x4 (&acc)[2][2][4][2], const Unit& u, int wr, int wc, int fr, int fq) const {
        const int lane = fq * 16 + fr;
        const int tc0 = wc * 32 + 8 * fq, j0 = u.pn * 128 + tc0;
        const int src1 = (lane & 48) | ((fr + 15) & 15), src2 = (lane & 48) | ((fr + 14) & 15);
        const bool sample = u.pm >= 64;
        PG8_LAS float* wl = eb + 2048;
        { const int t_ = (int)threadIdx.x; if (t_ < 256) { const int c_ = (t_ < 128 ? 0 : 2816 - 128) + u.pn * 128 + t_;
#pragma unroll
            for (int k = 0; k < 3; ++k) wl[k * 256 + t_] = cw[k * 5632 + c_]; } }
        if (!sample && fr >= 14) {
#pragma unroll
            for (int ai = 0; ai < 2; ++ai)
#pragma unroll
                for (int bj = 0; bj < 2; ++bj)
#pragma unroll
                    for (int n = 0; n < 2; ++n) *(PG8_LAS f32x4*)(eb + ((2 * ai + wr) * 2 + (fr - 14)) * 256 + 128 * bj + tc0 + 4 * n) = acc[ai][bj][3][n];
        }
        asm volatile("s_waitcnt lgkmcnt(0)" ::: "memory"); __builtin_amdgcn_s_barrier(); asm volatile("" ::: "memory");
#pragma unroll
        for (int ai = 0; ai < 2; ++ai) {
            const int blk = 2 * ai + wr;
#pragma unroll
            for (int m = 0; m < 4; ++m) {
                const int r = 128 * ai + 64 * wr + 16 * m + fr;
                int wo = tc0; asm volatile("" : "+v"(wo));
                f32x4 uu[2][2];
#pragma unroll
                for (int bj = 0; bj < 2; ++bj)
#pragma unroll
                    for (int n = 0; n < 2; ++n) {
                        const f32x4 x = acc[ai][bj][m][n];
                        f32x4 p1, p2;
                        if (!sample) {
                            if (m > 0) {
                                const f32x4 xp = acc[ai][bj][m > 0 ? m - 1 : 0][n];
                                p1 = shr4<1>(ror4<1>(xp), x); p2 = shr4<2>(ror4<2>(xp), x);
                            } else {
                                f32x4 b1 = (f32x4){0.f, 0.f, 0.f, 0.f}, b2 = b1;
                                if (blk > 0) { b1 = *(const PG8_LAS f32x4*)(eb + ((blk - 1) * 2 + 1) * 256 + 128 * bj + tc0 + 4 * n);
                                               b2 = *(const PG8_LAS f32x4*)(eb + ((blk - 1) * 2 + (fr == 0 ? 0 : 1)) * 256 + 128 * bj + tc0 + 4 * n); }
                                p1 = shr4<1>(b1, x); p2 = shr4<2>(b2, x);
                            }
                        } else {
                            const int srow = (u.pm - 64) * 256 + r, b = srow >> 2, t = fr & 3;
                            p1 = ror4<1>(x); p2 = ror4<2>(x);
                            const size_t so = (size_t)b * 2 * 5632 + bj * 2816 + j0 + 4 * n;
                            if (t < 2) { const f32x4 s0 = *(const f32x4*)(st + so), s1 = *(const f32x4*)(st + so + 5632);
                                if (t == 0) { p1 = s1; p2 = s0; } else { p2 = s1; } }
                            else *(f32x4*)(nfs + so + (size_t)(t - 2) * 5632) = x;
                        }
                        const PG8_LAS float* wp = wl + 128 * bj + wo + 4 * n;
                        uu[bj][n] = *(const PG8_LAS f32x4*)wp * p2 + *(const PG8_LAS f32x4*)(wp + 256) * p1 + *(const PG8_LAS f32x4*)(wp + 512) * x;
                    }
                float gv[8];
#pragma unroll
                for (int n = 0; n < 2; ++n)
#pragma unroll
                    for (int c = 0; c < 4; ++c) { const float a = uu[0][n][c], b = uu[1][n][c]; gv[n * 4 + c] = a * __builtin_amdgcn_rcpf(1.0f + __expf(-a)) * b; }
                u32x4 o; o.x = cvt_pk_bf16(gv[0], gv[1]); o.y = cvt_pk_bf16(gv[2], gv[3]); o.z = cvt_pk_bf16(gv[4], gv[5]); o.w = cvt_pk_bf16(gv[6], gv[7]);
                const bool deferred = (!sample) && (blk == 0) && (m == 0) && (fr < 2) && ((u.pm & 7) != 0);
                if (!deferred) *(u32x4*)(G + (size_t)(u.pm * BM + r) * 2816 + j0) = o;
            }
        }
        if (!sample) {
            float* eg = edge + (size_t)(u.pm * 22 + u.pn) * 1024;
            if (wr == 0 && fr < 2) {
#pragma unroll
                for (int bj = 0; bj < 2; ++bj)
#pragma unroll
                    for (int n = 0; n < 2; ++n) *(f32x4*)(eg + fr * 256 + 128 * bj + tc0 + 4 * n) = acc[0][bj][0][n];
            }
            if (wr == 1 && fr >= 14) {
#pragma unroll
                for (int bj = 0; bj < 2; ++bj)
#pragma unroll
                    for (int n = 0; n < 2; ++n) { *(f32x4*)(eg + (2 + fr - 14) * 256 + 128 * bj + tc0 + 4 * n) = acc[1][bj][3][n];
                        if ((u.pm & 7) == 7) *(f32x4*)(nfp + (size_t)((u.pm >> 3) * 2 + (fr - 14)) * 5632 + bj * 2816 + j0 + 4 * n) = acc[1][bj][3][n]; }
            }
        }
    }
};
struct PanelRms {
    unsigned* xbuf;
    unsigned* cnt;
    float eps;
    __device__ __forceinline__ void run(const f32x4 (&v)[2][2][4][2], const Unit& u, int wr, int wc, int fr, int fq, PG8_LAS unsigned char* lds, int wid, int lane) const {
        PG8_LAS float* P = (PG8_LAS float*)lds;
        PG8_LAS float* S = (PG8_LAS float*)(lds + 8192);
#pragma unroll
        for (int ai = 0; ai < 2; ++ai)
#pragma unroll
            for (int m = 0; m < 4; ++m) {
                float q = 0.f;
#pragma unroll
                for (int bj = 0; bj < 2; ++bj)
#pragma unroll
                    for (int n = 0; n < 2; ++n) { const f32x4 x = v[ai][bj][m][n]; q += (x[0] * x[0] + x[1] * x[1]) + (x[2] * x[2] + x[3] * x[3]); }
                q += __shfl_xor(q, 16); q += __shfl_xor(q, 32);
                if (fq == 0) P[(ai * HALF + wr * 64 + m * 16 + fr) * 4 + wc] = q;
            }
        asm volatile("s_waitcnt lgkmcnt(0)" ::: "memory"); __builtin_amdgcn_s_barrier(); asm volatile("" ::: "memory");
        const int row = wid * 32 + (lane & 31);
        if (lane < 32) {
            const float q = (P[row * 4 + 0] + P[row * 4 + 1]) + (P[row * 4 + 2] + P[row * 4 + 3]);
            __hip_atomic_store(xbuf + ((size_t)(u.pm * BM + row) * 4 + u.pn), __float_as_uint(q), __ATOMIC_RELAXED, __HIP_MEMORY_SCOPE_AGENT);
        }
        asm volatile("s_waitcnt vmcnt(0)" ::: "memory");
        if (lane == 0) __hip_atomic_fetch_add(cnt + 64 * u.pm, 1u, __ATOMIC_RELAXED, __HIP_MEMORY_SCOPE_AGENT);
        if (wid == 0) {
            unsigned spins = 0;
            for (;;) {
                if ((unsigned)__builtin_amdgcn_readfirstlane(__hip_atomic_load(cnt + 64 * u.pm, __ATOMIC_RELAXED, __HIP_MEMORY_SCOPE_AGENT)) >= 32u) break;
                if (++spins > (1u << 22)) break;
                __builtin_amdgcn_s_sleep(2);
            }
            __builtin_amdgcn_fence(__ATOMIC_ACQUIRE, "agent");
        }
        asm volatile("s_waitcnt vmcnt(0) lgkmcnt(0)" ::: "memory"); __builtin_amdgcn_s_barrier(); asm volatile("" ::: "memory");
        if (lane < 32) {
            const unsigned* slot = xbuf + (size_t)(u.pm * BM + row) * 4; float q = 0.f;
#pragma unroll
            for (int t = 0; t < 4; ++t) q += __uint_as_float(__hip_atomic_load(slot + t, __ATOMIC_RELAXED, __HIP_MEMORY_SCOPE_AGENT));
            S[row] = 1.0f / sqrtf(q * (1.0f / 1024.0f) + eps);
        }
        asm volatile("s_waitcnt lgkmcnt(0)" ::: "memory"); __builtin_amdgcn_s_barrier(); asm volatile("" ::: "memory");
    }
};
struct EpiMixNorm {
    static constexpr bool PERM = false, AFTER_DRAIN = true;
    const float* x; bf16_t* X1; bf16_t* H; const float* mod; const float* gpm; const float* gpf; PanelRms st1, st2;
    __device__ __forceinline__ void fused(f32x4 (&acc)[2][2][4][2], const Unit& u, int wr, int wc, int fr, int fq, PG8_LAS unsigned char* lds, int wid, int lane) const {
        typedef unsigned u32x2v __attribute__((ext_vector_type(2)));
        const PG8_LAS float* S = (const PG8_LAS float*)(lds + 8192);
        const float* md = mod + (size_t)(u.pm >> 3) * 6144;
        const int col0 = u.pn * BM + wc * 32 + 4 * fq;
        f32x4 pre[2][2][2];
#pragma unroll
        for (int m = 0; m < 2; ++m) { const size_t off = (size_t)(u.pm * BM + wr * 64 + m * 16 + fr) * 1024 + col0;
#pragma unroll
            for (int bj = 0; bj < 2; ++bj)
#pragma unroll
                for (int n = 0; n < 2; ++n) pre[m][bj][n] = *(const f32x4*)(x + off + bj * HALF + n * 16); }
        st1.run(acc, u, wr, wc, fr, fq, lds, wid, lane);
        f32x4 cf[2][2];
#pragma unroll
        for (int bj = 0; bj < 2; ++bj)
#pragma unroll
            for (int n = 0; n < 2; ++n) { const int c = col0 + bj * HALF + n * 16; cf[bj][n] = *(const f32x4*)(md + 2048 + c) * *(const f32x4*)(gpm + c); }
#pragma unroll
        for (int ai = 0; ai < 2; ++ai)
#pragma unroll
            for (int m = 0; m < 4; ++m) { const int r = ai * HALF + wr * 64 + m * 16 + fr; const float rs = S[r]; const size_t off = (size_t)(u.pm * BM + r) * 1024 + col0;
#pragma unroll
                for (int bj = 0; bj < 2; ++bj)
#pragma unroll
                    for (int n = 0; n < 2; ++n) { const f32x4 bs = (ai == 0 && m < 2) ? pre[m < 2 ? m : 0][bj][n] : *(const f32x4*)(x + off + bj * HALF + n * 16); acc[ai][bj][m][n] = bs + cf[bj][n] * (acc[ai][bj][m][n] * rs); }
                asm volatile("" : "+v"(acc[ai][0][m][0]), "+v"(acc[ai][0][m][1]), "+v"(acc[ai][1][m][0]), "+v"(acc[ai][1][m][1]));
                if (m & 1) asm volatile("" ::: "memory"); }
        st2.run(acc, u, wr, wc, fr, fq, lds, wid, lane);
        f32x4 c2[2][2], sh[2][2];
#pragma unroll
        for (int bj = 0; bj < 2; ++bj)
#pragma unroll
            for (int n = 0; n < 2; ++n) { const int c = col0 + bj * HALF + n * 16; c2[bj][n] = *(const f32x4*)(gpf + c) * (1.0f + *(const f32x4*)(md + 4096 + c)); sh[bj][n] = *(const f32x4*)(md + 3072 + c); }
#pragma unroll
        for (int ai = 0; ai < 2; ++ai)
#pragma unroll
            for (int m = 0; m < 4; ++m) { const int r = ai * HALF + wr * 64 + m * 16 + fr; const float rs = S[r]; const size_t off = (size_t)(u.pm * BM + r) * 1024 + col0;
#pragma unroll
                for (int bj = 0; bj < 2; ++bj)
#pragma unroll
                    for (int n = 0; n < 2; ++n) { const f32x4 x1 = acc[ai][bj][m][n]; { u32x2v w1; w1.x = cvt_pk_bf16(x1[0], x1[1]); w1.y = cvt_pk_bf16(x1[2], x1[3]); *(u32x2v*)(X1 + off + bj * HALF + n * 16) = w1; }
                        const f32x4 o = x1 * rs * c2[bj][n] + sh[bj][n]; u32x2v w; w.x = cvt_pk_bf16(o[0], o[1]); w.y = cvt_pk_bf16(o[2], o[3]);
                        *(u32x2v*)(H + off + bj * HALF + n * 16) = w; }
                asm volatile("" ::: "memory"); }
    }
};
struct EpiFfnNorm {
    static constexpr bool PERM = false, AFTER_DRAIN = true;
    const bf16_t* X1; float* Y; const float* mod; const float* gpo; PanelRms st;
    __device__ __forceinline__ void fused(f32x4 (&acc)[2][2][4][2], const Unit& u, int wr, int wc, int fr, int fq, PG8_LAS unsigned char* lds, int wid, int lane) const {
        typedef unsigned u32x2v __attribute__((ext_vector_type(2)));
        const PG8_LAS float* S = (const PG8_LAS float*)(lds + 8192);
        const float* md = mod + (size_t)(u.pm >> 3) * 6144;
        const int col0 = u.pn * BM + wc * 32 + 4 * fq;
        u32x2v pre[1][4][2][2];
#pragma unroll
        for (int ai = 0; ai < 1; ++ai)
#pragma unroll
            for (int m = 0; m < 4; ++m) { const size_t off = (size_t)(u.pm * BM + ai * HALF + wr * 64 + m * 16 + fr) * 1024 + col0;
#pragma unroll
                for (int bj = 0; bj < 2; ++bj)
#pragma unroll
                    for (int n = 0; n < 2; ++n) pre[ai][m][bj][n] = *(const u32x2v*)(X1 + off + bj * HALF + n * 16); }
        st.run(acc, u, wr, wc, fr, fq, lds, wid, lane);
        f32x4 cf[2][2];
#pragma unroll
        for (int bj = 0; bj < 2; ++bj)
#pragma unroll
            for (int n = 0; n < 2; ++n) { const int c = col0 + bj * HALF + n * 16; cf[bj][n] = *(const f32x4*)(md + 5120 + c) * *(const f32x4*)(gpo + c); }
#pragma unroll
        for (int ai = 0; ai < 2; ++ai)
#pragma unroll
            for (int m = 0; m < 4; ++m) { const int r = ai * HALF + wr * 64 + m * 16 + fr; const float rs = S[r]; const size_t off = (size_t)(u.pm * BM + r) * 1024 + col0;
#pragma unroll
                for (int bj = 0; bj < 2; ++bj)
#pragma unroll
                    for (int n = 0; n < 2; ++n) { const u32x2v p = ai == 0 ? pre[0][m][bj][n] : *(const u32x2v*)(X1 + off + bj * HALF + n * 16);
                        const f32x4 bs = (f32x4){__uint_as_float(p.x << 16), __uint_as_float(p.x & 0xffff0000u), __uint_as_float(p.y << 16), __uint_as_float(p.y & 0xffff0000u)};
                        *(f32x4*)(Y + off + bj * HALF + n * 16) = bs + cf[bj][n] * (acc[ai][bj][m][n] * rs); } }
    }
};
struct SliceOrder {
    int nN, nsl, c;
    __device__ bool next(int i, Unit& u) const { if (i != 0 || c >= 2 * nN * nsl) return false; u.ks = c % nsl; const int r = c / nsl; u.pn = r % nN; u.pm = 64 + r / nN; return true; }
    __device__ __forceinline__ void a_ready(const Unit&) const {}
    __device__ __forceinline__ void done(const Unit&) const {}
};
struct EpiF32Part {
    static constexpr bool PERM = false, AFTER_DRAIN = false;
    float* O; int ldc; size_t pstride;
    __device__ __forceinline__ void operator()(const f32x4 (&acc)[2][2][4][2], const Unit& u, int wr, int wc, int fr, int fq) const {
        const int row0 = (u.pm - 64) * BM + wr * 64 + fr, col0 = u.pn * BM + wc * 32 + 4 * fq;
        float* Ob = O + (size_t)u.ks * pstride;
#pragma unroll
        for (int ai = 0; ai < 2; ++ai)
#pragma unroll
            for (int m = 0; m < 4; ++m) { float* rowp = Ob + (size_t)(row0 + ai * HALF + m * 16) * ldc + col0;
#pragma unroll
                for (int bj = 0; bj < 2; ++bj)
#pragma unroll
                    for (int n = 0; n < 2; ++n) *(f32x4*)(rowp + bj * HALF + n * 16) = acc[ai][bj][m][n]; }
    }
};
struct UpOrder : StaticOrder {
    const unsigned* ready; unsigned need;
    __device__ __forceinline__ void a_ready(const Unit& u) const {
        if (u.pm < 64) return;
        if (threadIdx.x < 64) {
            unsigned spins = 0;
            while ((unsigned)__builtin_amdgcn_readfirstlane(__hip_atomic_load(ready, __ATOMIC_RELAXED, __HIP_MEMORY_SCOPE_AGENT)) < need) { if (++spins > (1u << 22)) break; __builtin_amdgcn_s_sleep(2); }
            __builtin_amdgcn_fence(__ATOMIC_ACQUIRE, "agent");
            asm volatile("s_waitcnt vmcnt(0)" ::: "memory");
        }
        asm volatile("" ::: "memory"); __builtin_amdgcn_s_barrier(); asm volatile("" ::: "memory");
    }
};
template <class Epi, class Sched, bool ALIGN_EPI = false, bool SP2 = false>
__device__ __forceinline__ void gemm_phase(PG8_LAS unsigned char* lds, const Gemm g, const Sched& S, const Epi& E) {
    const int tid = threadIdx.x, wid = __builtin_amdgcn_readfirstlane(tid >> 6), lane = tid & 63, wr = wid >> 2, wc = wid & 3, fr = lane & 15, fq = lane >> 4;
    const int K = g.P ? g.P : g.K, nt = g.K / BK;
    const size_t sstep = (size_t)g.K * 2;
    unsigned voffA[2], voffB[2];
#pragma unroll
    for (int i = 0; i < 2; ++i) { int R, C; stage_rc(tid * 16 + i * 8192, R, C); const int Rb = Epi::PERM ? ((R & ~31) + perm32(R & 31)) : R;
        voffA[i] = (unsigned)(R * K + C) * 2u; voffB[i] = (unsigned)(Rb * K + C) * 2u; }
    const size_t kstep = (size_t)(BK * 2);
    const size_t hstep = (size_t)HALF * K * 2;
    const size_t tstep = 2 * hstep;
    const unsigned ldsw = (unsigned)wid * 1024u;
    const int aoff = lds_byte(wr * 64 + fr, fq * 8), boff = lds_byte(wc * 32 + fr, fq * 8);
#define PG8_SA(b, h) (((b) * 2 + (h)) * HTB)
#define PG8_SB(b, h) ((4 + (b) * 2 + (h)) * HTB)
#define PG8_STAGE(bufoff, gbase, voff) do { _Pragma("unroll") for (int _i = 0; _i < 2; ++_i) \
        __builtin_amdgcn_global_load_lds((const unsigned*)((const char*)(gbase) + (voff)[_i]), (PG8_LAS unsigned*)(lds + (bufoff) + ldsw + _i * 8192), 16, 0, 0); } while (0)
#define PG8_LDA(dst, b, h) do { _Pragma("unroll") for (int m = 0; m < 4; ++m) _Pragma("unroll") for (int k = 0; k < 2; ++k) dst[m][k] = *(const PG8_LAS bf16x8*)(lds + PG8_SA(b, h) + aoff + m * 2048 + k * 1024); } while (0)
#define PG8_LDB(dst, b, h) do { _Pragma("unroll") for (int n = 0; n < 2; ++n) _Pragma("unroll") for (int k = 0; k < 2; ++k) dst[n][k] = *(const PG8_LAS bf16x8*)(lds + PG8_SB(b, h) + boff + n * 2048 + k * 1024); } while (0)
#define PG8_MMA(ai, bj, At, Bt) do { __builtin_amdgcn_s_setprio(1); _Pragma("unroll") for (int m = 0; m < 4; ++m) _Pragma("unroll") for (int n = 0; n < 2; ++n) _Pragma("unroll") for (int k = 0; k < 2; ++k) \
        acc[ai][bj][m][n] = __builtin_amdgcn_mfma_f32_16x16x32_bf16(Bt[n][k], At[m][k], acc[ai][bj][m][n], 0, 0, 0); __builtin_amdgcn_s_setprio(0); } while (0)
#define PG8_WAIT_V(n) asm volatile("s_waitcnt vmcnt(" #n ")" ::: "memory")
#define PG8_WAIT_L(n) asm volatile("s_waitcnt lgkmcnt(" #n ")" ::: "memory")
#define PG8_BAR __builtin_amdgcn_s_barrier()
#define PG8_SCHED __builtin_amdgcn_sched_barrier(0)
    Unit cur, nxt; int ui = 0;
    if (!S.next(0, cur)) return;
    f32x4 acc[2][2][4][2];
#pragma unroll
    for (int a = 0; a < 2; ++a)
#pragma unroll
        for (int b = 0; b < 2; ++b)
#pragma unroll
            for (int m = 0; m < 4; ++m)
#pragma unroll
                for (int n = 0; n < 2; ++n) acc[a][b][m][n] = (f32x4){0.f, 0.f, 0.f, 0.f};
    bf16x8 At[4][2], B0[2][2], B1[2][2];
    const char* cA = (const char*)g.A + (size_t)cur.pm * tstep + cur.ks * sstep; const char* cB = (const char*)g.Bt + (size_t)cur.pn * tstep + cur.ks * sstep;
    S.a_ready(cur);
    if constexpr (SP2) {
        PG8_STAGE(PG8_SB(0, 0), cB, voffB); PG8_STAGE(PG8_SB(0, 1), cB + hstep, voffB); PG8_STAGE(PG8_SA(0, 0), cA, voffA); PG8_STAGE(PG8_SA(0, 1), cA + hstep, voffA);
        if (wr == 1) PG8_BAR;
        PG8_WAIT_V(2); PG8_BAR;
        PG8_STAGE(PG8_SB(1, 0), cB + kstep, voffB); PG8_STAGE(PG8_SA(1, 0), cA + kstep, voffA); PG8_STAGE(PG8_SB(1, 1), cB + hstep + kstep, voffB);
        PG8_WAIT_V(6); PG8_BAR;
    } else {
        PG8_STAGE(PG8_SB(0, 0), cB, voffB); PG8_STAGE(PG8_SA(0, 0), cA, voffA); PG8_STAGE(PG8_SB(0, 1), cB + hstep, voffB); PG8_STAGE(PG8_SA(0, 1), cA + hstep, voffA);
        if (wr == 1) PG8_BAR;
        PG8_WAIT_V(4); PG8_BAR;
        PG8_STAGE(PG8_SB(1, 0), cB + kstep, voffB); PG8_STAGE(PG8_SA(1, 0), cA + kstep, voffA); PG8_STAGE(PG8_SB(1, 1), cB + hstep + kstep, voffB);
        PG8_WAIT_V(6); PG8_BAR;
    }
    for (;;) {
        const bool has_next = S.next(ui + 1, nxt);
        const char* nA = has_next ? (const char*)g.A + (size_t)nxt.pm * tstep + nxt.ks * sstep : cA; const char* nB = has_next ? (const char*)g.Bt + (size_t)nxt.pn * tstep + nxt.ks * sstep : cB;
        for (int t = 0; t < nt; t += 2) {
            const bool last = (t == nt - 2);
            const char* a1 = cA + (size_t)(t + 1) * kstep;
            const char* a2 = last ? nA : cA + (size_t)(t + 2) * kstep; const char* b2 = last ? nB : cB + (size_t)(t + 2) * kstep;
            const char* a3 = a2 + kstep; const char* b3 = b2 + kstep;
            if (last && has_next) S.a_ready(nxt);
            if constexpr (SP2) {
            PG8_LDB(B0, 0, 0); PG8_LDB(B1, 0, 1); PG8_SCHED; PG8_LDA(At, 0, 0); PG8_STAGE(PG8_SA(1, 1), a1 + hstep, voffA);
            PG8_WAIT_V(8); PG8_WAIT_L(0); PG8_BAR; PG8_MMA(0, 0, At, B0); PG8_MMA(0, 1, At, B1); PG8_BAR; PG8_SCHED;
            PG8_LDA(At, 0, 1); PG8_STAGE(PG8_SB(0, 0), b2, voffB); PG8_STAGE(PG8_SB(0, 1), b2 + hstep, voffB); PG8_STAGE(PG8_SA(0, 0), a2, voffA);
            PG8_WAIT_V(8); PG8_WAIT_L(0); PG8_BAR; PG8_MMA(1, 0, At, B0); PG8_MMA(1, 1, At, B1); PG8_BAR; PG8_SCHED;
            PG8_LDB(B0, 1, 0); PG8_LDB(B1, 1, 1); PG8_SCHED; PG8_LDA(At, 1, 0); PG8_STAGE(PG8_SA(0, 1), a2 + hstep, voffA);
            PG8_WAIT_V(8); PG8_WAIT_L(0); PG8_BAR; PG8_MMA(0, 0, At, B0); PG8_MMA(0, 1, At, B1); PG8_BAR; PG8_SCHED;
            PG8_LDA(At, 1, 1); PG8_STAGE(PG8_SB(1, 0), b3, voffB); PG8_STAGE(PG8_SB(1, 1), b3 + hstep, voffB); PG8_STAGE(PG8_SA(1, 0), a3, voffA);
            PG8_WAIT_V(8); PG8_WAIT_L(0); PG8_BAR; PG8_MMA(1, 0, At, B0); PG8_MMA(1, 1, At, B1); PG8_BAR; PG8_SCHED;
            } else {
            PG8_LDB(B0, 0, 0); PG8_SCHED; PG8_LDA(At, 0, 0); PG8_STAGE(PG8_SA(1, 1), a1 + hstep, voffA);
            PG8_WAIT_L(8); PG8_BAR; PG8_WAIT_L(0); PG8_MMA(0, 0, At, B0); PG8_BAR; PG8_SCHED;
            PG8_LDB(B1, 0, 1); PG8_STAGE(PG8_SB(0, 0), b2, voffB);
            PG8_BAR; PG8_WAIT_L(0); PG8_MMA(0, 1, At, B1); PG8_BAR;
            PG8_LDA(At, 0, 1); PG8_STAGE(PG8_SA(0, 0), a2, voffA);
            PG8_BAR; PG8_WAIT_L(0); PG8_MMA(1, 0, At, B0); PG8_BAR; PG8_SCHED;
            PG8_STAGE(PG8_SB(0, 1), b2 + hstep, voffB);
            PG8_WAIT_V(6); PG8_BAR; PG8_MMA(1, 1, At, B1); PG8_BAR;
            PG8_LDB(B0, 1, 0); PG8_SCHED; PG8_LDA(At, 1, 0); PG8_STAGE(PG8_SA(0, 1), a2 + hstep, voffA);
            PG8_WAIT_L(8); PG8_BAR; PG8_WAIT_L(0); PG8_MMA(0, 0, At, B0); PG8_BAR; PG8_SCHED;
            PG8_LDB(B1, 1, 1); PG8_STAGE(PG8_SB(1, 0), b3, voffB);
            PG8_BAR; PG8_WAIT_L(0); PG8_MMA(0, 1, At, B1); PG8_BAR;
            PG8_LDA(At, 1, 1); PG8_STAGE(PG8_SA(1, 0), a3, voffA);
            PG8_BAR; PG8_WAIT_L(0); PG8_MMA(1, 0, At, B0); PG8_BAR; PG8_SCHED;
            PG8_STAGE(PG8_SB(1, 1), b3 + hstep, voffB);
            PG8_WAIT_V(6); PG8_BAR; PG8_MMA(1, 1, At, B1); PG8_BAR;
            }
        }
        if constexpr (ALIGN_EPI) { if (wr == 0) PG8_BAR; }
        if constexpr (!Epi::AFTER_DRAIN) { E(acc, cur, wr, wc, fr, fq); S.done(cur); }
        if (!has_next) break;
#pragma unroll
        for (int a = 0; a < 2; ++a)
#pragma unroll
            for (int b = 0; b < 2; ++b)
#pragma unroll
                for (int m = 0; m < 4; ++m)
#pragma unroll
                    for (int n = 0; n < 2; ++n) acc[a][b][m][n] = (f32x4){0.f, 0.f, 0.f, 0.f};
        cur = nxt; cA = nA; cB = nB; ++ui;
        if constexpr (ALIGN_EPI) { if (wr == 1) PG8_BAR; }
    }
    PG8_WAIT_V(0);
    if constexpr (!ALIGN_EPI) { if (wr == 0) PG8_BAR; }
    PG8_BAR;
    if constexpr (Epi::AFTER_DRAIN) { E.fused(acc, cur, wr, wc, fr, fq, lds, wid, lane); S.done(cur); }
#undef PG8_SA
#undef PG8_SB
#undef PG8_STAGE
#undef PG8_LDA
#undef PG8_LDB
#undef PG8_MMA
#undef PG8_WAIT_V
#undef PG8_WAIT_L
#undef PG8_BAR
#undef PG8_SCHED
}
}
#define LAS __attribute__((address_space(3)))
typedef unsigned short bf16;
typedef unsigned v4u __attribute__((ext_vector_type(4)));
typedef unsigned v2u __attribute__((ext_vector_type(2)));
typedef float f32x4 __attribute__((ext_vector_type(4)));
typedef float f32x2v __attribute__((ext_vector_type(2)));
typedef short bf16x8 __attribute__((ext_vector_type(8)));
#ifndef REPMASK
#define REPMASK 0
#endif
#ifndef MK_COOP
#define MK_COOP 1
#endif
constexpr int NWAVES = 8, NPHASE = 10;
constexpr int MP = 16384, MS = 512, M = MP + MS, D = 1024, DIN = 2048, DFF = 2816, DUP = 5632, NBATCH = 136, NMOD = 6144;
constexpr float EPS = 1e-6f;
constexpr size_t MiB = 1u << 20;
constexpr size_t WS_CTL = 0, CTL_ZERO_BYTES = 1 * MiB, WS_MOD = 1 * MiB, WS_WIN = 5 * MiB, WS_WOUT = 9 * MiB, WS_WUP = 11 * MiB, WS_WDN = 22 * MiB, WS_EDGE = 28 * MiB,
                 WS_H = 34 * MiB, WS_DY = 67 * MiB, WS_PROJ = 100 * MiB, WS_MIX = 100 * MiB, WS_G = 67 * MiB, WS_F = 160 * MiB, WS_XB = 228 * MiB, WS_PART = 200 * MiB  , WS_X1 = 168 * MiB  , WS_END = 256 * MiB;
constexpr int CNT_BANK_WORDS = 64 * 64;
constexpr size_t O_Y = 0, O_NPP = 17301504, O_NCP = 17362944, O_NFP = 17371136, O_NPS = 17461248, O_NCS = 18444288, O_NFS = 18575360, O_END = 20017152;
constexpr int RING_BYTES = 131072, EB_OFF = 131072, LDS_BYTES = 147456;
#define LDS_WAIT() asm volatile("s_waitcnt lgkmcnt(0)" ::: "memory")

__device__ __forceinline__ unsigned f2bf(float f) { unsigned u = __builtin_bit_cast(unsigned, f); return (u + 0x7fffu + ((u >> 16) & 1u)) >> 16; }
__device__ __forceinline__ unsigned pk2(float lo, float hi) { unsigned r; asm("v_cvt_pk_bf16_f32 %0, %1, %2" : "=v"(r) : "v"(lo), "v"(hi)); return r; }
__device__ __forceinline__ void unpack8(v4u v, float (&f)[8]) {
    f[0] = __builtin_bit_cast(float, v.x << 16); f[1] = __builtin_bit_cast(float, v.x & 0xffff0000u);
    f[2] = __builtin_bit_cast(float, v.y << 16); f[3] = __builtin_bit_cast(float, v.y & 0xffff0000u);
    f[4] = __builtin_bit_cast(float, v.z << 16); f[5] = __builtin_bit_cast(float, v.z & 0xffff0000u);
    f[6] = __builtin_bit_cast(float, v.w << 16); f[7] = __builtin_bit_cast(float, v.w & 0xffff0000u);
}
__device__ __forceinline__ v4u pack8(const float (&f)[8]) { v4u o; o.x = pk2(f[0], f[1]); o.y = pk2(f[2], f[3]); o.z = pk2(f[4], f[5]); o.w = pk2(f[6], f[7]); return o; }
__device__ __forceinline__ float wave_sum(float v) {
#pragma unroll
    for (int o = 1; o < 64; o <<= 1) v += __shfl_xor(v, o);
    return v;
}
__device__ __forceinline__ float silu_f(float a) { return a * __builtin_amdgcn_rcpf(1.0f + __expf(-a)); }

struct Args { const float* in[21]; float* out; unsigned char* ws; int ph_lo, ph_hi; };
enum { I_XP = 0, I_XS, I_SPOOL, I_SCONV, I_SFFN, I_CP, I_CS, I_WADA, I_BADA, I_GPREMIX, I_GPOSTMIX, I_GPREFFN, I_GPOSTFFN, I_WIN, I_POOLW, I_POOLS, I_CONVW, I_WOUT, I_WUP, I_FCONVW, I_WDN };

__device__ __forceinline__ const float* xrow(const Args& a, int m) { return m < MP ? a.in[I_XP] + (size_t)m * D : a.in[I_XS] + (size_t)(m - MP) * D; }
__device__ __forceinline__ int batch_of(int m) { return m < MP ? (m >> 11) : 8 + ((m - MP) >> 2); }

__device__ __forceinline__ void tr_item(const float* W, int ldw, int k0, int n0, bf16* WT, int ldt, int drow0, int dk0, LAS float* scr, int lane) {
    float tv[64];
#pragma unroll
    for (int i = 0; i < 64; ++i) tv[i] = W[(size_t)(k0 + i) * ldw + n0 + lane];
    __builtin_amdgcn_sched_barrier(0);
#pragma unroll
    for (int i = 0; i < 64; ++i) scr[i * 65 + lane] = tv[i];
    LDS_WAIT(); asm volatile("" ::: "memory");
    const int c = lane & 7;
#pragma unroll
    for (int j = 0; j < 8; ++j) { const int n = (lane >> 3) + 8 * j; const LAS float* sp = scr + (8 * c) * 65 + n;
        v4u o; o.x = pk2(sp[0 * 65], sp[1 * 65]); o.y = pk2(sp[2 * 65], sp[3 * 65]); o.z = pk2(sp[4 * 65], sp[5 * 65]); o.w = pk2(sp[6 * 65], sp[7 * 65]);
        *(v4u*)(WT + (size_t)(drow0 + n) * ldt + dk0 + 8 * c) = o; }
    LDS_WAIT(); asm volatile("" ::: "memory");
}

__device__ __forceinline__ void weight_items(const Args& a, LAS unsigned char* lds, int lane, int wave, int it0, int step, int cnt, int lim);
__device__ __forceinline__ void p0_prologue(const Args& a, LAS unsigned char* lds, int tid, int lane, int wave) {
    unsigned char* ws = a.ws;
    bf16* Win_t = (bf16*)(ws + WS_WIN); bf16* Wout_t = (bf16*)(ws + WS_WOUT); bf16* Wup_t = (bf16*)(ws + WS_WUP); bf16* Wdn_t = (bf16*)(ws + WS_WDN);
    float* mod = (float*)(ws + WS_MOD);
    const int G = gridDim.x, gw = blockIdx.x * NWAVES + wave, NGW = G * NWAVES;
    for (int i = blockIdx.x * 512 + tid; i < 16384; i += G * 512) ((unsigned*)(ws + WS_CTL))[i] = 0u;
    {
        LAS float* red = (LAS float*)lds;
        const int fr = lane & 15, fq = lane >> 4;
        for (int wi = blockIdx.x; wi < NMOD / 32; wi += G) {
            const int n0 = wi * 32, kb = wave * 128 + fq * 8;
            f32x4 acc[9][2];
#pragma unroll
            for (int rb = 0; rb < 9; ++rb) { acc[rb][0] = (f32x4){0.f, 0.f, 0.f, 0.f}; acc[rb][1] = acc[rb][0]; }
            LAS unsigned char* sa = lds + 32768 + wave * 12288;
            const int arow = lane >> 3, akk = (lane & 7) * 4;
            f32x2v wn[8];
#pragma unroll
            for (int i = 0; i < 8; ++i) wn[i] = *(const f32x2v*)(a.in[I_WADA] + (size_t)(kb + i) * NMOD + n0 + 2 * fr);
#pragma unroll 1
            for (int ks = 0; ks < 4; ++ks) {
                float wv[2][8];
#pragma unroll
                for (int i = 0; i < 8; ++i) { wv[0][i] = wn[i].x; wv[1][i] = wn[i].y; }
                { const int k1 = kb + (ks < 3 ? ks + 1 : 3) * 32;
#pragma unroll
                  for (int i = 0; i < 8; ++i) wn[i] = *(const f32x2v*)(a.in[I_WADA] + (size_t)(k1 + i) * NMOD + n0 + 2 * fr); }
                f32x4 cl[18];
#pragma unroll
                for (int j = 0; j < 18; ++j) { int row = 8 * j + arow; row = row < NBATCH ? row : NBATCH - 1;
                    cl[j] = *(const f32x4*)((row < 8 ? a.in[I_CP] + (size_t)row * D : a.in[I_CS] + (size_t)(row - 8) * D) + wave * 128 + ks * 32 + akk); }
                __builtin_amdgcn_sched_barrier(0);
#pragma unroll
                for (int j = 0; j < 18; ++j) { v2u w; w.x = pk2(silu_f(cl[j].x), silu_f(cl[j].y)); w.y = pk2(silu_f(cl[j].z), silu_f(cl[j].w));
                    *(LAS v2u*)(sa + (8 * j + arow) * 80 + akk * 2) = w; }
                const bf16x8 b0 = __builtin_bit_cast(bf16x8, pack8(wv[0])), b1 = __builtin_bit_cast(bf16x8, pack8(wv[1]));
                LDS_WAIT(); asm volatile("" ::: "memory");
#pragma unroll
                for (int rb = 0; rb < 9; ++rb) {
                    const bf16x8 af = *(const LAS bf16x8*)(sa + (rb * 16 + fr) * 80 + fq * 16);
                    acc[rb][0] = __builtin_amdgcn_mfma_f32_16x16x32_bf16(b0, af, acc[rb][0], 0, 0, 0);
                    acc[rb][1] = __builtin_amdgcn_mfma_f32_16x16x32_bf16(b1, af, acc[rb][1], 0, 0, 0);
                }
                LDS_WAIT(); asm volatile("" ::: "memory");
            }
            __syncthreads();
#pragma unroll
            for (int st = 4; st >= 1; st >>= 1) {
                LAS float* slot = (LAS float*)(lds + 32768) + (wave & (st - 1)) * (18 * 256);
                if (wave >= st && wave < 2 * st) {
#pragma unroll
                    for (int rb = 0; rb < 9; ++rb)
#pragma unroll
                        for (int cb = 0; cb < 2; ++cb)
#pragma unroll
                            for (int e = 0; e < 4; ++e) slot[((rb * 2 + cb) * 4 + e) * 64 + lane] = acc[rb][cb][e];
                }
                __syncthreads();
                if (wave < st) {
#pragma unroll
                    for (int rb = 0; rb < 9; ++rb)
#pragma unroll
                        for (int cb = 0; cb < 2; ++cb)
#pragma unroll
                            for (int e = 0; e < 4; ++e) acc[rb][cb][e] += slot[((rb * 2 + cb) * 4 + e) * 64 + lane];
                }
                __syncthreads();
            }
            if (wave == 0) {
#pragma unroll
                for (int rb = 0; rb < 9; ++rb) { const int row = rb * 16 + fr, col = n0 + 8 * fq;
                    const f32x4 lo = (f32x4){acc[rb][0][0], acc[rb][1][0], acc[rb][0][1], acc[rb][1][1]} + *(const f32x4*)(a.in[I_BADA] + col);
                    const f32x4 hi = (f32x4){acc[rb][0][2], acc[rb][1][2], acc[rb][0][3], acc[rb][1][3]} + *(const f32x4*)(a.in[I_BADA] + col + 4);
                    if (row < NBATCH) { *(f32x4*)(mod + (size_t)row * NMOD + col) = lo; *(f32x4*)(mod + (size_t)row * NMOD + col + 4) = hi; } }
            }
            __syncthreads();
        }
    }
    if (G == 256) { if (blockIdx.x >= 192) weight_items(a, lds, lane, wave, ((int)blockIdx.x - 192) * 8 + wave, 512, 6, 2688); }
    else weight_items(a, lds, lane, wave, gw, NGW, (4800 + NGW - 1) / NGW, 4800);
}

__device__ __forceinline__ void weight_items(const Args& a, LAS unsigned char* lds, int lane, int wave, int it0, int step, int cnt, int lim) {
    unsigned char* ws = a.ws;
    bf16* Win_t = (bf16*)(ws + WS_WIN); bf16* Wout_t = (bf16*)(ws + WS_WOUT); bf16* Wup_t = (bf16*)(ws + WS_WUP); bf16* Wdn_t = (bf16*)(ws + WS_WDN);
    LAS float* scr = (LAS float*)(lds + wave * 17408);
    constexpr int I_FOLD = 2048, I_IN = 16 * 32, I_OUT = 8 * 16, I_UP = 16 * 88;
        for (int ii = 0; ii < cnt; ++ii) {
            int r = it0 + ii * step; if (r >= lim) break;
            if (r < I_FOLD) {
                const int k0 = (r >> 6) * 16, n0 = (r & 63) * 16, gb = (k0 >> 7) * 128, rr = lane & 15, q = lane >> 4;
                f32x4 pw[8], ps[8]; float wo[32];
                const f32x4* pwp = (const f32x4*)(a.in[I_POOLW] + (size_t)(k0 + rr) * 128 + q * 32); const f32x4* psp = (const f32x4*)(a.in[I_POOLS] + gb + q * 32);
#pragma unroll
                for (int i = 0; i < 8; ++i) { pw[i] = pwp[i]; ps[i] = psp[i]; }
#pragma unroll
                for (int sidx = 0; sidx < 32; ++sidx) wo[sidx] = a.in[I_WOUT][(size_t)(gb + q * 32 + sidx) * D + n0 + rr];
                __builtin_amdgcn_sched_barrier(0);
                f32x4 acc = (f32x4){0.f, 0.f, 0.f, 0.f};
#pragma unroll
                for (int sidx = 0; sidx < 32; ++sidx) acc = __builtin_amdgcn_mfma_f32_16x16x4f32(pw[sidx >> 2][sidx & 3], ps[sidx >> 2][sidx & 3] * wo[sidx], acc, 0, 0, 0);
                v2u o; o.x = pk2(acc[0], acc[1]); o.y = pk2(acc[2], acc[3]);
                *(v2u*)(Wout_t + (size_t)(n0 + rr) * D + k0 + 4 * q) = o;
                continue;
            } r -= I_FOLD;
            if (r < I_IN) { const int kb = r / 32, nb = r % 32; tr_item(a.in[I_WIN], DIN, 64 * kb, 64 * nb, Win_t, D, 64 * nb, 64 * kb, scr, lane); continue; } r -= I_IN;
            if (r < I_OUT) { const int kb = r / 16, nb = r % 16; tr_item(a.in[I_WOUT] + (size_t)512 * D, D, 64 * kb, 64 * nb, Wout_t, D, 64 * nb, 512 + 64 * kb, scr, lane); continue; } r -= I_OUT;
            if (r < I_UP) { const int kb = r / 88, nb = r % 88, n0 = 64 * nb;
                const int drow0 = n0 < DFF ? (n0 / 128) * 256 + (n0 % 128) : ((n0 - DFF) / 128) * 256 + 128 + ((n0 - DFF) % 128);
                tr_item(a.in[I_WUP], DUP, 64 * kb, n0, Wup_t, D, drow0, 64 * kb, scr, lane); continue; } r -= I_UP;
            { const int kb = r / 16, nb = r % 16; tr_item(a.in[I_WDN], D, 64 * kb, 64 * nb, Wdn_t, DFF, 64 * nb, 64 * kb, scr, lane); }
        }
}

__device__ __forceinline__ void p1_norm(const Args& a, int lane, int wave) {
    bf16* H = (bf16*)(a.ws + WS_H); const float* mod = (const float*)(a.ws + WS_MOD);
    const int gw = blockIdx.x * NWAVES + wave, NGW = gridDim.x * NWAVES;
    for (int mb = gw; mb < M; mb += 4 * NGW) {
        f32x4 v[4][4];
#pragma unroll
        for (int r = 0; r < 4; ++r) { const int m = mb + r * NGW; const float* xr = xrow(a, m < M ? m : mb);
#pragma unroll
            for (int j = 0; j < 4; ++j) v[r][j] = *(const f32x4*)(xr + 4 * lane + 256 * j); }
        __builtin_amdgcn_sched_barrier(0);
#pragma unroll
        for (int r = 0; r < 4; ++r) {
            const int m = mb + r * NGW; if (m >= M) break;
            const float* md = mod + (size_t)batch_of(m) * NMOD;
            float ss = 0.f;
#pragma unroll
            for (int j = 0; j < 4; ++j) ss += (v[r][j].x * v[r][j].x + v[r][j].y * v[r][j].y) + (v[r][j].z * v[r][j].z + v[r][j].w * v[r][j].w);
            const float rstd = 1.0f / sqrtf(wave_sum(ss) * (1.0f / D) + EPS);
#pragma unroll
            for (int j = 0; j < 4; ++j) { const int col = 4 * lane + 256 * j;
                const f32x4 g = *(const f32x4*)(a.in[I_GPREMIX] + col), sc = *(const f32x4*)(md + 1024 + col), sh = *(const f32x4*)(md + col);
                const f32x4 o = v[r][j] * rstd * g * (1.0f + sc) + sh;
                v2u w; w.x = pk2(o.x, o.y); w.y = pk2(o.z, o.w); *(v2u*)(H + (size_t)m * D + col) = w; }
        }
    }
}

__device__ __forceinline__ void ldpart8(const float* part, size_t sstride, int nsl, size_t off, float (&v)[8]) {
    f32x4 a = (f32x4){0.f, 0.f, 0.f, 0.f}, b = a;
    for (int sl = 0; sl < nsl; ++sl) { a += *(const f32x4*)(part + sl * sstride + off); b += *(const f32x4*)(part + sl * sstride + off + 4); }
    v[0] = a.x; v[1] = a.y; v[2] = a.z; v[3] = a.w; v[4] = b.x; v[5] = b.y; v[6] = b.z; v[7] = b.w;
}
__device__ __forceinline__ void st8(float* o, const float (&v)[8]) { *(f32x4*)o = (f32x4){v[0], v[1], v[2], v[3]}; *(f32x4*)(o + 4) = (f32x4){v[4], v[5], v[6], v[7]}; }
__device__ __forceinline__ void ld8(const float* p, float (&v)[8]) { const f32x4 a = *(const f32x4*)p, b = *(const f32x4*)(p + 4); v[0] = a.x; v[1] = a.y; v[2] = a.z; v[3] = a.w; v[4] = b.x; v[5] = b.y; v[6] = b.z; v[7] = b.w; }
template <int W>
__device__ __forceinline__ void pool_pair(const bf16* PROJ, bf16* DY, float* npp, const int (&rows)[2], int j0, bool hasB) {
    v4u cv[2], hv[2][W - 1];
#pragma unroll
    for (int r = 0; r < 2; ++r) { const int t = rows[r] & 2047; const bf16* pr = PROJ + (size_t)rows[r] * DIN + j0; cv[r] = *(const v4u*)pr;
#pragma unroll
        for (int i = 1; i < W; ++i) hv[r][i - 1] = *(const v4u*)(pr - (size_t)(i <= t ? i : 0) * DIN); }
    __builtin_amdgcn_sched_barrier(0);
#pragma unroll
    for (int r = 0; r < 2; ++r) { if (r == 1 && !hasB) break;
        const int m = rows[r], b = m >> 11, t = m & 2047; float cur[8], s[8];
        unpack8(cv[r], cur);
#pragma unroll
        for (int e = 0; e < 8; ++e) s[e] = cur[e];
#pragma unroll
        for (int i = 1; i < W; ++i) { float tmp[8]; unpack8(hv[r][i - 1], tmp);
#pragma unroll
            for (int e = 0; e < 8; ++e) s[e] += (i <= t) ? tmp[e] : 0.f; }
        const float inv = 1.0f / (float)((t + 1) < W ? (t + 1) : W); float d[8];
        if (t >= 2033) st8(npp + (size_t)(b * 15 + (t - 2033)) * 512 + j0, cur);
#pragma unroll
        for (int e = 0; e < 8; ++e) d[e] = s[e] * inv - cur[e];
        *(v4u*)(DY + (size_t)m * D + j0) = pack8(d); }
}
__device__ __forceinline__ void p3_mixer(const Args& a, int tid) {
    const bf16* PROJ = (const bf16*)(a.ws + WS_PROJ); bf16* DY = (bf16*)(a.ws + WS_DY);
    const float* PART = (const float*)(a.ws + WS_PART); constexpr size_t PS = (size_t)MS * DIN;
    float* npp = a.out + O_NPP; float* ncp = a.out + O_NCP; float* nps = a.out + O_NPS; float* ncs = a.out + O_NCS;
    const long NT = (long)gridDim.x * 512;
    for (long it = (long)blockIdx.x * 512 + tid; it < (long)MP * 128; it += 2 * NT) {
        const int q = (int)(it & 127), mA = (int)(it >> 7); const bool hasB = (it + NT) < (long)MP * 128; const int mB = hasB ? (int)((it + NT) >> 7) : mA;
        const int mm[2] = {mA, mB};
        if (q < 64) {
            const int g = mA & 3, j0 = g * 128 + (q & 15) * 8;
            const int rows[2] = {(mA & ~3) + (q >> 4), (mB & ~3) + (q >> 4)};
            if (g == 0) pool_pair<2>(PROJ, DY, npp, rows, j0, hasB);
            else if (g == 1) pool_pair<4>(PROJ, DY, npp, rows, j0, hasB);
            else if (g == 2) pool_pair<8>(PROJ, DY, npp, rows, j0, hasB);
            else pool_pair<16>(PROJ, DY, npp, rows, j0, hasB);
        } else {
            const int j0 = 8 * (q - 64);
            v4u rx[2][3], rc[2][3], rb[2];
#pragma unroll
            for (int r = 0; r < 2; ++r) { const int t = mm[r] & 2047; const bf16* pr = PROJ + (size_t)mm[r] * DIN + j0; rb[r] = *(const v4u*)(pr + 1024);
#pragma unroll
                for (int k = 0; k < 3; ++k) { const int kk = t >= k ? k : 0; rx[r][k] = *(const v4u*)(pr - (size_t)kk * DIN + 512); rc[r][k] = *(const v4u*)(pr - (size_t)kk * DIN + 1536); } }
            const float* cwp = a.in[I_CONVW] + j0; float w0[8], w1[8], w2[8];
            ld8(cwp, w0); ld8(cwp + 512, w1); ld8(cwp + 1024, w2);
            __builtin_amdgcn_sched_barrier(0);
#pragma unroll
            for (int r = 0; r < 2; ++r) { if (r == 1 && !hasB) break;
                const int m = mm[r], b = m >> 11, t = m & 2047; float bv[8], cx[3][8], y[8];
                unpack8(rb[r], bv);
#pragma unroll
                for (int k = 0; k < 3; ++k) { float x2[8], c2[8]; unpack8(rx[r][k], x2); unpack8(rc[r][k], c2);
#pragma unroll
                    for (int e = 0; e < 8; ++e) cx[k][e] = t >= k ? c2[e] * x2[e] : 0.f; }
#pragma unroll
                for (int e = 0; e < 8; ++e) y[e] = bv[e] * (w0[e] * cx[2][e] + w1[e] * cx[1][e] + w2[e] * cx[0][e]);
                *(v4u*)(DY + (size_t)m * D + 512 + j0) = pack8(y);
                if (t >= 2046) st8(ncp + (size_t)(b * 2 + t - 2046) * 512 + j0, cx[0]); }
        }
    }
    for (long it = (long)MP * 128 + (long)blockIdx.x * 512 + tid; it < (long)M * 128; it += NT) {
        const int m = (int)(it >> 7), q = (int)(it & 127);
        {
            const int sr = m - MP, b = sr >> 2, t = sr & 3;
            if (q < 64) {
                const int j0 = 8 * q, w = 2 << (j0 >> 7);
                float cur[8], s[8];
                ldpart8(PART, PS, 4, (size_t)sr * DIN + j0, cur);
#pragma unroll
                for (int e = 0; e < 8; ++e) s[e] = cur[e];
                for (int i = 1; i < w; ++i) { float tmp[8];
                    if (t - i >= 0) ldpart8(PART, PS, 4, (size_t)(sr - i) * DIN + j0, tmp); else ld8(a.in[I_SPOOL] + (size_t)(b * 15 + 15 + t - i) * 512 + j0, tmp);
#pragma unroll
                    for (int e = 0; e < 8; ++e) s[e] += tmp[e]; }
                st8(nps + (size_t)(b * 15 + 11 + t) * 512 + j0, cur);
                for (int i = t; i < 11; i += 4) { float tmp[8]; ld8(a.in[I_SPOOL] + (size_t)(b * 15 + i + 4) * 512 + j0, tmp); st8(nps + (size_t)(b * 15 + i) * 512 + j0, tmp); }
                const float inv = 1.0f / (float)w; float d[8];
#pragma unroll
                for (int e = 0; e < 8; ++e) d[e] = s[e] * inv - cur[e];
                *(v4u*)(DY + (size_t)m * D + j0) = pack8(d);
            } else {
                const int j0 = 8 * (q - 64);
                float xv[8], bv[8], cv[8], cx[3][8];
                ldpart8(PART, PS, 4, (size_t)sr * DIN + 1024 + j0, bv);
#pragma unroll
                for (int k = 0; k < 3; ++k) {
                    if (t - k >= 0) { ldpart8(PART, PS, 4, (size_t)(sr - k) * DIN + 512 + j0, xv); ldpart8(PART, PS, 4, (size_t)(sr - k) * DIN + 1536 + j0, cv);
#pragma unroll
                        for (int e = 0; e < 8; ++e) cx[k][e] = cv[e] * xv[e]; }
                    else ld8(a.in[I_SCONV] + (size_t)(b * 2 + 2 + t - k) * 512 + j0, cx[k]);
                }
                const float* cwp = a.in[I_CONVW] + j0; float w0[8], w1[8], w2[8], y[8];
                ld8(cwp, w0); ld8(cwp + 512, w1); ld8(cwp + 1024, w2);
#pragma unroll
                for (int e = 0; e < 8; ++e) y[e] = bv[e] * (w0[e] * cx[2][e] + w1[e] * cx[1][e] + w2[e] * cx[0][e]);
                *(v4u*)(DY + (size_t)m * D + 512 + j0) = pack8(y);
                if (t >= 2) st8(ncs + (size_t)(b * 2 + t - 2) * 512 + j0, cx[0]);
            }
        }
    }
}

__device__ __forceinline__ void p5_rowwise1(const Args& a, int lane, int wave, unsigned* done_cnt) {
    const float* MIX = (const float*)(a.ws + WS_MIX); bf16* H = (bf16*)(a.ws + WS_H); const float* mod = (const float*)(a.ws + WS_MOD); float* Y = a.out + O_Y;
    const int gw = blockIdx.x * NWAVES + wave, NGW = gridDim.x * NWAVES;
    int m0 = MP + gw, mstep = NGW;
    if (gridDim.x == 256) { m0 = blockIdx.x >= 192 ? MP + ((int)blockIdx.x - 192) * NWAVES + wave : M; mstep = M; }
    for (int m = m0; m < M; m += mstep) {
        const float* xr = xrow(a, m); const float* md = mod + (size_t)batch_of(m) * NMOD; const float* mr = (const float*)(a.ws + WS_PART) + (size_t)(m - MP) * D;
        f32x4 v[4]; float ss = 0.f;
#pragma unroll
        for (int j = 0; j < 4; ++j) { v[j] = (*(const f32x4*)(mr + 4 * lane + 256 * j) + *(const f32x4*)(mr + (size_t)MS * D + 4 * lane + 256 * j)) + (*(const f32x4*)(mr + 2 * (size_t)MS * D + 4 * lane + 256 * j) + *(const f32x4*)(mr + 3 * (size_t)MS * D + 4 * lane + 256 * j)); ss += (v[j].x * v[j].x + v[j].y * v[j].y) + (v[j].z * v[j].z + v[j].w * v[j].w); }
        const float r1 = 1.0f / sqrtf(wave_sum(ss) * (1.0f / D) + EPS);
        float s2 = 0.f;
#pragma unroll
        for (int j = 0; j < 4; ++j) { const int col = 4 * lane + 256 * j;
            const f32x4 x = *(const f32x4*)(xr + col), g = *(const f32x4*)(a.in[I_GPOSTMIX] + col), gt = *(const f32x4*)(md + 2048 + col);
            v[j] = x + gt * (v[j] * r1 * g);
            *(f32x4*)(Y + (size_t)m * D + col) = v[j];
            s2 += (v[j].x * v[j].x + v[j].y * v[j].y) + (v[j].z * v[j].z + v[j].w * v[j].w); }
        const float r2 = 1.0f / sqrtf(wave_sum(s2) * (1.0f / D) + EPS);
#pragma unroll
        for (int j = 0; j < 4; ++j) { const int col = 4 * lane + 256 * j;
            const f32x4 g = *(const f32x4*)(a.in[I_GPREFFN] + col), sc = *(const f32x4*)(md + 4096 + col), sh = *(const f32x4*)(md + 3072 + col);
            const f32x4 o = v[j] * r2 * g * (1.0f + sc) + sh;
            v2u w; w.x = pk2(o.x, o.y); w.y = pk2(o.z, o.w); *(v2u*)(H + (size_t)m * D + col) = w; }
        __threadfence();
        if (lane == 0) __hip_atomic_fetch_add(done_cnt, 1u, __ATOMIC_RELAXED, __HIP_MEMORY_SCOPE_AGENT);
    }
}

__device__ __forceinline__ void fixup_tile(const Args& a, int pm, int tid) {
    if ((pm & 7) == 0 || pm >= 64) return;
    const float* edge = (const float*)(a.ws + WS_EDGE); bf16* Gb = (bf16*)(a.ws + WS_G); const float* cw = a.in[I_FCONVW];
    for (int idx = tid; idx < DFF; idx += 512) {
        const int pn = idx >> 7, rho = idx & 127;
        const float* et = edge + (size_t)(pm * 22 + pn) * 1024; const float* eb = edge + (size_t)((pm - 1) * 22 + pn) * 1024 + 512;
        float u0[2], u1[2];
#pragma unroll
        for (int h = 0; h < 2; ++h) { const int tc = rho + 128 * h, c = h * DFF + idx;
            const float pb0 = eb[tc], pb1 = eb[256 + tc], t0 = et[tc], t1 = et[256 + tc];
            const float w0 = cw[c], w1 = cw[DUP + c], w2 = cw[2 * DUP + c];
            u0[h] = w0 * pb0 + w1 * pb1 + w2 * t0; u1[h] = w0 * pb1 + w1 * t0 + w2 * t1; }
        Gb[(size_t)(pm * 256) * DFF + idx] = (bf16)f2bf(silu_f(u0[0]) * u0[1]);
        Gb[(size_t)(pm * 256 + 1) * DFF + idx] = (bf16)f2bf(silu_f(u1[0]) * u1[1]);
    }
}

__device__ __forceinline__ void p9_rows(const Args& a, int lane, int m0, int m1, int mstep) {
    const float* Fb = (const float*)(a.ws + WS_F); const float* mod = (const float*)(a.ws + WS_MOD); float* Y = a.out + O_Y;
    for (int m = m0; m < m1; m += mstep) {
        const float* md = mod + (size_t)batch_of(m) * NMOD; const float* fr = (const float*)(a.ws + WS_PART) + (size_t)(m - MP) * D;
        f32x4 v[4]; float ss = 0.f;
#pragma unroll
        for (int j = 0; j < 4; ++j) { v[j] = *(const f32x4*)(fr + 4 * lane + 256 * j);
#pragma unroll
            for (int sl = 1; sl < 11; ++sl) v[j] += *(const f32x4*)(fr + sl * (size_t)MS * D + 4 * lane + 256 * j); ss += (v[j].x * v[j].x + v[j].y * v[j].y) + (v[j].z * v[j].z + v[j].w * v[j].w); }
        const float r1 = 1.0f / sqrtf(wave_sum(ss) * (1.0f / D) + EPS);
#pragma unroll
        for (int j = 0; j < 4; ++j) { const int col = 4 * lane + 256 * j;
            const f32x4 x = *(const f32x4*)(Y + (size_t)m * D + col), g = *(const f32x4*)(a.in[I_GPOSTFFN] + col), gt = *(const f32x4*)(md + 5120 + col);
            *(f32x4*)(Y + (size_t)m * D + col) = x + gt * (v[j] * r1 * g); }
    }
}

template <int NI, int NJ, int U>
__device__ __forceinline__ void sgemm_block(f32x4 (&acc)[NI][NJ], const bf16* ap, const bf16* bp, int K) {
    bf16x8 af[U][NI], bfr[U][NJ];
#pragma unroll
    for (int u = 0; u < U; ++u) {
#pragma unroll
        for (int i = 0; i < NI; ++i) af[u][i] = *(const bf16x8*)(ap + (size_t)i * 16 * K + u * 32);
#pragma unroll
        for (int j = 0; j < NJ; ++j) bfr[u][j] = *(const bf16x8*)(bp + (size_t)j * 16 * K + u * 32);
    }
    __builtin_amdgcn_sched_barrier(0);
#pragma unroll
    for (int u = 0; u < U; ++u)
#pragma unroll
        for (int i = 0; i < NI; ++i)
#pragma unroll
            for (int j = 0; j < NJ; ++j) acc[i][j] = __builtin_amdgcn_mfma_f32_16x16x32_bf16(bfr[u][j], af[u][i], acc[i][j], 0, 0, 0);
    __builtin_amdgcn_sched_barrier(0);
}
template <int NI, int NJ, int U, int NKS, class Epi>
__device__ __forceinline__ void sgemm_tile(const bf16* A, const bf16* Bt, int K, LAS unsigned char* lds, int tid, int lane, int wave, const Epi& epi) {
    LAS float* red = (LAS float*)lds;
    for (int i = tid; i < NI * NJ * 256; i += 512) red[i] = 0.f;
    __syncthreads();
    const int fr = lane & 15, fq = lane >> 4, kw = K / 8;
    const bf16* ap = A + (size_t)fr * K + wave * kw + fq * 8; const bf16* bp = Bt + (size_t)fr * K + wave * kw + fq * 8;
    f32x4 acc[NI][NJ];
#pragma unroll
    for (int i = 0; i < NI; ++i)
#pragma unroll
        for (int j = 0; j < NJ; ++j) acc[i][j] = (f32x4){0.f, 0.f, 0.f, 0.f};
#pragma unroll 1
    for (int ks = 0; ks + U <= NKS; ks += U) sgemm_block<NI, NJ, U>(acc, ap + ks * 32, bp + ks * 32, K);
    if constexpr (NKS % U != 0) sgemm_block<NI, NJ, NKS % U>(acc, ap + (NKS - NKS % U) * 32, bp + (NKS - NKS % U) * 32, K);
#pragma unroll
    for (int i = 0; i < NI; ++i)
#pragma unroll
        for (int j = 0; j < NJ; ++j)
#pragma unroll
            for (int e = 0; e < 4; ++e) __hip_atomic_fetch_add(red + ((i * NJ + j) * 4 + e) * 64 + lane, acc[i][j][e], __ATOMIC_RELAXED, __HIP_MEMORY_SCOPE_WORKGROUP);
    __syncthreads();
    for (int blk = wave; blk < NI * NJ; blk += 8) { const int i = blk / NJ, j = blk % NJ; const LAS float* rp = red + blk * 256 + lane; epi(i * 16 + fr, j * 16 + 4 * fq, (f32x4){rp[0], rp[64], rp[128], rp[192]}); }
    __syncthreads();
}

#define XB_TMO      128
#define XB_XCNT(j)  (256  + 64 * (j))
#define XB_XSUB(j)  (1280 + 64 * (j))
#define XB_XGEN(j)  (2304 + 64 * (j))
#define XB_TOP      3328
#define XB_TOPGEN   3392
#define XCD_BAR_WORDS 3456
#define XB_SPIN_CAP (1u << 18)

__device__ __forceinline__ unsigned xb_ld(unsigned* p)              { return __hip_atomic_load(p, __ATOMIC_RELAXED, __HIP_MEMORY_SCOPE_AGENT); }
__device__ __forceinline__ unsigned xb_add(unsigned* p, unsigned v) { return __hip_atomic_fetch_add(p, v, __ATOMIC_RELAXED, __HIP_MEMORY_SCOPE_AGENT); }
__device__ __forceinline__ unsigned xb_xcc_id() { return (unsigned)__builtin_amdgcn_s_getreg((3 << 11) | 20) & 0xFu; }
#define XB_SPIN(cond, bar) do { unsigned _sp = 0; while (cond) { __builtin_amdgcn_s_sleep(1); \
    if ((++_sp & 255u) == 0u) { if (xb_ld(&(bar)[XB_TMO])) break; if (_sp > XB_SPIN_CAP) { atomicAdd(&(bar)[XB_TMO], 1u); break; } } } } while (0)

struct XcdBarrier {
    unsigned* bar; unsigned x;
    volatile LAS unsigned* st;
};

__device__ __forceinline__ XcdBarrier xcd_barrier_post(unsigned* bar, volatile LAS unsigned* st) {
    XcdBarrier b; b.bar = bar; b.x = xb_xcc_id(); b.st = st;
    if (threadIdx.x == 0) (void)xb_add(&bar[XB_XCNT(b.x)], 1u);
    return b;
}
__device__ __forceinline__ void xcd_barrier_complete(unsigned* bar, unsigned x, unsigned& nloc, unsigned& nx) {
    const unsigned G = gridDim.x * gridDim.y * gridDim.z;
    unsigned sum, cnt, mine, sp = 0u;
    for (;;) {
        sum = 0u; cnt = 0u; mine = 0u;
#pragma unroll
        for (unsigned j = 0; j < 16; ++j) { const unsigned c = xb_ld(&bar[XB_XCNT(j)]); sum += c; cnt += (c > 0u) ? 1u : 0u; mine = (j == x) ? c : mine; }
        if (sum == G) break;
        __builtin_amdgcn_s_sleep(1);
        if ((++sp & 255u) == 0u) { if (xb_ld(&bar[XB_TMO])) break; if (sp > XB_SPIN_CAP) { atomicAdd(&bar[XB_TMO], 1u); break; } }
    }
    nloc = mine > 0u ? mine : 1u; nx = cnt > 0u ? cnt : 1u;
}

__device__ __forceinline__ void xcd_barrier(const XcdBarrier& b) {
    asm volatile("s_waitcnt vmcnt(0)" ::: "memory");
    __syncthreads();
    if (threadIdx.x == 0) {
        unsigned* bar = b.bar;
        __builtin_amdgcn_s_waitcnt(0);
        unsigned nloc = b.st[0], nx = b.st[1];
        if (nloc == 0u) { xcd_barrier_complete(bar, b.x, nloc, nx); b.st[0] = nloc; b.st[1] = nx; }
        const unsigned old = xb_add(&bar[XB_XSUB(b.x)], 1u);
        const unsigned gen = old / nloc;
        if (old + 1u == (gen + 1u) * nloc) {
            __builtin_amdgcn_fence(__ATOMIC_RELEASE, "agent");
            asm volatile("s_waitcnt vmcnt(0)" ::: "memory");
            const unsigned og = xb_add(&bar[XB_TOP], 1u);
            const unsigned tg = og / nx;
            if (og + 1u == (tg + 1u) * nx) xb_add(&bar[XB_TOPGEN], 1u);
            else XB_SPIN(xb_ld(&bar[XB_TOPGEN]) == tg, bar);
            __builtin_amdgcn_fence(__ATOMIC_ACQUIRE, "agent");
            xb_add(&bar[XB_XGEN(b.x)], 1u);
            asm volatile("s_waitcnt vmcnt(0)" ::: "memory");
        } else {
            XB_SPIN(xb_ld(&bar[XB_XGEN(b.x)]) == gen, bar);
            __builtin_amdgcn_fence(__ATOMIC_ACQUIRE, "agent");
            asm volatile("s_waitcnt vmcnt(0)" ::: "memory");
        }
    }
    __syncthreads();
}

__global__ void __launch_bounds__(NWAVES * 64, 2) fwd_mk(Args args) {
    extern __shared__ __attribute__((aligned(16))) unsigned char lds_raw[];
    LAS unsigned char* lds = (LAS unsigned char*)lds_raw;
    const int tid = threadIdx.x, lane = tid & 63, wave = __builtin_amdgcn_readfirstlane(tid >> 6);
    const int lo = args.ph_lo, hi = args.ph_hi, G = gridDim.x;
    unsigned char* ws = args.ws;
#define IN(k) (lo <= (k) && (k) < hi)
#define REP(k) for (int rep_ = 0; rep_ <= ((REPMASK >> (k)) & 1); ++rep_)
#define SEAM(k) do { if (IN(k) && IN((k) + 1)) xcd_barrier(bar); } while (0)
    volatile LAS unsigned* MISC = (volatile LAS unsigned*)(lds + EB_OFF + 12288);
    if (tid < 2) MISC[tid] = 0u;
    __syncthreads();
    XcdBarrier bar; bar.bar = (unsigned*)(ws + WS_CTL) + 16384; bar.x = 0; bar.st = MISC;
    if (hi - lo > 1) bar = xcd_barrier_post((unsigned*)(ws + WS_CTL) + 16384, MISC);
    if (lo < -1) cg::this_grid().sync();
    if (IN(0)) { p0_prologue(args, lds, tid, lane, wave); } SEAM(0);
    if (IN(1)) { p1_norm(args, lane, wave); } SEAM(1);
    if (IN(2)) {
        pg8::Gemm g{(const bf16*)(ws + WS_H), (const bf16*)(ws + WS_WIN), MP, DIN, D}; pg8::StaticOrder S; S.init(MP, DIN, G, (int)blockIdx.x);
        pg8::EpiBf16<0> E{(bf16*)(ws + WS_PROJ), DIN, nullptr, 0, 0, 1.f};
        pg8::gemm_phase<pg8::EpiBf16<0>, pg8::StaticOrder, true, true>(lds, g, S, E);
        { pg8::Gemm gs{(const bf16*)(ws + WS_H), (const bf16*)(ws + WS_WIN), M, DIN, 256, D}; pg8::SliceOrder Ss{DIN / 256, 4, (int)blockIdx.x};
          pg8::EpiF32Part Es{(float*)(ws + WS_PART), DIN, (size_t)MS * DIN};
          pg8::gemm_phase<pg8::EpiF32Part, pg8::SliceOrder, true, true>(lds, gs, Ss, Es); }
        if (G == 256 && blockIdx.x >= 64) weight_items(args, lds, lane, wave, 2688 + ((int)blockIdx.x - 64) * 8 + wave, 1536, 1, 4096);
    } SEAM(2);
    if (IN(3)) { p3_mixer(args, tid); } SEAM(3);
    if (IN(4)) {
        { pg8::Gemm g{(const bf16*)(ws + WS_DY), (const bf16*)(ws + WS_WOUT), MP, D, D}; pg8::StaticOrder S; S.init(MP, D, G, (int)blockIdx.x);
          unsigned* ctl = (unsigned*)(ws + WS_CTL); unsigned* xb = (unsigned*)(ws + WS_XB);
          pg8::PanelRms st1{xb, ctl, EPS}, st2{xb + 65536, ctl + CNT_BANK_WORDS, EPS};
          pg8::EpiMixNorm E{args.in[I_XP], (bf16*)(ws + WS_X1), (bf16*)(ws + WS_H), (const float*)(ws + WS_MOD), args.in[I_GPOSTMIX], args.in[I_GPREFFN], st1, st2};
          if (G == 256) pg8::gemm_phase<pg8::EpiMixNorm, pg8::StaticOrder, false, true>(lds, g, S, E); }
        __syncthreads();
        { pg8::Gemm gs{(const bf16*)(ws + WS_DY), (const bf16*)(ws + WS_WOUT), M, D, 256, D}; pg8::SliceOrder Ss{D / 256, 4, (int)blockIdx.x};
          pg8::EpiF32Part Es{(float*)(ws + WS_PART), D, (size_t)MS * D};
          pg8::gemm_phase<pg8::EpiF32Part, pg8::SliceOrder, true, true>(lds, gs, Ss, Es); }
        if (G == 256 && blockIdx.x >= 32) weight_items(args, lds, lane, wave, 4096 + ((int)blockIdx.x - 32) * 8 + wave, 1792, 1, 4800);
    } SEAM(4);
    if (IN(6)) {
        unsigned* cnt5 = (unsigned*)(ws + WS_CTL) + 3 * CNT_BANK_WORDS + 64;
        p5_rowwise1(args, lane, wave, cnt5);
        pg8::Gemm g{(const bf16*)(ws + WS_H), (const bf16*)(ws + WS_WUP), M, DUP, D}; pg8::UpOrder S; S.init(M, DUP, G, (int)blockIdx.x); S.ready = cnt5; S.need = MS;
        pg8::EpiUpGate E{(bf16*)(ws + WS_G), args.in[I_FCONVW], args.in[I_SFFN], args.out + O_NFP, args.out + O_NFS, (float*)(ws + WS_EDGE), (LAS float*)(lds + EB_OFF)};
        pg8::gemm_phase<pg8::EpiUpGate, pg8::UpOrder, true, true>(lds, g, S, E);
    } SEAM(6);
    if (IN(8)) {
        { pg8::Gemm g{(const bf16*)(ws + WS_G), (const bf16*)(ws + WS_WDN), MP, D, DFF}; pg8::StaticOrder S; S.init(MP, D, G, (int)blockIdx.x);
          { pg8::Unit u; for (int i = 0; S.next(i, u); ++i) fixup_tile(args, u.pm, tid); asm volatile("s_waitcnt vmcnt(0)" ::: "memory"); __syncthreads(); }
          pg8::PanelRms st{(unsigned*)(ws + WS_XB) + 131072, (unsigned*)(ws + WS_CTL) + 2 * CNT_BANK_WORDS, EPS};
          pg8::EpiFfnNorm E{(const bf16*)(ws + WS_X1), args.out + O_Y, (const float*)(ws + WS_MOD), args.in[I_GPOSTFFN], st};
          if (G == 256) pg8::gemm_phase<pg8::EpiFfnNorm, pg8::StaticOrder, false, true>(lds, g, S, E); }
        __syncthreads();
        { pg8::Gemm gs{(const bf16*)(ws + WS_G), (const bf16*)(ws + WS_WDN), M, D, 256, DFF}; pg8::SliceOrder Ss{D / 256, 11, (int)blockIdx.x};
          pg8::EpiF32Part Es{(float*)(ws + WS_PART), D, (size_t)MS * D};
          pg8::gemm_phase<pg8::EpiF32Part, pg8::SliceOrder, true, true>(lds, gs, Ss, Es); }
    } SEAM(8);
    if (IN(9)) { const int gw = blockIdx.x * NWAVES + wave; p9_rows(args, lane, MP + gw, M, G * NWAVES); }
#undef IN
#undef SEAM
}

extern "C" void kernel_launch(void* const* d_in, const int* in_sizes, int n_in, void* d_out, int out_size, void* d_ws, size_t ws_size, hipStream_t stream) {
    static int grid = 0;
    if (grid == 0) {
        if (n_in != 21 || out_size != (int)O_END || ws_size < WS_END) { fprintf(stderr, "kernel_launch: unexpected shapes (n_in %d out %d ws %zu)\n", n_in, out_size, ws_size); grid = -1; return; }
        int dev = 0, cus = 0, per_cu = 0;
        hipGetDevice(&dev); hipDeviceGetAttribute(&cus, hipDeviceAttributeMultiprocessorCount, dev);
        if (hipFuncSetAttribute((const void*)fwd_mk, hipFuncAttributeMaxDynamicSharedMemorySize, LDS_BYTES) != hipSuccess) { fprintf(stderr, "kernel_launch: hipFuncSetAttribute failed\n"); grid = -1; return; }
        if (hipOccupancyMaxActiveBlocksPerMultiprocessor(&per_cu, (const void*)fwd_mk, NWAVES * 64, LDS_BYTES) != hipSuccess || per_cu < 1) { fprintf(stderr, "kernel_launch: occupancy query says %d\n", per_cu); per_cu = 1; }
        (void)hipGetLastError();
        grid = cus > 0 ? cus : 256;
    }
    if (grid < 0) return;
    if (hipMemsetAsync((char*)d_ws + WS_CTL + 65536, 0, 16384, stream) != hipSuccess) { fprintf(stderr, "kernel_launch: memset failed\n"); return; }
    Args a{};
    for (int i = 0; i < 21; ++i) a.in[i] = (const float*)d_in[i];
    a.out = (float*)d_out; a.ws = (unsigned char*)d_ws;
#if MK_COOP
    a.ph_lo = 0; a.ph_hi = NPHASE;
    void* kargs[] = {&a};
    hipError_t e = hipLaunchCooperativeKernel((const void*)fwd_mk, dim3(grid), dim3(NWAVES * 64), kargs, LDS_BYTES, stream);
    if (e != hipSuccess) fprintf(stderr, "kernel_launch: cooperative launch failed: %s (grid %d)\n", hipGetErrorString(e), grid);
#else
    for (int p = 0; p < NPHASE; ++p) for (int rep_ = 0; rep_ <= ((REPMASK >> p) & 1); ++rep_) { a.ph_lo = p; a.ph_hi = p + 1; hipLaunchKernelGGL(fwd_mk, dim3(grid), dim3(NWAVES * 64), LDS_BYTES, stream, a); }
#endif
}
```

```cpp
#include <hip/hip_runtime.h>
#include <hip/hip_cooperative_groups.h>
#include <cstdio>
#include <cstdint>
namespace cg = cooperative_groups;
namespace pg8 {
#define PG8_LAS __attribute__((address_space(3)))
typedef unsigned short bf16_t;
typedef short bf16x8 __attribute__((ext_vector_type(8)));
typedef float f32x4 __attribute__((ext_vector_type(4)));
typedef unsigned u32x4 __attribute__((ext_vector_type(4)));
constexpr int BM = 256, BK = 64, HALF = 128, HTB = HALF * BK * 2  , STAGE_BYTES = 8 * HTB, NXCD = 8, WGM = 8;

__host__ __device__ __forceinline__ int lds_byte(int r, int c) { const int st = (r >> 4) * 2 + (c >> 5), rr = r & 15, cc = c & 31, ob = rr * 64 + cc * 2; return st * 1024 + (ob ^ (((ob >> 9) & 1) << 5)); }
__host__ __device__ __forceinline__ void stage_rc(int b, int& R, int& C) { const int st = b / 1024, sb = b % 1024, swz = sb ^ (((sb >> 9) & 1) << 5); R = (st >> 1) * 16 + swz / 64; C = (st & 1) * 32 + (swz % 64) / 2; }
__host__ __device__ __forceinline__ int perm32(int rho) { const int n = rho >> 4, i = rho & 15; return 8 * (i >> 2) + 4 * n + (i & 3); }

struct Unit { int pm, pn, ks; };
struct Gemm { const bf16_t* A; const bf16_t* Bt; int M, N, K; int P = 0; };

struct StaticOrder {
    int nM, nN, nwg, G, c;
    __host__ __device__ void init(int M, int N, int G_, int c_) { nM = M / BM; nN = N / BM; nwg = nM * nN; G = G_; c = c_; }
    __host__ __device__ bool next(int i, Unit& u) const {
        const long L = (long)i * G + c; if (L >= nwg) return false;
        int wgid = (int)L; { const int q = nwg / NXCD, r = nwg % NXCD, xcd = wgid % NXCD, off = wgid / NXCD; wgid = (xcd < r ? xcd * (q + 1) : r * (q + 1) + (xcd - r) * q) + off; }
        const int nig = WGM * nN, gid = wgid / nig, fm = gid * WGM, gsz = (nM - fm) < WGM ? (nM - fm) : WGM;
        u.pm = fm + ((wgid % nig) % gsz); u.pn = (wgid % nig) / gsz; u.ks = 0; return true;
    }
    __device__ __forceinline__ void a_ready(const Unit&) const {}
    __device__ __forceinline__ void done(const Unit&) const {}
};

__device__ __forceinline__ unsigned cvt_pk_bf16(float lo, float hi) { unsigned r; asm volatile("v_cvt_pk_bf16_f32 %0, %1, %2" : "=v"(r) : "v"(lo), "v"(hi)); return r; }
typedef float f32x2 __attribute__((ext_vector_type(2)));
__device__ __forceinline__ f32x2 gelu_pk(f32x2 v) {
    const f32x2 av = __builtin_elementwise_abs(v), d = av * 0.2316418882f + 1.0f;
    f32x2 t; t.x = __builtin_amdgcn_rcpf(d.x); t.y = __builtin_amdgcn_rcpf(d.y);
    f32x2 q = t * 0.5307027145f + (-0.7265760135f); q = q * t + 0.7107068705f; q = q * t + (-0.142248368f); q = q * t + 0.127414796f; q = q * t;
    const f32x2 s = (v * v) * (-0.72134752044f);
    f32x2 e; e.x = __builtin_amdgcn_exp2f(s.x); e.y = __builtin_amdgcn_exp2f(s.y);
    const f32x2 m = v * (q * e), r = v - m;
    f32x2 o; o.x = v.x < 0.f ? m.x : r.x; o.y = v.y < 0.f ? m.y : r.y; return o;
}

template <int ACT  > struct EpiBf16 {
    static constexpr bool PERM = true, AFTER_DRAIN = false; static_assert(ACT == 0 || ACT == 1, "EpiBf16: ACT is 0 (none) or 1 (gelu_pk)");
    bf16_t* O; int ldc; const float* bias; int split_cols; size_t split_stride; float scale0;
    __device__ __forceinline__ void operator()(const f32x4 (&acc)[2][2][4][2], const Unit& u, int wr, int wc, int fr, int fq) const {
        const int row0 = u.pm * BM + wr * 64 + fr; int colt = u.pn * BM; bf16_t* base = O;
        float sc = 1.f; if (split_cols) { const int t = colt / split_cols; base += (size_t)t * split_stride; colt -= t * split_cols; if (t == 0) sc = scale0; }
        const int col0 = colt + wc * 32 + 8 * fq, bcol0 = u.pn * BM + wc * 32 + 8 * fq;
        f32x4 bv[2][2];
#pragma unroll
        for (int bj = 0; bj < 2; ++bj)
#pragma unroll
            for (int n = 0; n < 2; ++n) bv[bj][n] = bias ? *(const f32x4*)(bias + bcol0 + bj * HALF + 4 * n) : (f32x4){0.f, 0.f, 0.f, 0.f};
#pragma unroll
        for (int ai = 0; ai < 2; ++ai)
#pragma unroll
            for (int m = 0; m < 4; ++m) { bf16_t* rowp = base + (size_t)(row0 + ai * HALF + m * 16) * ldc + col0;
#pragma unroll
                for (int bj = 0; bj < 2; ++bj) { f32x4 v0 = acc[ai][bj][m][0] + bv[bj][0], v1 = acc[ai][bj][m][1] + bv[bj][1];
                    if (ACT == 1) { f32x2 a = gelu_pk((f32x2){v0[0], v0[1]}), b = gelu_pk((f32x2){v0[2], v0[3]}), c = gelu_pk((f32x2){v1[0], v1[1]}), d = gelu_pk((f32x2){v1[2], v1[3]});
                        v0 = (f32x4){a.x, a.y, b.x, b.y}; v1 = (f32x4){c.x, c.y, d.x, d.y}; }
                    v0 = v0 * sc; v1 = v1 * sc; u32x4 w; w.x = cvt_pk_bf16(v0[0], v0[1]); w.y = cvt_pk_bf16(v0[2], v0[3]); w.z = cvt_pk_bf16(v1[0], v1[1]); w.w = cvt_pk_bf16(v1[2], v1[3]);
                    *(u32x4*)(rowp + bj * HALF) = w; } }
    }
};
struct EpiF32 {
    static constexpr bool PERM = false, AFTER_DRAIN = false;
    float* O; int ldc;
    __device__ __forceinline__ void operator()(const f32x4 (&acc)[2][2][4][2], const Unit& u, int wr, int wc, int fr, int fq) const {
        const int row0 = u.pm * BM + wr * 64 + fr, col0 = u.pn * BM + wc * 32 + 4 * fq;
#pragma unroll
        for (int ai = 0; ai < 2; ++ai)
#pragma unroll
            for (int m = 0; m < 4; ++m) { float* rowp = O + (size_t)(row0 + ai * HALF + m * 16) * ldc + col0;
#pragma unroll
                for (int bj = 0; bj < 2; ++bj)
#pragma unroll
                    for (int n = 0; n < 2; ++n) *(f32x4*)(rowp + bj * HALF + n * 16) = acc[ai][bj][m][n]; }
    }
};
struct EpiProj {
    static constexpr bool PERM = true, AFTER_DRAIN = false;
    bf16_t* O;
    __device__ __forceinline__ void operator()(const f32x4 (&acc)[2][2][4][2], const Unit& u, int wr, int wc, int fr, int fq) const {
        const int row0 = u.pm * BM + wr * 64 + fr, cl = wc * 32 + 8 * fq;
#pragma unroll
        for (int ai = 0; ai < 2; ++ai)
#pragma unroll
            for (int m = 0; m < 4; ++m) { bf16_t* rowp = O + (size_t)(row0 + ai * HALF + m * 16) * 1536;
                if (u.pn < 4) {
#pragma unroll
                    for (int bj = 0; bj < 2; ++bj) { const f32x4 v0 = acc[ai][bj][m][0], v1 = acc[ai][bj][m][1]; u32x4 w;
                        w.x = cvt_pk_bf16(v0[0], v0[1]); w.y = cvt_pk_bf16(v0[2], v0[3]); w.z = cvt_pk_bf16(v1[0], v1[1]); w.w = cvt_pk_bf16(v1[2], v1[3]);
                        *(u32x4*)(rowp + u.pn * BM + bj * HALF + cl) = w; }
                } else {
                    const f32x4 v0 = acc[ai][0][m][0] * acc[ai][1][m][0], v1 = acc[ai][0][m][1] * acc[ai][1][m][1]; u32x4 w;
                    w.x = cvt_pk_bf16(v0[0], v0[1]); w.y = cvt_pk_bf16(v0[2], v0[3]); w.z = cvt_pk_bf16(v1[0], v1[1]); w.w = cvt_pk_bf16(v1[2], v1[3]);
                    *(u32x4*)(rowp + 1024 + (u.pn - 4) * HALF + cl) = w;
                } }
    }
};
__device__ __forceinline__ f32x4 shfl4(f32x4 v, int src) { f32x4 r; r.x = __shfl(v.x, src); r.y = __shfl(v.y, src); r.z = __shfl(v.z, src); r.w = __shfl(v.w, src); return r; }
template <int N> __device__ __forceinline__ float dpp_ror(float v) { return __builtin_bit_cast(float, __builtin_amdgcn_mov_dpp(__builtin_bit_cast(int, v), 0x120 + N, 0xf, 0xf, true)); }
template <int N> __device__ __forceinline__ f32x4 ror4(f32x4 v) { f32x4 r; r.x = dpp_ror<N>(v.x); r.y = dpp_ror<N>(v.y); r.z = dpp_ror<N>(v.z); r.w = dpp_ror<N>(v.w); return r; }
template <int N> __device__ __forceinline__ float dpp_shr_old(float old, float v) { return __builtin_bit_cast(float, __builtin_amdgcn_update_dpp(__builtin_bit_cast(int, old), __builtin_bit_cast(int, v), 0x110 + N, 0xf, 0xf, false)); }
template <int N> __device__ __forceinline__ f32x4 shr4(f32x4 old, f32x4 v) { f32x4 r; r.x = dpp_shr_old<N>(old.x, v.x); r.y = dpp_shr_old<N>(old.y, v.y); r.z = dpp_shr_old<N>(old.z, v.z); r.w = dpp_shr_old<N>(old.w, v.w); return r; }
struct EpiUpGate {
    static constexpr bool PERM = true, AFTER_DRAIN = false;
    bf16_t* G; const float* cw; const float* st; float* nfp; float* nfs; float* edge; PG8_LAS float* eb;
    __device__ __forceinline__ void operator()(const f32x4 (&acc)[2][2][4][2], const Unit& u, int wr, int wc, int fr, int fq) const {
        const int lane = fq * 16 + fr;
        const int tc0 = wc * 32 + 8 * fq, j0 = u.pn * 128 + tc0;
        const int src1 = (lane & 48) | ((fr + 15) & 15), src2 = (lane & 48) | ((fr + 14) & 15);
        const bool sample = u.pm >= 64;
        PG8_LAS float* wl = eb + 2048;
        { const int t_ = (int)threadIdx.x; if (t_ < 256) { const int c_ = (t_ < 128 ? 0 : 2816 - 128) + u.pn * 128 + t_;
#pragma unroll
            for (int k = 0; k < 3; ++k) wl[k * 256 + t_] = cw[k * 5632 + c_]; } }
        if (!sample && fr >= 14) {
#pragma unroll
            for (int ai = 0; ai < 2; ++ai)
#pragma unroll
                for (int bj = 0; bj < 2; ++bj)
#pragma unroll
                    for (int n = 0; n < 2; ++n) *(PG8_LAS f32x4*)(eb + ((2 * ai + wr) * 2 + (fr - 14)) * 256 + 128 * bj + tc0 + 4 * n) = acc[ai][bj][3][n];
        }
        asm volatile("s_waitcnt lgkmcnt(0)" ::: "memory"); __builtin_amdgcn_s_barrier(); asm volatile("" ::: "memory");
#pragma unroll
        for (int ai = 0; ai < 2; ++ai) {
            const int blk = 2 * ai + wr;
#pragma unroll
            for (int m = 0; m < 4; ++m) {
                const int r = 128 * ai + 64 * wr + 16 * m + fr;
                int wo = tc0; asm volatile("" : "+v"(wo));
                f32x4 uu[2][2];
#pragma unroll
                for (int bj = 0; bj < 2; ++bj)
#pragma unroll
                    for (int n = 0; n < 2; ++n) {
                        const f32x4 x = acc[ai][bj][m][n];
                        f32x4 p1, p2;
                        if (!sample) {
                            if (m > 0) {
                                const f32x4 xp = acc[ai][bj][m > 0 ? m - 1 : 0][n];
                                p1 = shr4<1>(ror4<1>(xp), x); p2 = shr4<2>(ror4<2>(xp), x);
                            } else {
                                f32x4 b1 = (f32x4){0.f, 0.f, 0.f, 0.f}, b2 = b1;
                                if (blk > 0) { b1 = *(const PG8_LAS f32x4*)(eb + ((blk - 1) * 2 + 1) * 256 + 128 * bj + tc0 + 4 * n);
                                               b2 = *(const PG8_LAS f32x4*)(eb + ((blk - 1) * 2 + (fr == 0 ? 0 : 1)) * 256 + 128 * bj + tc0 + 4 * n); }
                                p1 = shr4<1>(b1, x); p2 = shr4<2>(b2, x);
                            }
                        } else {
                            const int srow = (u.pm - 64) * 256 + r, b = srow >> 2, t = fr & 3;
                            p1 = ror4<1>(x); p2 = ror4<2>(x);
                            const size_t so = (size_t)b * 2 * 5632 + bj * 2816 + j0 + 4 * n;
                            if (t < 2) { const f32x4 s0 = *(const f32x4*)(st + so), s1 = *(const f32x4*)(st + so + 5632);
                                if (t == 0) { p1 = s1; p2 = s0; } else { p2 = s1; } }
                            else *(f32x4*)(nfs + so + (size_t)(t - 2) * 5632) = x;
                        }
                        const PG8_LAS float* wp = wl + 128 * bj + wo + 4 * n;
                        uu[bj][n] = *(const PG8_LAS f32x4*)wp * p2 + *(const PG8_LAS f32x4*)(wp + 256) * p1 + *(const PG8_LAS f32x4*)(wp + 512) * x;
                    }
                float gv[8];
#pragma unroll
                for (int n = 0; n < 2; ++n)
#pragma unroll
                    for (int c = 0; c < 4; ++c) { const float a = uu[0][n][c], b = uu[1][n][c]; gv[n * 4 + c] = a * __builtin_amdgcn_rcpf(1.0f + __expf(-a)) * b; }
                u32x4 o; o.x = cvt_pk_bf16(gv[0], gv[1]); o.y = cvt_pk_bf16(gv[2], gv[3]); o.z = cvt_pk_bf16(gv[4], gv[5]); o.w = cvt_pk_bf16(gv[6], gv[7]);
                const bool deferred = (!sample) && (blk == 0) && (m == 0) && (fr < 2) && ((u.pm & 7) != 0);
                if (!deferred) *(u32x4*)(G + (size_t)(u.pm * BM + r) * 2816 + j0) = o;
            }
        }
        if (!sample) {
            float* eg = edge + (size_t)(u.pm * 22 + u.pn) * 1024;
            if (wr == 0 && fr < 2) {
#pragma unroll
                for (int bj = 0; bj < 2; ++bj)
#pragma unroll
                    for (int n = 0; n < 2; ++n) *(f32x4*)(eg + fr * 256 + 128 * bj + tc0 + 4 * n) = acc[0][bj][0][n];
            }
            if (wr == 1 && fr >= 14) {
#pragma unroll
                for (int bj = 0; bj < 2; ++bj)
#pragma unroll
                    for (int n = 0; n < 2; ++n) { *(f32x4*)(eg + (2 + fr - 14) * 256 + 128 * bj + tc0 + 4 * n) = acc[1][bj][3][n];
                        if ((u.pm & 7) == 7) *(f32x4*)(nfp + (size_t)((u.pm >> 3) * 2 + (fr - 14)) * 5632 + bj * 2816 + j0 + 4 * n) = acc[1][bj][3][n]; }
            }
        }
    }
};
struct PanelRms {
    unsigned* xbuf;
    unsigned* cnt;
    float eps;
    __device__ __forceinline__ void run(const f32x4 (&v)[2][2][4][2], const Unit& u, int wr, int wc, int fr, int fq, PG8_LAS unsigned char* lds, int wid, int lane) const {
        PG8_LAS float* P = (PG8_LAS float*)lds;
        PG8_LAS float* S = (PG8_LAS float*)(lds + 8192);
#pragma unroll
        for (int ai = 0; ai < 2; ++ai)
#pragma unroll
            for (int m = 0; m < 4; ++m) {
                float q = 0.f;
#pragma unroll
                for (int bj = 0; bj < 2; ++bj)
#pragma unroll
                    for (int n = 0; n < 2; ++n) { const f32x4 x = v[ai][bj][m][n]; q += (x[0] * x[0] + x[1] * x[1]) + (x[2] * x[2] + x[3] * x[3]); }
                q += __shfl_xor(q, 16); q += __shfl_xor(q, 32);
                if (fq == 0) P[(ai * HALF + wr * 64 + m * 16 + fr) * 4 + wc] = q;
            }
        asm volatile("s_waitcnt lgkmcnt(0)" ::: "memory"); __builtin_amdgcn_s_barrier(); asm volatile("" ::: "memory");
        const int row = wid * 32 + (lane & 31);
        if (lane < 32) {
            const float q = (P[row * 4 + 0] + P[row * 4 + 1]) + (P[row * 4 + 2] + P[row * 4 + 3]);
            __hip_atomic_store(xbuf + ((size_t)(u.pm * BM + row) * 4 + u.pn), __float_as_uint(q), __ATOMIC_RELAXED, __HIP_MEMORY_SCOPE_AGENT);
        }
        asm volatile("s_waitcnt vmcnt(0)" ::: "memory");
        if (lane == 0) __hip_atomic_fetch_add(cnt + 64 * u.pm, 1u, __ATOMIC_RELAXED, __HIP_MEMORY_SCOPE_AGENT);
        if (wid == 0) {
            unsigned spins = 0;
            for (;;) {
                if ((unsigned)__builtin_amdgcn_readfirstlane(__hip_atomic_load(cnt + 64 * u.pm, __ATOMIC_RELAXED, __HIP_MEMORY_SCOPE_AGENT)) >= 32u) break;
                if (++spins > (1u << 22)) break;
                __builtin_amdgcn_s_sleep(2);
            }
            __builtin_amdgcn_fence(__ATOMIC_ACQUIRE, "agent");
        }
        asm volatile("s_waitcnt vmcnt(0) lgkmcnt(0)" ::: "memory"); __builtin_amdgcn_s_barrier(); asm volatile("" ::: "memory");
        if (lane < 32) {
            const unsigned* slot = xbuf + (size_t)(u.pm * BM + row) * 4; float q = 0.f;
#pragma unroll
            for (int t = 0; t < 4; ++t) q += __uint_as_float(__hip_atomic_load(slot + t, __ATOMIC_RELAXED, __HIP_MEMORY_SCOPE_AGENT));
            S[row] = 1.0f / sqrtf(q * (1.0f / 1024.0f) + eps);
        }
        asm volatile("s_waitcnt lgkmcnt(0)" ::: "memory"); __builtin_amdgcn_s_barrier(); asm volatile("" ::: "memory");
    }
};
struct EpiMixNorm {
    static constexpr bool PERM = false, AFTER_DRAIN = true;
    const float* x; bf16_t* X1; bf16_t* H; const float* mod; const float* gpm; const float* gpf; PanelRms st1, st2;
    __device__ __forceinline__ void fused(f32x4 (&acc)[2][2][4][2], const Unit& u, int wr, int wc, int fr, int fq, PG8_LAS unsigned char* lds, int wid, int lane) const {
        typedef unsigned u32x2v __attribute__((ext_vector_type(2)));
        const PG8_LAS float* S = (const PG8_LAS float*)(lds + 8192);
        const float* md = mod + (size_t)(u.pm >> 3) * 6144;
        const int col0 = u.pn * BM + wc * 32 + 4 * fq;
        f32x4 pre[2][2][2];
#pragma unroll
        for (int m = 0; m < 2; ++m) { const size_t off = (size_t)(u.pm * BM + wr * 64 + m * 16 + fr) * 1024 + col0;
#pragma unroll
            for (int bj = 0; bj < 2; ++bj)
#pragma unroll
                for (int n = 0; n < 2; ++n) pre[m][bj][n] = *(const f32x4*)(x + off + bj * HALF + n * 16); }
        st1.run(acc, u, wr, wc, fr, fq, lds, wid, lane);
        f32x4 cf[2][2];
#pragma unroll
        for (int bj = 0; bj < 2; ++bj)
#pragma unroll
            for (int n = 0; n < 2; ++n) { const int c = col0 + bj * HALF + n * 16; cf[bj][n] = *(const f32x4*)(md + 2048 + c) * *(const f32x4*)(gpm + c); }
#pragma unroll
        for (int ai = 0; ai < 2; ++ai)
#pragma unroll
            for (int m = 0; m < 4; ++m) { const int r = ai * HALF + wr * 64 + m * 16 + fr; const float rs = S[r]; const size_t off = (size_t)(u.pm * BM + r) * 1024 + col0;
#pragma unroll
                for (int bj = 0; bj < 2; ++bj)
#pragma unroll
                    for (int n = 0; n < 2; ++n) { const f32x4 bs = (ai == 0 && m < 2) ? pre[m < 2 ? m : 0][bj][n] : *(const f32x4*)(x + off + bj * HALF + n * 16); acc[ai][bj][m][n] = bs + cf[bj][n] * (acc[ai][bj][m][n] * rs); }
                asm volatile("" : "+v"(acc[ai][0][m][0]), "+v"(acc[ai][0][m][1]), "+v"(acc[ai][1][m][0]), "+v"(acc[ai][1][m][1]));
                if (m & 1) asm volatile("" ::: "memory"); }
        st2.run(acc, u, wr, wc, fr, fq, lds, wid, lane);
        f32x4 c2[2][2], sh[2][2];
#pragma unroll
        for (int bj = 0; bj < 2; ++bj)
#pragma unroll
            for (int n = 0; n < 2; ++n) { const int c = col0 + bj * HALF + n * 16; c2[bj][n] = *(const f32x4*)(gpf + c) * (1.0f + *(const f32x4*)(md + 4096 + c)); sh[bj][n] = *(const f32x4*)(md + 3072 + c); }
#pragma unroll
        for (int ai = 0; ai < 2; ++ai)
#pragma unroll
            for (int m = 0; m < 4; ++m) { const int r = ai * HALF + wr * 64 + m * 16 + fr; const float rs = S[r]; const size_t off = (size_t)(u.pm * BM + r) * 1024 + col0;
#pragma unroll
                for (int bj = 0; bj < 2; ++bj)
#pragma unroll
                    for (int n = 0; n < 2; ++n) { const f32x4 x1 = acc[ai][bj][m][n]; { u32x2v w1; w1.x = cvt_pk_bf16(x1[0], x1[1]); w1.y = cvt_pk_bf16(x1[2], x1[3]); *(u32x2v*)(X1 + off + bj * HALF + n * 16) = w1; }
                        const f32x4 o = x1 * rs * c2[bj][n] + sh[bj][n]; u32x2v w; w.x = cvt_pk_bf16(o[0], o[1]); w.y = cvt_pk_bf16(o[2], o[3]);
                        *(u32x2v*)(H + off + bj * HALF + n * 16) = w; }
                asm volatile("" ::: "memory"); }
    }
};
struct EpiFfnNorm {
    static constexpr bool PERM = false, AFTER_DRAIN = true;
    const bf16_t* X1; float* Y; const float* mod; const float* gpo; PanelRms st;
    __device__ __forceinline__ void fused(f32x4 (&acc)[2][2][4][2], const Unit& u, int wr, int wc, int fr, int fq, PG8_LAS unsigned char* lds, int wid, int lane) const {
        typedef unsigned u32x2v __attribute__((ext_vector_type(2)));
        const PG8_LAS float* S = (const PG8_LAS float*)(lds + 8192);
        const float* md = mod + (size_t)(u.pm >> 3) * 6144;
        const int col0 = u.pn * BM + wc * 32 + 4 * fq;
        u32x2v pre[1][4][2][2];
#pragma unroll
        for (int ai = 0; ai < 1; ++ai)
#pragma unroll
            for (int m = 0; m < 4; ++m) { const size_t off = (size_t)(u.pm * BM + ai * HALF + wr * 64 + m * 16 + fr) * 1024 + col0;
#pragma unroll
                for (int bj = 0; bj < 2; ++bj)
#pragma unroll
                    for (int n = 0; n < 2; ++n) pre[ai][m][bj][n] = *(const u32x2v*)(X1 + off + bj * HALF + n * 16); }
        st.run(acc, u, wr, wc, fr, fq, lds, wid, lane);
        f32x4 cf[2][2];
#pragma unroll
        for (int bj = 0; bj < 2; ++bj)
#pragma unroll
            for (int n = 0; n < 2; ++n) { const int c = col0 + bj * HALF + n * 16; cf[bj][n] = *(const f32x4*)(md + 5120 + c) * *(const f32x4*)(gpo + c); }
#pragma unroll
        for (int ai = 0; ai < 2; ++ai)
#pragma unroll
            for (int m = 0; m < 4; ++m) { const int r = ai * HALF + wr * 64 + m * 16 + fr; const float rs = S[r]; const size_t off = (size_t)(u.pm * BM + r) * 1024 + col0;
#pragma unroll
                for (int bj = 0; bj < 2; ++bj)
#pragma unroll
                    for (int n = 0; n < 2; ++n) { const u32x2v p = ai == 0 ? pre[0][m][bj][n] : *(const u32x2v*)(X1 + off + bj * HALF + n * 16);
                        const f32x4 bs = (f32x4){__uint_as_float(p.x << 16), __uint_as_float(p.x & 0xffff0000u), __uint_as_float(p.y << 16), __uint_as_float(p.y & 0xffff0000u)};
                        *(f32x4*)(Y + off + bj * HALF + n * 16) = bs + cf[bj][n] * (acc[ai][bj][m][n] * rs); } }
    }
};
struct SliceOrder {
    int nN, nsl, c;
    __device__ bool next(int i, Unit& u) const { if (i != 0 || c >= 2 * nN * nsl) return false; u.ks = c % nsl; const int r = c / nsl; u.pn = r % nN; u.pm = 64 + r / nN; return true; }
    __device__ __forceinline__ void a_ready(const Unit&) const {}
    __device__ __forceinline__ void done(const Unit&) const {}
};
struct EpiF32Part {
    static constexpr bool PERM = false, AFTER_DRAIN = false;
    float* O; int ldc; size_t pstride;
    __device__ __forceinline__ void operator()(const f32x4 (&acc)[2][2][4][2], const Unit& u, int wr, int wc, int fr, int fq) const {
        const int row0 = (u.pm - 64) * BM + wr * 64 + fr, col0 = u.pn * BM + wc * 32 + 4 * fq;
        float* Ob = O + (size_t)u.ks * pstride;
#pragma unroll
        for (int ai = 0; ai < 2; ++ai)
#pragma unroll
            for (int m = 0; m < 4; ++m) { float* rowp = Ob + (size_t)(row0 + ai * HALF + m * 16) * ldc + col0;
#pragma unroll
                for (int bj = 0; bj < 2; ++bj)
#pragma unroll
                    for (int n = 0; n < 2; ++n) *(f32x4*)(rowp + bj * HALF + n * 16) = acc[ai][bj][m][n]; }
    }
};
struct UpOrder : StaticOrder {
    const unsigned* ready; unsigned need;
    __device__ __forceinline__ void a_ready(const Unit& u) const {
        if (u.pm < 64) return;
        if (threadIdx.x < 64) {
            unsigned spins = 0;
            while ((unsigned)__builtin_amdgcn_readfirstlane(__hip_atomic_load(ready, __ATOMIC_RELAXED, __HIP_MEMORY_SCOPE_AGENT)) < need) { if (++spins > (1u << 22)) break; __builtin_amdgcn_s_sleep(2); }
            __builtin_amdgcn_fence(__ATOMIC_ACQUIRE, "agent");
            asm volatile("s_waitcnt vmcnt(0)" ::: "memory");
        }
        asm volatile("" ::: "memory"); __builtin_amdgcn_s_barrier(); asm volatile("" ::: "memory");
    }
};
template <class Epi, class Sched, bool ALIGN_EPI = false, bool SP2 = false>
__device__ __forceinline__ void gemm_phase(PG8_LAS unsigned char* lds, const Gemm g, const Sched& S, const Epi& E) {
    const int tid = threadIdx.x, wid = __builtin_amdgcn_readfirstlane(tid >> 6), lane = tid & 63, wr = wid >> 2, wc = wid & 3, fr = lane & 15, fq = lane >> 4;
    const int K = g.P ? g.P : g.K, nt = g.K / BK;
    const size_t sstep = (size_t)g.K * 2;
    unsigned voffA[2], voffB[2];
#pragma unroll
    for (int i = 0; i < 2; ++i) { int R, C; stage_rc(tid * 16 + i * 8192, R, C); const int Rb = Epi::PERM ? ((R & ~31) + perm32(R & 31)) : R;
        voffA[i] = (unsigned)(R * K + C) * 2u; voffB[i] = (unsigned)(Rb * K + C) * 2u; }
    const size_t kstep = (size_t)(BK * 2);
    const size_t hstep = (size_t)HALF * K * 2;
    const size_t tstep = 2 * hstep;
    const unsigned ldsw = (unsigned)wid * 1024u;
    const int aoff = lds_byte(wr * 64 + fr, fq * 8), boff = lds_byte(wc * 32 + fr, fq * 8);
#define PG8_SA(b, h) (((b) * 2 + (h)) * HTB)
#define PG8_SB(b, h) ((4 + (b) * 2 + (h)) * HTB)
#define PG8_STAGE(bufoff, gbase, voff) do { _Pragma("unroll") for (int _i = 0; _i < 2; ++_i) \
        __builtin_amdgcn_global_load_lds((const unsigned*)((const char*)(gbase) + (voff)[_i]), (PG8_LAS unsigned*)(lds + (bufoff) + ldsw + _i * 8192), 16, 0, 0); } while (0)
#define PG8_LDA(dst, b, h) do { _Pragma("unroll") for (int m = 0; m < 4; ++m) _Pragma("unroll") for (int k = 0; k < 2; ++k) dst[m][k] = *(const PG8_LAS bf16x8*)(lds + PG8_SA(b, h) + aoff + m * 2048 + k * 1024); } while (0)
#define PG8_LDB(dst, b, h) do { _Pragma("unroll") for (int n = 0; n < 2; ++n) _Pragma("unroll") for (int k = 0; k < 2; ++k) dst[n][k] = *(const PG8_LAS bf16x8*)(lds + PG8_SB(b, h) + boff + n * 2048 + k * 1024); } while (0)
#define PG8_MMA(ai, bj, At, Bt) do { __builtin_amdgcn_s_setprio(1); _Pragma("unroll") for (int m = 0; m < 4; ++m) _Pragma("unroll") for (int n = 0; n < 2; ++n) _Pragma("unroll") for (int k = 0; k < 2; ++k) \
        acc[ai][bj][m][n] = __builtin_amdgcn_mfma_f32_16x16x32_bf16(Bt[n][k], At[m][k], acc[ai][bj][m][n], 0, 0, 0); __builtin_amdgcn_s_setprio(0); } while (0)
#define PG8_WAIT_V(n) asm volatile("s_waitcnt vmcnt(" #n ")" ::: "memory")
#define PG8_WAIT_L(n) asm volatile("s_waitcnt lgkmcnt(" #n ")" ::: "memory")
#define PG8_BAR __builtin_amdgcn_s_barrier()
#define PG8_SCHED __builtin_amdgcn_sched_barrier(0)
    Unit cur, nxt; int ui = 0;
    if (!S.next(0, cur)) return;
    f32x4 acc[2][2][4][2];
#pragma unroll
    for (int a = 0; a < 2; ++a)
#pragma unroll
        for (int b = 0; b < 2; ++b)
#pragma unroll
            for (int m = 0; m < 4; ++m)
#pragma unroll
                for (int n = 0; n < 2; ++n) acc[a][b][m][n] = (f32x4){0.f, 0.f, 0.f, 0.f};
    bf16x8 At[4][2], B0[2][2], B1[2][2];
    const char* cA = (const char*)g.A + (size_t)cur.pm * tstep + cur.ks * sstep; const char* cB = (const char*)g.Bt + (size_t)cur.pn * tstep + cur.ks * sstep;
    S.a_ready(cur);
    if constexpr (SP2) {
        PG8_STAGE(PG8_SB(0, 0), cB, voffB); PG8_STAGE(PG8_SB(0, 1), cB + hstep, voffB); PG8_STAGE(PG8_SA(0, 0), cA, voffA); PG8_STAGE(PG8_SA(0, 1), cA + hstep, voffA);
        if (wr == 1) PG8_BAR;
        PG8_WAIT_V(2); PG8_BAR;
        PG8_STAGE(PG8_SB(1, 0), cB + kstep, voffB); PG8_STAGE(PG8_SA(1, 0), cA + kstep, voffA); PG8_STAGE(PG8_SB(1, 1), cB + hstep + kstep, voffB);
        PG8_WAIT_V(6); PG8_BAR;
    } else {
        PG8_STAGE(PG8_SB(0, 0), cB, voffB); PG8_STAGE(PG8_SA(0, 0), cA, voffA); PG8_STAGE(PG8_SB(0, 1), cB + hstep, voffB); PG8_STAGE(PG8_SA(0, 1), cA + hstep, voffA);
        if (wr == 1) PG8_BAR;
        PG8_WAIT_V(4); PG8_BAR;
        PG8_STAGE(PG8_SB(1, 0), cB + kstep, voffB); PG8_STAGE(PG8_SA(1, 0), cA + kstep, voffA); PG8_STAGE(PG8_SB(1, 1), cB + hstep + kstep, voffB);
        PG8_WAIT_V(6); PG8_BAR;
    }
    for (;;) {
        const bool has_next = S.next(ui + 1, nxt);
        const char* nA = has_next ? (const char*)g.A + (size_t)nxt.pm * tstep + nxt.ks * sstep : cA; const char* nB = has_next ? (const char*)g.Bt + (size_t)nxt.pn * tstep + nxt.ks * sstep : cB;
        for (int t = 0; t < nt; t += 2) {
            const bool last = (t == nt - 2);
            const char* a1 = cA + (size_t)(t + 1) * kstep;
            const char* a2 = last ? nA : cA + (size_t)(t + 2) * kstep; const char* b2 = last ? nB : cB + (size_t)(t + 2) * kstep;
            const char* a3 = a2 + kstep; const char* b3 = b2 + kstep;
            if (last && has_next) S.a_ready(nxt);
            if constexpr (SP2) {
            PG8_LDB(B0, 0, 0); PG8_LDB(B1, 0, 1); PG8_SCHED; PG8_LDA(At, 0, 0); PG8_STAGE(PG8_SA(1, 1), a1 + hstep, voffA);
            PG8_WAIT_V(8); PG8_WAIT_L(0); PG8_BAR; PG8_MMA(0, 0, At, B0); PG8_MMA(0, 1, At, B1); PG8_BAR; PG8_SCHED;
            PG8_LDA(At, 0, 1); PG8_STAGE(PG8_SB(0, 0), b2, voffB); PG8_STAGE(PG8_SB(0, 1), b2 + hstep, voffB); PG8_STAGE(PG8_SA(0, 0), a2, voffA);
            PG8_WAIT_V(8); PG8_WAIT_L(0); PG8_BAR; PG8_MMA(1, 0, At, B0); PG8_MMA(1, 1, At, B1); PG8_BAR; PG8_SCHED;
            PG8_LDB(B0, 1, 0); PG8_LDB(B1, 1, 1); PG8_SCHED; PG8_LDA(At, 1, 0); PG8_STAGE(PG8_SA(0, 1), a2 + hstep, voffA);
            PG8_WAIT_V(8); PG8_WAIT_L(0); PG8_BAR; PG8_MMA(0, 0, At, B0); PG8_MMA(0, 1, At, B1); PG8_BAR; PG8_SCHED;
            PG8_LDA(At, 1, 1); PG8_STAGE(PG8_SB(1, 0), b3, voffB); PG8_STAGE(PG8_SB(1, 1), b3 + hstep, voffB); PG8_STAGE(PG8_SA(1, 0), a3, voffA);
            PG8_WAIT_V(8); PG8_WAIT_L(0); PG8_BAR; PG8_MMA(1, 0, At, B0); PG8_MMA(1, 1, At, B1); PG8_BAR; PG8_SCHED;
            } else {
            PG8_LDB(B0, 0, 0); PG8_SCHED; PG8_LDA(At, 0, 0); PG8_STAGE(PG8_SA(1, 1), a1 + hstep, voffA);
            PG8_WAIT_L(8); PG8_BAR; PG8_WAIT_L(0); PG8_MMA(0, 0, At, B0); PG8_BAR; PG8_SCHED;
            PG8_LDB(B1, 0, 1); PG8_STAGE(PG8_SB(0, 0), b2, voffB);
            PG8_BAR; PG8_WAIT_L(0); PG8_MMA(0, 1, At, B1); PG8_BAR;
            PG8_LDA(At, 0, 1); PG8_STAGE(PG8_SA(0, 0), a2, voffA);
            PG8_BAR; PG8_WAIT_L(0); PG8_MMA(1, 0, At, B0); PG8_BAR; PG8_SCHED;
            PG8_STAGE(PG8_SB(0, 1), b2 + hstep, voffB);
            PG8_WAIT_V(6); PG8_BAR; PG8_MMA(1, 1, At, B1); PG8_BAR;
            PG8_LDB(B0, 1, 0); PG8_SCHED; PG8_LDA(At, 1, 0); PG8_STAGE(PG8_SA(0, 1), a2 + hstep, voffA);
            PG8_WAIT_L(8); PG8_BAR; PG8_WAIT_L(0); PG8_MMA(0, 0, At, B0); PG8_BAR; PG8_SCHED;
            PG8_LDB(B1, 1, 1); PG8_STAGE(PG8_SB(1, 0), b3, voffB);
            PG8_BAR; PG8_WAIT_L(0); PG8_MMA(0, 1, At, B1); PG8_BAR;
            PG8_LDA(At, 1, 1); PG8_STAGE(PG8_SA(1, 0), a3, voffA);
            PG8_BAR; PG8_WAIT_L(0); PG8_MMA(1, 0, At, B0); PG8_BAR; PG8_SCHED;
            PG8_STAGE(PG8_SB(1, 1), b3 + hstep, voffB);
            PG8_WAIT_V(6); PG8_BAR; PG8_MMA(1, 1, At, B1); PG8_BAR;
            }
        }
        if constexpr (ALIGN_EPI) { if (wr == 0) PG8_BAR; }
        if constexpr (!Epi::AFTER_DRAIN) { E(acc, cur, wr, wc, fr, fq); S.done(cur); }
        if (!has_next) break;
#pragma unroll
        for (int a = 0; a < 2; ++a)
#pragma unroll
            for (int b = 0; b < 2; ++b)
#pragma unroll
                for (int m = 0; m < 4; ++m)
#pragma unroll
                    for (int n = 0; n < 2; ++n) acc[a][b][m][n] = (f32x4){0.f, 0.f, 0.f, 0.f};
        cur = nxt; cA = nA; cB = nB; ++ui;
        if constexpr (ALIGN_EPI) { if (wr == 1) PG8_BAR; }
    }
    PG8_WAIT_V(0);
    if constexpr (!ALIGN_EPI) { if (wr == 0) PG8_BAR; }
    PG8_BAR;
    if constexpr (Epi::AFTER_DRAIN) { E.fused(acc, cur, wr, wc, fr, fq, lds, wid, lane); S.done(cur); }
#undef PG8_SA
#undef PG8_SB
#undef PG8_STAGE
#undef PG8_LDA
#undef PG8_LDB
#undef PG8_MMA
#undef PG8_WAIT_V
#undef PG8_WAIT_L
#undef PG8_BAR
#undef PG8_SCHED
}
}
#define LAS __attribute__((address_space(3)))
typedef unsigned short bf16;
typedef unsigned v4u __attribute__((ext_vector_type(4)));
typedef unsigned v2u __attribute__((ext_vector_type(2)));
typedef float f32x4 __attribute__((ext_vector_type(4)));
typedef float f32x2v __attribute__((ext_vector_type(2)));
typedef short bf16x8 __attribute__((ext_vector_type(8)));
#ifndef REPMASK
#define REPMASK 0
#endif
#ifndef MK_COOP
#define MK_COOP 1
#endif
constexpr int NWAVES = 8, NPHASE = 10;
constexpr int PP = 1536;
constexpr int MP = 16384, MS = 512, M = MP + MS, D = 1024, DIN = 2048, DFF = 2816, DUP = 5632, NBATCH = 136, NMOD = 6144;
constexpr float EPS = 1e-6f;
constexpr size_t MiB = 1u << 20;
constexpr size_t WS_CTL = 0, CTL_ZERO_BYTES = 1 * MiB, WS_MOD = 1 * MiB, WS_WIN = 5 * MiB, WS_WOUT = 9 * MiB, WS_WUP = 11 * MiB, WS_WDN = 22 * MiB, WS_EDGE = 28 * MiB,
                 WS_H = 34 * MiB, WS_DY = 67 * MiB, WS_PROJ = 100 * MiB, WS_MIX = 100 * MiB, WS_G = 67 * MiB, WS_F = 160 * MiB, WS_XB = 228 * MiB, WS_PART = 200 * MiB  , WS_X1 = 168 * MiB  , WS_END = 256 * MiB;
constexpr int CNT_BANK_WORDS = 64 * 64;
constexpr size_t O_Y = 0, O_NPP = 17301504, O_NCP = 17362944, O_NFP = 17371136, O_NPS = 17461248, O_NCS = 18444288, O_NFS = 18575360, O_END = 20017152;
constexpr int RING_BYTES = 131072, EB_OFF = 131072, LDS_BYTES = 147456;
#define LDS_WAIT() asm volatile("s_waitcnt lgkmcnt(0)" ::: "memory")

__device__ __forceinline__ unsigned f2bf(float f) { unsigned u = __builtin_bit_cast(unsigned, f); return (u + 0x7fffu + ((u >> 16) & 1u)) >> 16; }
__device__ __forceinline__ unsigned pk2(float lo, float hi) { unsigned r; asm("v_cvt_pk_bf16_f32 %0, %1, %2" : "=v"(r) : "v"(lo), "v"(hi)); return r; }
__device__ __forceinline__ void unpack8(v4u v, float (&f)[8]) {
    f[0] = __builtin_bit_cast(float, v.x << 16); f[1] = __builtin_bit_cast(float, v.x & 0xffff0000u);
    f[2] = __builtin_bit_cast(float, v.y << 16); f[3] = __builtin_bit_cast(float, v.y & 0xffff0000u);
    f[4] = __builtin_bit_cast(float, v.z << 16); f[5] = __builtin_bit_cast(float, v.z & 0xffff0000u);
    f[6] = __builtin_bit_cast(float, v.w << 16); f[7] = __builtin_bit_cast(float, v.w & 0xffff0000u);
}
__device__ __forceinline__ v4u pack8(const float (&f)[8]) { v4u o; o.x = pk2(f[0], f[1]); o.y = pk2(f[2], f[3]); o.z = pk2(f[4], f[5]); o.w = pk2(f[6], f[7]); return o; }
__device__ __forceinline__ float wave_sum(float v) {
#pragma unroll
    for (int o = 1; o < 64; o <<= 1) v += __shfl_xor(v, o);
    return v;
}
__device__ __forceinline__ float silu_f(float a) { return a * __builtin_amdgcn_rcpf(1.0f + __expf(-a)); }

struct Args { const float* in[21]; float* out; unsigned char* ws; int ph_lo, ph_hi; };
enum { I_XP = 0, I_XS, I_SPOOL, I_SCONV, I_SFFN, I_CP, I_CS, I_WADA, I_BADA, I_GPREMIX, I_GPOSTMIX, I_GPREFFN, I_GPOSTFFN, I_WIN, I_POOLW, I_POOLS, I_CONVW, I_WOUT, I_WUP, I_FCONVW, I_WDN };

__device__ __forceinline__ const float* xrow(const Args& a, int m) { return m < MP ? a.in[I_XP] + (size_t)m * D : a.in[I_XS] + (size_t)(m - MP) * D; }
__device__ __forceinline__ int batch_of(int m) { return m < MP ? (m >> 11) : 8 + ((m - MP) >> 2); }

__device__ __forceinline__ void tr_item(const float* W, int ldw, int k0, int n0, bf16* WT, int ldt, int drow0, int dk0, LAS float* scr, int lane) {
    float tv[64];
#pragma unroll
    for (int i = 0; i < 64; ++i) tv[i] = W[(size_t)(k0 + i) * ldw + n0 + lane];
    __builtin_amdgcn_sched_barrier(0);
#pragma unroll
    for (int i = 0; i < 64; ++i) scr[i * 65 + lane] = tv[i];
    LDS_WAIT(); asm volatile("" ::: "memory");
    const int c = lane & 7;
#pragma unroll
    for (int j = 0; j < 8; ++j) { const int n = (lane >> 3) + 8 * j; const LAS float* sp = scr + (8 * c) * 65 + n;
        v4u o; o.x = pk2(sp[0 * 65], sp[1 * 65]); o.y = pk2(sp[2 * 65], sp[3 * 65]); o.z = pk2(sp[4 * 65], sp[5 * 65]); o.w = pk2(sp[6 * 65], sp[7 * 65]);
        *(v4u*)(WT + (size_t)(drow0 + n) * ldt + dk0 + 8 * c) = o; }
    LDS_WAIT(); asm volatile("" ::: "memory");
}

__device__ __forceinline__ void weight_items(const Args& a, LAS unsigned char* lds, int lane, int wave, int it0, int step, int cnt, int lim);
__device__ __forceinline__ void p0_prologue(const Args& a, LAS unsigned char* lds, int tid, int lane, int wave) {
    unsigned char* ws = a.ws;
    bf16* Win_t = (bf16*)(ws + WS_WIN); bf16* Wout_t = (bf16*)(ws + WS_WOUT); bf16* Wup_t = (bf16*)(ws + WS_WUP); bf16* Wdn_t = (bf16*)(ws + WS_WDN);
    float* mod = (float*)(ws + WS_MOD);
    const int G = gridDim.x, gw = blockIdx.x * NWAVES + wave, NGW = G * NWAVES;
    for (int i = blockIdx.x * 512 + tid; i < 16384; i += G * 512) ((unsigned*)(ws + WS_CTL))[i] = 0u;
    {
        LAS float* red = (LAS float*)lds;
        const int fr = lane & 15, fq = lane >> 4;
        for (int wi = blockIdx.x; wi < NMOD / 32; wi += G) {
            const int n0 = wi * 32, kb = wave * 128 + fq * 8;
            f32x4 acc[9][2];
#pragma unroll
            for (int rb = 0; rb < 9; ++rb) { acc[rb][0] = (f32x4){0.f, 0.f, 0.f, 0.f}; acc[rb][1] = acc[rb][0]; }
            LAS unsigned char* sa = lds + 32768 + wave * 12288;
            const int arow = lane >> 3, akk = (lane & 7) * 4;
            f32x2v wn[8];
#pragma unroll
            for (int i = 0; i < 8; ++i) wn[i] = *(const f32x2v*)(a.in[I_WADA] + (size_t)(kb + i) * NMOD + n0 + 2 * fr);
#pragma unroll 1
            for (int ks = 0; ks < 4; ++ks) {
                float wv[2][8];
#pragma unroll
                for (int i = 0; i < 8; ++i) { wv[0][i] = wn[i].x; wv[1][i] = wn[i].y; }
                { const int k1 = kb + (ks < 3 ? ks + 1 : 3) * 32;
#pragma unroll
                  for (int i = 0; i < 8; ++i) wn[i] = *(const f32x2v*)(a.in[I_WADA] + (size_t)(k1 + i) * NMOD + n0 + 2 * fr); }
                f32x4 cl[18];
#pragma unroll
                for (int j = 0; j < 18; ++j) { int row = 8 * j + arow; row = row < NBATCH ? row : NBATCH - 1;
                    cl[j] = *(const f32x4*)((row < 8 ? a.in[I_CP] + (size_t)row * D : a.in[I_CS] + (size_t)(row - 8) * D) + wave * 128 + ks * 32 + akk); }
                __builtin_amdgcn_sched_barrier(0);
#pragma unroll
                for (int j = 0; j < 18; ++j) { v2u w; w.x = pk2(silu_f(cl[j].x), silu_f(cl[j].y)); w.y = pk2(silu_f(cl[j].z), silu_f(cl[j].w));
                    *(LAS v2u*)(sa + (8 * j + arow) * 80 + akk * 2) = w; }
                const bf16x8 b0 = __builtin_bit_cast(bf16x8, pack8(wv[0])), b1 = __builtin_bit_cast(bf16x8, pack8(wv[1]));
                LDS_WAIT(); asm volatile("" ::: "memory");
#pragma unroll
                for (int rb = 0; rb < 9; ++rb) {
                    const bf16x8 af = *(const LAS bf16x8*)(sa + (rb * 16 + fr) * 80 + fq * 16);
                    acc[rb][0] = __builtin_amdgcn_mfma_f32_16x16x32_bf16(b0, af, acc[rb][0], 0, 0, 0);
                    acc[rb][1] = __builtin_amdgcn_mfma_f32_16x16x32_bf16(b1, af, acc[rb][1], 0, 0, 0);
                }
                LDS_WAIT(); asm volatile("" ::: "memory");
            }
            __syncthreads();
#pragma unroll
            for (int st = 4; st >= 1; st >>= 1) {
                LAS float* slot = (LAS float*)(lds + 32768) + (wave & (st - 1)) * (18 * 256);
                if (wave >= st && wave < 2 * st) {
#pragma unroll
                    for (int rb = 0; rb < 9; ++rb)
#pragma unroll
                        for (int cb = 0; cb < 2; ++cb)
#pragma unroll
                            for (int e = 0; e < 4; ++e) slot[((rb * 2 + cb) * 4 + e) * 64 + lane] = acc[rb][cb][e];
                }
                __syncthreads();
                if (wave < st) {
#pragma unroll
                    for (int rb = 0; rb < 9; ++rb)
#pragma unroll
                        for (int cb = 0; cb < 2; ++cb)
#pragma unroll
                            for (int e = 0; e < 4; ++e) acc[rb][cb][e] += slot[((rb * 2 + cb) * 4 + e) * 64 + lane];
                }
                __syncthreads();
            }
            if (wave == 0) {
#pragma unroll
                for (int rb = 0; rb < 9; ++rb) { const int row = rb * 16 + fr, col = n0 + 8 * fq;
                    const f32x4 lo = (f32x4){acc[rb][0][0], acc[rb][1][0], acc[rb][0][1], acc[rb][1][1]} + *(const f32x4*)(a.in[I_BADA] + col);
                    const f32x4 hi = (f32x4){acc[rb][0][2], acc[rb][1][2], acc[rb][0][3], acc[rb][1][3]} + *(const f32x4*)(a.in[I_BADA] + col + 4);
                    if (row < NBATCH) { *(f32x4*)(mod + (size_t)row * NMOD + col) = lo; *(f32x4*)(mod + (size_t)row * NMOD + col + 4) = hi; } }
            }
            __syncthreads();
        }
    }
    if (G == 256) { if (blockIdx.x >= 192) weight_items(a, lds, lane, wave, ((int)blockIdx.x - 192) * 8 + wave, 512, 6, 2688); }
    else weight_items(a, lds, lane, wave, gw, NGW, (4800 + NGW - 1) / NGW, 4800);
}

__device__ __forceinline__ void weight_items(const Args& a, LAS unsigned char* lds, int lane, int wave, int it0, int step, int cnt, int lim) {
    unsigned char* ws = a.ws;
    bf16* Win_t = (bf16*)(ws + WS_WIN); bf16* Wout_t = (bf16*)(ws + WS_WOUT); bf16* Wup_t = (bf16*)(ws + WS_WUP); bf16* Wdn_t = (bf16*)(ws + WS_WDN);
    LAS float* scr = (LAS float*)(lds + wave * 17408);
    constexpr int I_FOLD = 2048, I_IN = 16 * 32, I_OUT = 8 * 16, I_UP = 16 * 88;
        for (int ii = 0; ii < cnt; ++ii) {
            int r = it0 + ii * step; if (r >= lim) break;
            if (r < I_FOLD) {
                const int k0 = (r >> 6) * 16, n0 = (r & 63) * 16, gb = (k0 >> 7) * 128, rr = lane & 15, q = lane >> 4;
                f32x4 pw[8], ps[8]; float wo[32];
                const f32x4* pwp = (const f32x4*)(a.in[I_POOLW] + (size_t)(k0 + rr) * 128 + q * 32); const f32x4* psp = (const f32x4*)(a.in[I_POOLS] + gb + q * 32);
#pragma unroll
                for (int i = 0; i < 8; ++i) { pw[i] = pwp[i]; ps[i] = psp[i]; }
#pragma unroll
                for (int sidx = 0; sidx < 32; ++sidx) wo[sidx] = a.in[I_WOUT][(size_t)(gb + q * 32 + sidx) * D + n0 + rr];
                __builtin_amdgcn_sched_barrier(0);
                f32x4 acc = (f32x4){0.f, 0.f, 0.f, 0.f};
#pragma unroll
                for (int sidx = 0; sidx < 32; ++sidx) acc = __builtin_amdgcn_mfma_f32_16x16x4f32(pw[sidx >> 2][sidx & 3], ps[sidx >> 2][sidx & 3] * wo[sidx], acc, 0, 0, 0);
                v2u o; o.x = pk2(acc[0], acc[1]); o.y = pk2(acc[2], acc[3]);
                *(v2u*)(Wout_t + (size_t)(n0 + rr) * D + k0 + 4 * q) = o;
                continue;
            } r -= I_FOLD;
            if (r < I_IN) { const int kb = r / 32, nb = r % 32, n0 = 64 * nb;
                const int jx = (n0 - 512) & 511, drow0 = n0 < 512 ? n0 : (n0 < 1024 ? 1024 + (jx >> 7) * 256 + (jx & 127) : (n0 < 1536 ? n0 - 512 : 1024 + (((n0 - 1536) >> 7) * 256) + 128 + ((n0 - 1536) & 127)));
                tr_item(a.in[I_WIN], DIN, 64 * kb, n0, Win_t, D, drow0, 64 * kb, scr, lane); continue; } r -= I_IN;
            if (r < I_OUT) { const int kb = r / 16, nb = r % 16; tr_item(a.in[I_WOUT] + (size_t)512 * D, D, 64 * kb, 64 * nb, Wout_t, D, 64 * nb, 512 + 64 * kb, scr, lane); continue; } r -= I_OUT;
            if (r < I_UP) { const int kb = r / 88, nb = r % 88, n0 = 64 * nb;
                const int drow0 = n0 < DFF ? (n0 / 128) * 256 + (n0 % 128) : ((n0 - DFF) / 128) * 256 + 128 + ((n0 - DFF) % 128);
                tr_item(a.in[I_WUP], DUP, 64 * kb, n0, Wup_t, D, drow0, 64 * kb, scr, lane); continue; } r -= I_UP;
            { const int kb = r / 16, nb = r % 16; tr_item(a.in[I_WDN], D, 64 * kb, 64 * nb, Wdn_t, DFF, 64 * nb, 64 * kb, scr, lane); }
        }
}

__device__ __forceinline__ void p1_norm(const Args& a, int lane, int wave) {
    bf16* H = (bf16*)(a.ws + WS_H); const float* mod = (const float*)(a.ws + WS_MOD);
    const int gw = blockIdx.x * NWAVES + wave, NGW = gridDim.x * NWAVES;
    for (int mb = gw; mb < M; mb += 4 * NGW) {
        f32x4 v[4][4];
#pragma unroll
        for (int r = 0; r < 4; ++r) { const int m = mb + r * NGW; const float* xr = xrow(a, m < M ? m : mb);
#pragma unroll
            for (int j = 0; j < 4; ++j) v[r][j] = *(const f32x4*)(xr + 4 * lane + 256 * j); }
        __builtin_amdgcn_sched_barrier(0);
#pragma unroll
        for (int r = 0; r < 4; ++r) {
            const int m = mb + r * NGW; if (m >= M) break;
            const float* md = mod + (size_t)batch_of(m) * NMOD;
            float ss = 0.f;
#pragma unroll
            for (int j = 0; j < 4; ++j) ss += (v[r][j].x * v[r][j].x + v[r][j].y * v[r][j].y) + (v[r][j].z * v[r][j].z + v[r][j].w * v[r][j].w);
            const float rstd = 1.0f / sqrtf(wave_sum(ss) * (1.0f / D) + EPS);
#pragma unroll
            for (int j = 0; j < 4; ++j) { const int col = 4 * lane + 256 * j;
                const f32x4 g = *(const f32x4*)(a.in[I_GPREMIX] + col), sc = *(const f32x4*)(md + 1024 + col), sh = *(const f32x4*)(md + col);
                const f32x4 o = v[r][j] * rstd * g * (1.0f + sc) + sh;
                v2u w; w.x = pk2(o.x, o.y); w.y = pk2(o.z, o.w); *(v2u*)(H + (size_t)m * D + col) = w; }
        }
    }
}

__device__ __forceinline__ void ldpart8(const float* part, size_t sstride, int nsl, size_t off, float (&v)[8]) {
    f32x4 a = (f32x4){0.f, 0.f, 0.f, 0.f}, b = a;
    for (int sl = 0; sl < nsl; ++sl) { a += *(const f32x4*)(part + sl * sstride + off); b += *(const f32x4*)(part + sl * sstride + off + 4); }
    v[0] = a.x; v[1] = a.y; v[2] = a.z; v[3] = a.w; v[4] = b.x; v[5] = b.y; v[6] = b.z; v[7] = b.w;
}
__device__ __forceinline__ void st8(float* o, const float (&v)[8]) { *(f32x4*)o = (f32x4){v[0], v[1], v[2], v[3]}; *(f32x4*)(o + 4) = (f32x4){v[4], v[5], v[6], v[7]}; }
__device__ __forceinline__ void ld8(const float* p, float (&v)[8]) { const f32x4 a = *(const f32x4*)p, b = *(const f32x4*)(p + 4); v[0] = a.x; v[1] = a.y; v[2] = a.z; v[3] = a.w; v[4] = b.x; v[5] = b.y; v[6] = b.z; v[7] = b.w; }
template <int W>
__device__ __forceinline__ void pool_pair(const bf16* PROJ, bf16* DY, float* npp, const int (&rows)[2], int j0, bool hasB) {
    v4u cv[2], hv[2][W - 1];
#pragma unroll
    for (int r = 0; r < 2; ++r) { const int t = rows[r] & 2047; const bf16* pr = PROJ + (size_t)rows[r] * PP + j0; cv[r] = *(const v4u*)pr;
#pragma unroll
        for (int i = 1; i < W; ++i) hv[r][i - 1] = *(const v4u*)(pr - (size_t)(i <= t ? i : 0) * PP); }
    __builtin_amdgcn_sched_barrier(0);
#pragma unroll
    for (int r = 0; r < 2; ++r) { if (r == 1 && !hasB) break;
        const int m = rows[r], b = m >> 11, t = m & 2047; float cur[8], s[8];
        unpack8(cv[r], cur);
#pragma unroll
        for (int e = 0; e < 8; ++e) s[e] = cur[e];
#pragma unroll
        for (int i = 1; i < W; ++i) { float tmp[8]; unpack8(hv[r][i - 1], tmp);
#pragma unroll
            for (int e = 0; e < 8; ++e) s[e] += (i <= t) ? tmp[e] : 0.f; }
        const float inv = 1.0f / (float)((t + 1) < W ? (t + 1) : W); float d[8];
        if (t >= 2033) st8(npp + (size_t)(b * 15 + (t - 2033)) * 512 + j0, cur);
#pragma unroll
        for (int e = 0; e < 8; ++e) d[e] = s[e] * inv - cur[e];
        *(v4u*)(DY + (size_t)m * D + j0) = pack8(d); }
}
__device__ __forceinline__ void p3_mixer(const Args& a, int tid) {
    const bf16* PROJ = (const bf16*)(a.ws + WS_PROJ); bf16* DY = (bf16*)(a.ws + WS_DY);
    const float* PART = (const float*)(a.ws + WS_PART); constexpr size_t PS = (size_t)MS * DIN;
    float* npp = a.out + O_NPP; float* ncp = a.out + O_NCP; float* nps = a.out + O_NPS; float* ncs = a.out + O_NCS;
    const long NT = (long)gridDim.x * 512;
    for (long it = (long)blockIdx.x * 512 + tid; it < (long)MP * 128; it += 2 * NT) {
        const int q = (int)(it & 127), mA = (int)(it >> 7); const bool hasB = (it + NT) < (long)MP * 128; const int mB = hasB ? (int)((it + NT) >> 7) : mA;
        const int mm[2] = {mA, mB};
        if (q < 64) {
            const int g = mA & 3, j0 = g * 128 + (q & 15) * 8;
            const int rows[2] = {(mA & ~3) + (q >> 4), (mB & ~3) + (q >> 4)};
            if (g == 0) pool_pair<2>(PROJ, DY, npp, rows, j0, hasB);
            else if (g == 1) pool_pair<4>(PROJ, DY, npp, rows, j0, hasB);
            else if (g == 2) pool_pair<8>(PROJ, DY, npp, rows, j0, hasB);
            else pool_pair<16>(PROJ, DY, npp, rows, j0, hasB);
        } else {
            const int j0 = 8 * (q - 64);
            v4u rcx[2][3], rb[2];
#pragma unroll
            for (int r = 0; r < 2; ++r) { const int t = mm[r] & 2047; const bf16* pr = PROJ + (size_t)mm[r] * PP + j0; rb[r] = *(const v4u*)(pr + 512);
#pragma unroll
                for (int k = 0; k < 3; ++k) { const int kk = t >= k ? k : 0; rcx[r][k] = *(const v4u*)(pr - (size_t)kk * PP + 1024); } }
            const float* cwp = a.in[I_CONVW] + j0; float w0[8], w1[8], w2[8];
            ld8(cwp, w0); ld8(cwp + 512, w1); ld8(cwp + 1024, w2);
            __builtin_amdgcn_sched_barrier(0);
#pragma unroll
            for (int r = 0; r < 2; ++r) { if (r == 1 && !hasB) break;
                const int m = mm[r], b = m >> 11, t = m & 2047; float bv[8], cx[3][8], y[8];
                unpack8(rb[r], bv);
#pragma unroll
                for (int k = 0; k < 3; ++k) { float c2[8]; unpack8(rcx[r][k], c2);
#pragma unroll
                    for (int e = 0; e < 8; ++e) cx[k][e] = t >= k ? c2[e] : 0.f; }
#pragma unroll
                for (int e = 0; e < 8; ++e) y[e] = bv[e] * (w0[e] * cx[2][e] + w1[e] * cx[1][e] + w2[e] * cx[0][e]);
                *(v4u*)(DY + (size_t)m * D + 512 + j0) = pack8(y);
                if (t >= 2046) st8(ncp + (size_t)(b * 2 + t - 2046) * 512 + j0, cx[0]); }
        }
    }
    for (long it = (long)MP * 128 + (long)blockIdx.x * 512 + tid; it < (long)M * 128; it += NT) {
        const int m = (int)(it >> 7), q = (int)(it & 127);
        {
            const int sr = m - MP, b = sr >> 2, t = sr & 3;
            if (q < 64) {
                const int j0 = 8 * q, w = 2 << (j0 >> 7);
                float cur[8], s[8];
                ldpart8(PART, PS, 4, (size_t)sr * DIN + j0, cur);
#pragma unroll
                for (int e = 0; e < 8; ++e) s[e] = cur[e];
                for (int i = 1; i < w; ++i) { float tmp[8];
                    if (t - i >= 0) ldpart8(PART, PS, 4, (size_t)(sr - i) * DIN + j0, tmp); else ld8(a.in[I_SPOOL] + (size_t)(b * 15 + 15 + t - i) * 512 + j0, tmp);
#pragma unroll
                    for (int e = 0; e < 8; ++e) s[e] += tmp[e]; }
                st8(nps + (size_t)(b * 15 + 11 + t) * 512 + j0, cur);
                for (int i = t; i < 11; i += 4) { float tmp[8]; ld8(a.in[I_SPOOL] + (size_t)(b * 15 + i + 4) * 512 + j0, tmp); st8(nps + (size_t)(b * 15 + i) * 512 + j0, tmp); }
                const float inv = 1.0f / (float)w; float d[8];
#pragma unroll
                for (int e = 0; e < 8; ++e) d[e] = s[e] * inv - cur[e];
                *(v4u*)(DY + (size_t)m * D + j0) = pack8(d);
            } else {
                const int j0 = 8 * (q - 64);
                float xv[8], bv[8], cv[8], cx[3][8];
                const int xcol = 1024 + (j0 >> 7) * 256 + (j0 & 127);
                ldpart8(PART, PS, 4, (size_t)sr * DIN + 512 + j0, bv);
#pragma unroll
                for (int k = 0; k < 3; ++k) {
                    if (t - k >= 0) { ldpart8(PART, PS, 4, (size_t)(sr - k) * DIN + xcol, xv); ldpart8(PART, PS, 4, (size_t)(sr - k) * DIN + xcol + 128, cv);
#pragma unroll
                        for (int e = 0; e < 8; ++e) cx[k][e] = cv[e] * xv[e]; }
                    else ld8(a.in[I_SCONV] + (size_t)(b * 2 + 2 + t - k) * 512 + j0, cx[k]);
                }
                const float* cwp = a.in[I_CONVW] + j0; float w0[8], w1[8], w2[8], y[8];
                ld8(cwp, w0); ld8(cwp + 512, w1); ld8(cwp + 1024, w2);
#pragma unroll
                for (int e = 0; e < 8; ++e) y[e] = bv[e] * (w0[e] * cx[2][e] + w1[e] * cx[1][e] + w2[e] * cx[0][e]);
                *(v4u*)(DY + (size_t)m * D + 512 + j0) = pack8(y);
                if (t >= 2) st8(ncs + (size_t)(b * 2 + t - 2) * 512 + j0, cx[0]);
            }
        }
    }
}

__device__ __forceinline__ void p5_rowwise1(const Args& a, int lane, int wave, unsigned* done_cnt) {
    const float* MIX = (const float*)(a.ws + WS_MIX); bf16* H = (bf16*)(a.ws + WS_H); const float* mod = (const float*)(a.ws + WS_MOD); float* Y = a.out + O_Y;
    const int gw = blockIdx.x * NWAVES + wave, NGW = gridDim.x * NWAVES;
    int m0 = MP + gw, mstep = NGW;
    if (gridDim.x == 256) { m0 = blockIdx.x >= 192 ? MP + ((int)blockIdx.x - 192) * NWAVES + wave : M; mstep = M; }
    for (int m = m0; m < M; m += mstep) {
        const float* xr = xrow(a, m); const float* md = mod + (size_t)batch_of(m) * NMOD; const float* mr = (const float*)(a.ws + WS_PART) + (size_t)(m - MP) * D;
        f32x4 v[4]; float ss = 0.f;
#pragma unroll
        for (int j = 0; j < 4; ++j) { v[j] = (*(const f32x4*)(mr + 4 * lane + 256 * j) + *(const f32x4*)(mr + (size_t)MS * D + 4 * lane + 256 * j)) + (*(const f32x4*)(mr + 2 * (size_t)MS * D + 4 * lane + 256 * j) + *(const f32x4*)(mr + 3 * (size_t)MS * D + 4 * lane + 256 * j)); ss += (v[j].x * v[j].x + v[j].y * v[j].y) + (v[j].z * v[j].z + v[j].w * v[j].w); }
        const float r1 = 1.0f / sqrtf(wave_sum(ss) * (1.0f / D) + EPS);
        float s2 = 0.f;
#pragma unroll
        for (int j = 0; j < 4; ++j) { const int col = 4 * lane + 256 * j;
            const f32x4 x = *(const f32x4*)(xr + col), g = *(const f32x4*)(a.in[I_GPOSTMIX] + col), gt = *(const f32x4*)(md + 2048 + col);
            v[j] = x + gt * (v[j] * r1 * g);
            *(f32x4*)(Y + (size_t)m * D + col) = v[j];
            s2 += (v[j].x * v[j].x + v[j].y * v[j].y) + (v[j].z * v[j].z + v[j].w * v[j].w); }
        const float r2 = 1.0f / sqrtf(wave_sum(s2) * (1.0f / D) + EPS);
#pragma unroll
        for (int j = 0; j < 4; ++j) { const int col = 4 * lane + 256 * j;
            const f32x4 g = *(const f32x4*)(a.in[I_GPREFFN] + col), sc = *(const f32x4*)(md + 4096 + col), sh = *(const f32x4*)(md + 3072 + col);
            const f32x4 o = v[j] * r2 * g * (1.0f + sc) + sh;
            v2u w; w.x = pk2(o.x, o.y); w.y = pk2(o.z, o.w); *(v2u*)(H + (size_t)m * D + col) = w; }
        __threadfence();
        if (lane == 0) __hip_atomic_fetch_add(done_cnt, 1u, __ATOMIC_RELAXED, __HIP_MEMORY_SCOPE_AGENT);
    }
}

__device__ __forceinline__ void fixup_tile(const Args& a, int pm, int tid) {
    if ((pm & 7) == 0 || pm >= 64) return;
    const float* edge = (const float*)(a.ws + WS_EDGE); bf16* Gb = (bf16*)(a.ws + WS_G); const float* cw = a.in[I_FCONVW];
    for (int idx = tid; idx < DFF; idx += 512) {
        const int pn = idx >> 7, rho = idx & 127;
        const float* et = edge + (size_t)(pm * 22 + pn) * 1024; const float* eb = edge + (size_t)((pm - 1) * 22 + pn) * 1024 + 512;
        float u0[2], u1[2];
#pragma unroll
        for (int h = 0; h < 2; ++h) { const int tc = rho + 128 * h, c = h * DFF + idx;
            const float pb0 = eb[tc], pb1 = eb[256 + tc], t0 = et[tc], t1 = et[256 + tc];
            const float w0 = cw[c], w1 = cw[DUP + c], w2 = cw[2 * DUP + c];
            u0[h] = w0 * pb0 + w1 * pb1 + w2 * t0; u1[h] = w0 * pb1 + w1 * t0 + w2 * t1; }
        Gb[(size_t)(pm * 256) * DFF + idx] = (bf16)f2bf(silu_f(u0[0]) * u0[1]);
        Gb[(size_t)(pm * 256 + 1) * DFF + idx] = (bf16)f2bf(silu_f(u1[0]) * u1[1]);
    }
}

__device__ __forceinline__ void p9_rows(const Args& a, int lane, int m0, int m1, int mstep) {
    const float* Fb = (const float*)(a.ws + WS_F); const float* mod = (const float*)(a.ws + WS_MOD); float* Y = a.out + O_Y;
    for (int m = m0; m < m1; m += mstep) {
        const float* md = mod + (size_t)batch_of(m) * NMOD; const float* fr = (const float*)(a.ws + WS_PART) + (size_t)(m - MP) * D;
        f32x4 v[4]; float ss = 0.f;
#pragma unroll
        for (int j = 0; j < 4; ++j) { v[j] = *(const f32x4*)(fr + 4 * lane + 256 * j);
#pragma unroll
            for (int sl = 1; sl < 11; ++sl) v[j] += *(const f32x4*)(fr + sl * (size_t)MS * D + 4 * lane + 256 * j); ss += (v[j].x * v[j].x + v[j].y * v[j].y) + (v[j].z * v[j].z + v[j].w * v[j].w); }
        const float r1 = 1.0f / sqrtf(wave_sum(ss) * (1.0f / D) + EPS);
#pragma unroll
        for (int j = 0; j < 4; ++j) { const int col = 4 * lane + 256 * j;
            const f32x4 x = *(const f32x4*)(Y + (size_t)m * D + col), g = *(const f32x4*)(a.in[I_GPOSTFFN] + col), gt = *(const f32x4*)(md + 5120 + col);
            *(f32x4*)(Y + (size_t)m * D + col) = x + gt * (v[j] * r1 * g); }
    }
}

template <int NI, int NJ, int U>
__device__ __forceinline__ void sgemm_block(f32x4 (&acc)[NI][NJ], const bf16* ap, const bf16* bp, int K) {
    bf16x8 af[U][NI], bfr[U][NJ];
#pragma unroll
    for (int u = 0; u < U; ++u) {
#pragma unroll
        for (int i = 0; i < NI; ++i) af[u][i] = *(const bf16x8*)(ap + (size_t)i * 16 * K + u * 32);
#pragma unroll
        for (int j = 0; j < NJ; ++j) bfr[u][j] = *(const bf16x8*)(bp + (size_t)j * 16 * K + u * 32);
    }
    __builtin_amdgcn_sched_barrier(0);
#pragma unroll
    for (int u = 0; u < U; ++u)
#pragma unroll
        for (int i = 0; i < NI; ++i)
#pragma unroll
            for (int j = 0; j < NJ; ++j) acc[i][j] = __builtin_amdgcn_mfma_f32_16x16x32_bf16(bfr[u][j], af[u][i], acc[i][j], 0, 0, 0);
    __builtin_amdgcn_sched_barrier(0);
}
template <int NI, int NJ, int U, int NKS, class Epi>
__device__ __forceinline__ void sgemm_tile(const bf16* A, const bf16* Bt, int K, LAS unsigned char* lds, int tid, int lane, int wave, const Epi& epi) {
    LAS float* red = (LAS float*)lds;
    for (int i = tid; i < NI * NJ * 256; i += 512) red[i] = 0.f;
    __syncthreads();
    const int fr = lane & 15, fq = lane >> 4, kw = K / 8;
    const bf16* ap = A + (size_t)fr * K + wave * kw + fq * 8; const bf16* bp = Bt + (size_t)fr * K + wave * kw + fq * 8;
    f32x4 acc[NI][NJ];
#pragma unroll
    for (int i = 0; i < NI; ++i)
#pragma unroll
        for (int j = 0; j < NJ; ++j) acc[i][j] = (f32x4){0.f, 0.f, 0.f, 0.f};
#pragma unroll 1
    for (int ks = 0; ks + U <= NKS; ks += U) sgemm_block<NI, NJ, U>(acc, ap + ks * 32, bp + ks * 32, K);
    if constexpr (NKS % U != 0) sgemm_block<NI, NJ, NKS % U>(acc, ap + (NKS - NKS % U) * 32, bp + (NKS - NKS % U) * 32, K);
#pragma unroll
    for (int i = 0; i < NI; ++i)
#pragma unroll
        for (int j = 0; j < NJ; ++j)
#pragma unroll
            for (int e = 0; e < 4; ++e) __hip_atomic_fetch_add(red + ((i * NJ + j) * 4 + e) * 64 + lane, acc[i][j][e], __ATOMIC_RELAXED, __HIP_MEMORY_SCOPE_WORKGROUP);
    __syncthreads();
    for (int blk = wave; blk < NI * NJ; blk += 8) { const int i = blk / NJ, j = blk % NJ; const LAS float* rp = red + blk * 256 + lane; epi(i * 16 + fr, j * 16 + 4 * fq, (f32x4){rp[0], rp[64], rp[128], rp[192]}); }
    __syncthreads();
}

#define XB_TMO      128
#define XB_XCNT(j)  (256  + 64 * (j))
#define XB_XSUB(j)  (1280 + 64 * (j))
#define XB_XGEN(j)  (2304 + 64 * (j))
#define XB_TOP      3328
#define XB_TOPGEN   3392
#define XCD_BAR_WORDS 3456
#define XB_SPIN_CAP (1u << 18)

__device__ __forceinline__ unsigned xb_ld(unsigned* p)              { return __hip_atomic_load(p, __ATOMIC_RELAXED, __HIP_MEMORY_SCOPE_AGENT); }
__device__ __forceinline__ unsigned xb_add(unsigned* p, unsigned v) { return __hip_atomic_fetch_add(p, v, __ATOMIC_RELAXED, __HIP_MEMORY_SCOPE_AGENT); }
__device__ __forceinline__ unsigned xb_xcc_id() { return (unsigned)__builtin_amdgcn_s_getreg((3 << 11) | 20) & 0xFu; }
#define XB_SPIN(cond, bar) do { unsigned _sp = 0; while (cond) { __builtin_amdgcn_s_sleep(1); \
    if ((++_sp & 255u) == 0u) { if (xb_ld(&(bar)[XB_TMO])) break; if (_sp > XB_SPIN_CAP) { atomicAdd(&(bar)[XB_TMO], 1u); break; } } } } while (0)

struct XcdBarrier {
    unsigned* bar; unsigned x;
    volatile LAS unsigned* st;
};

__device__ __forceinline__ XcdBarrier xcd_barrier_post(unsigned* bar, volatile LAS unsigned* st) {
    XcdBarrier b; b.bar = bar; b.x = xb_xcc_id(); b.st = st;
    if (threadIdx.x == 0) (void)xb_add(&bar[XB_XCNT(b.x)], 1u);
    return b;
}
__device__ __forceinline__ void xcd_barrier_complete(unsigned* bar, unsigned x, unsigned& nloc, unsigned& nx) {
    const unsigned G = gridDim.x * gridDim.y * gridDim.z;
    unsigned sum, cnt, mine, sp = 0u;
    for (;;) {
        sum = 0u; cnt = 0u; mine = 0u;
#pragma unroll
        for (unsigned j = 0; j < 16; ++j) { const unsigned c = xb_ld(&bar[XB_XCNT(j)]); sum += c; cnt += (c > 0u) ? 1u : 0u; mine = (j == x) ? c : mine; }
        if (sum == G) break;
        __builtin_amdgcn_s_sleep(1);
        if ((++sp & 255u) == 0u) { if (xb_ld(&bar[XB_TMO])) break; if (sp > XB_SPIN_CAP) { atomicAdd(&bar[XB_TMO], 1u); break; } }
    }
    nloc = mine > 0u ? mine : 1u; nx = cnt > 0u ? cnt : 1u;
}

__device__ __forceinline__ void xcd_barrier(const XcdBarrier& b) {
    asm volatile("s_waitcnt vmcnt(0)" ::: "memory");
    __syncthreads();
    if (threadIdx.x == 0) {
        unsigned* bar = b.bar;
        __builtin_amdgcn_s_waitcnt(0);
        unsigned nloc = b.st[0], nx = b.st[1];
        if (nloc == 0u) { xcd_barrier_complete(bar, b.x, nloc, nx); b.st[0] = nloc; b.st[1] = nx; }
        const unsigned old = xb_add(&bar[XB_XSUB(b.x)], 1u);
        const unsigned gen = old / nloc;
        if (old + 1u == (gen + 1u) * nloc) {
            __builtin_amdgcn_fence(__ATOMIC_RELEASE, "agent");
            asm volatile("s_waitcnt vmcnt(0)" ::: "memory");
            const unsigned og = xb_add(&bar[XB_TOP], 1u);
            const unsigned tg = og / nx;
            if (og + 1u == (tg + 1u) * nx) xb_add(&bar[XB_TOPGEN], 1u);
            else XB_SPIN(xb_ld(&bar[XB_TOPGEN]) == tg, bar);
            __builtin_amdgcn_fence(__ATOMIC_ACQUIRE, "agent");
            xb_add(&bar[XB_XGEN(b.x)], 1u);
            asm volatile("s_waitcnt vmcnt(0)" ::: "memory");
        } else {
            XB_SPIN(xb_ld(&bar[XB_XGEN(b.x)]) == gen, bar);
            __builtin_amdgcn_fence(__ATOMIC_ACQUIRE, "agent");
            asm volatile("s_waitcnt vmcnt(0)" ::: "memory");
        }
    }
    __syncthreads();
}

__global__ void __launch_bounds__(NWAVES * 64, 2) fwd_mk(Args args) {
    extern __shared__ __attribute__((aligned(16))) unsigned char lds_raw[];
    LAS unsigned char* lds = (LAS unsigned char*)lds_raw;
    const int tid = threadIdx.x, lane = tid & 63, wave = __builtin_amdgcn_readfirstlane(tid >> 6);
    const int lo = args.ph_lo, hi = args.ph_hi, G = gridDim.x;
    unsigned char* ws = args.ws;
#define IN(k) (lo <= (k) && (k) < hi)
#define REP(k) for (int rep_ = 0; rep_ <= ((REPMASK >> (k)) & 1); ++rep_)
#define SEAM(k) do { if (IN(k) && IN((k) + 1)) xcd_barrier(bar); } while (0)
    volatile LAS unsigned* MISC = (volatile LAS unsigned*)(lds + EB_OFF + 12288);
    if (tid < 2) MISC[tid] = 0u;
    __syncthreads();
    XcdBarrier bar; bar.bar = (unsigned*)(ws + WS_CTL) + 16384; bar.x = 0; bar.st = MISC;
    if (hi - lo > 1) bar = xcd_barrier_post((unsigned*)(ws + WS_CTL) + 16384, MISC);
    if (lo < -1) cg::this_grid().sync();
    if (IN(0)) { p0_prologue(args, lds, tid, lane, wave); } SEAM(0);
    if (IN(1)) { p1_norm(args, lane, wave); } SEAM(1);
    if (IN(2)) {
        pg8::Gemm g{(const bf16*)(ws + WS_H), (const bf16*)(ws + WS_WIN), MP, DIN, D}; pg8::StaticOrder S; S.init(MP, DIN, G, (int)blockIdx.x);
        pg8::EpiProj E{(bf16*)(ws + WS_PROJ)};
        pg8::gemm_phase<pg8::EpiProj, pg8::StaticOrder, true, true>(lds, g, S, E);
        { pg8::Gemm gs{(const bf16*)(ws + WS_H), (const bf16*)(ws + WS_WIN), M, DIN, 256, D}; pg8::SliceOrder Ss{DIN / 256, 4, (int)blockIdx.x};
          pg8::EpiF32Part Es{(float*)(ws + WS_PART), DIN, (size_t)MS * DIN};
          pg8::gemm_phase<pg8::EpiF32Part, pg8::SliceOrder, true, true>(lds, gs, Ss, Es); }
        if (G == 256 && blockIdx.x >= 64) weight_items(args, lds, lane, wave, 2688 + ((int)blockIdx.x - 64) * 8 + wave, 1536, 1, 4096);
    } SEAM(2);
    if (IN(3)) { p3_mixer(args, tid); } SEAM(3);
    if (IN(4)) {
        { pg8::Gemm g{(const bf16*)(ws + WS_DY), (const bf16*)(ws + WS_WOUT), MP, D, D}; pg8::StaticOrder S; S.init(MP, D, G, (int)blockIdx.x);
          unsigned* ctl = (unsigned*)(ws + WS_CTL); unsigned* xb = (unsigned*)(ws + WS_XB);
          pg8::PanelRms st1{xb, ctl, EPS}, st2{xb + 65536, ctl + CNT_BANK_WORDS, EPS};
          pg8::EpiMixNorm E{args.in[I_XP], (bf16*)(ws + WS_X1), (bf16*)(ws + WS_H), (const float*)(ws + WS_MOD), args.in[I_GPOSTMIX], args.in[I_GPREFFN], st1, st2};
          if (G == 256) pg8::gemm_phase<pg8::EpiMixNorm, pg8::StaticOrder, false, true>(lds, g, S, E); }
        __syncthreads();
        { pg8::Gemm gs{(const bf16*)(ws + WS_DY), (const bf16*)(ws + WS_WOUT), M, D, 256, D}; pg8::SliceOrder Ss{D / 256, 4, (int)blockIdx.x};
          pg8::EpiF32Part Es{(float*)(ws + WS_PART), D, (size_t)MS * D};
          pg8::gemm_phase<pg8::EpiF32Part, pg8::SliceOrder, true, true>(lds, gs, Ss, Es); }
        if (G == 256 && blockIdx.x >= 32) weight_items(args, lds, lane, wave, 4096 + ((int)blockIdx.x - 32) * 8 + wave, 1792, 1, 4800);
    } SEAM(4);
    if (IN(6)) {
        unsigned* cnt5 = (unsigned*)(ws + WS_CTL) + 3 * CNT_BANK_WORDS + 64;
        p5_rowwise1(args, lane, wave, cnt5);
        pg8::Gemm g{(const bf16*)(ws + WS_H), (const bf16*)(ws + WS_WUP), M, DUP, D}; pg8::UpOrder S; S.init(M, DUP, G, (int)blockIdx.x); S.ready = cnt5; S.need = MS;
        pg8::EpiUpGate E{(bf16*)(ws + WS_G), args.in[I_FCONVW], args.in[I_SFFN], args.out + O_NFP, args.out + O_NFS, (float*)(ws + WS_EDGE), (LAS float*)(lds + EB_OFF)};
        pg8::gemm_phase<pg8::EpiUpGate, pg8::UpOrder, true, true>(lds, g, S, E);
    } SEAM(6);
    if (IN(8)) {
        { pg8::Gemm g{(const bf16*)(ws + WS_G), (const bf16*)(ws + WS_WDN), MP, D, DFF}; pg8::StaticOrder S; S.init(MP, D, G, (int)blockIdx.x);
          { pg8::Unit u; for (int i = 0; S.next(i, u); ++i) fixup_tile(args, u.pm, tid); asm volatile("s_waitcnt vmcnt(0)" ::: "memory"); __syncthreads(); }
          pg8::PanelRms st{(unsigned*)(ws + WS_XB) + 131072, (unsigned*)(ws + WS_CTL) + 2 * CNT_BANK_WORDS, EPS};
          pg8::EpiFfnNorm E{(const bf16*)(ws + WS_X1), args.out + O_Y, (const float*)(ws + WS_MOD), args.in[I_GPOSTFFN], st};
          if (G == 256) pg8::gemm_phase<pg8::EpiFfnNorm, pg8::StaticOrder, false, true>(lds, g, S, E); }
        __syncthreads();
        { pg8::Gemm gs{(const bf16*)(ws + WS_G), (const bf16*)(ws + WS_WDN), M, D, 256, DFF}; pg8::SliceOrder Ss{D / 256, 11, (int)blockIdx.x};
          pg8::EpiF32Part Es{(float*)(ws + WS_PART), D, (size_t)MS * D};
          pg8::gemm_phase<pg8::EpiF32Part, pg8::SliceOrder, true, true>(lds, gs, Ss, Es); }
    } SEAM(8);
    if (IN(9)) { const int gw = blockIdx.x * NWAVES + wave; p9_rows(args, lane, MP + gw, M, G * NWAVES); }
#undef IN
#undef SEAM
}

extern "C" void kernel_launch(void* const* d_in, const int* in_sizes, int n_in, void* d_out, int out_size, void* d_ws, size_t ws_size, hipStream_t stream) {
    static int grid = 0;
    if (grid == 0) {
        if (n_in != 21 || out_size != (int)O_END || ws_size < WS_END) { fprintf(stderr, "kernel_launch: unexpected shapes (n_in %d out %d ws %zu)\n", n_in, out_size, ws_size); grid = -1; return; }
        int dev = 0, cus = 0, per_cu = 0;
        hipGetDevice(&dev); hipDeviceGetAttribute(&cus, hipDeviceAttributeMultiprocessorCount, dev);
        if (hipFuncSetAttribute((const void*)fwd_mk, hipFuncAttributeMaxDynamicSharedMemorySize, LDS_BYTES) != hipSuccess) { fprintf(stderr, "kernel_launch: hipFuncSetAttribute failed\n"); grid = -1; return; }
        if (hipOccupancyMaxActiveBlocksPerMultiprocessor(&per_cu, (const void*)fwd_mk, NWAVES * 64, LDS_BYTES) != hipSuccess || per_cu < 1) { fprintf(stderr, "kernel_launch: occupancy query says %d\n", per_cu); per_cu = 1; }
        (void)hipGetLastError();
        grid = cus > 0 ? cus : 256;
    }
    if (grid < 0) return;
    if (hipMemsetAsync((char*)d_ws + WS_CTL + 65536, 0, 16384, stream) != hipSuccess) { fprintf(stderr, "kernel_launch: memset failed\n"); return; }
    Args a{};
    for (int i = 0; i < 21; ++i) a.in[i] = (const float*)d_in[i];
    a.out = (float*)d_out; a.ws = (unsigned char*)d_ws;
#if MK_COOP
    a.ph_lo = 0; a.ph_hi = NPHASE;
    void* kargs[] = {&a};
    hipError_t e = hipLaunchCooperativeKernel((const void*)fwd_mk, dim3(grid), dim3(NWAVES * 64), kargs, LDS_BYTES, stream);
    if (e != hipSuccess) fprintf(stderr, "kernel_launch: cooperative launch failed: %s (grid %d)\n", hipGetErrorString(e), grid);
#else
    for (int p = 0; p < NPHASE; ++p) for (int rep_ = 0; rep_ <= ((REPMASK >> p) & 1); ++rep_) { a.ph_lo = p; a.ph_hi = p + 1; hipLaunchKernelGGL(fwd_mk, dim3(grid), dim3(NWAVES * 64), LDS_BYTES, stream, a); }
#endif
}
```

```cpp
#include <hip/hip_runtime.h>
#include <hip/hip_cooperative_groups.h>
#include <cstdio>
#include <cstdint>
namespace cg = cooperative_groups;
namespace pg8 {
#define PG8_LAS __attribute__((address_space(3)))
typedef unsigned short bf16_t;
typedef short bf16x8 __attribute__((ext_vector_type(8)));
typedef float f32x4 __attribute__((ext_vector_type(4)));
typedef unsigned u32x4 __attribute__((ext_vector_type(4)));
constexpr int BM = 256, BK = 64, HALF = 128, HTB = HALF * BK * 2  , STAGE_BYTES = 8 * HTB, NXCD = 8, WGM = 8;

__host__ __device__ __forceinline__ int lds_byte(int r, int c) { const int st = (r >> 4) * 2 + (c >> 5), rr = r & 15, cc = c & 31, ob = rr * 64 + cc * 2; return st * 1024 + (ob ^ (((ob >> 9) & 1) << 5)); }
__host__ __device__ __forceinline__ void stage_rc(int b, int& R, int& C) { const int st = b / 1024, sb = b % 1024, swz = sb ^ (((sb >> 9) & 1) << 5); R = (st >> 1) * 16 + swz / 64; C = (st & 1) * 32 + (swz % 64) / 2; }
__host__ __device__ __forceinline__ int perm32(int rho) { const int n = rho >> 4, i = rho & 15; return 8 * (i >> 2) + 4 * n + (i & 3); }

struct Unit { int pm, pn, ks; };
struct Gemm { const bf16_t* A; const bf16_t* Bt; int M, N, K; int P = 0; };

struct StaticOrder {
    int nM, nN, nwg, G, c;
    __host__ __device__ void init(int M, int N, int G_, int c_) { nM = M / BM; nN = N / BM; nwg = nM * nN; G = G_; c = c_; }
    __host__ __device__ bool next(int i, Unit& u) const {
        const long L = (long)i * G + c; if (L >= nwg) return false;
        int wgid = (int)L; { const int q = nwg / NXCD, r = nwg % NXCD, xcd = wgid % NXCD, off = wgid / NXCD; wgid = (xcd < r ? xcd * (q + 1) : r * (q + 1) + (xcd - r) * q) + off; }
        const int nig = WGM * nN, gid = wgid / nig, fm = gid * WGM, gsz = (nM - fm) < WGM ? (nM - fm) : WGM;
        u.pm = fm + ((wgid % nig) % gsz); u.pn = (wgid % nig) / gsz; u.ks = 0; return true;
    }
    __device__ __forceinline__ void a_ready(const Unit&) const {}
    __device__ __forceinline__ void done(const Unit&) const {}
};

__device__ __forceinline__ unsigned cvt_pk_bf16(float lo, float hi) { unsigned r; asm volatile("v_cvt_pk_bf16_f32 %0, %1, %2" : "=v"(r) : "v"(lo), "v"(hi)); return r; }
typedef float f32x2 __attribute__((ext_vector_type(2)));
__device__ __forceinline__ f32x2 gelu_pk(f32x2 v) {
    const f32x2 av = __builtin_elementwise_abs(v), d = av * 0.2316418882f + 1.0f;
    f32x2 t; t.x = __builtin_amdgcn_rcpf(d.x); t.y = __builtin_amdgcn_rcpf(d.y);
    f32x2 q = t * 0.5307027145f + (-0.7265760135f); q = q * t + 0.7107068705f; q = q * t + (-0.142248368f); q = q * t + 0.127414796f; q = q * t;
    const f32x2 s = (v * v) * (-0.72134752044f);
    f32x2 e; e.x = __builtin_amdgcn_exp2f(s.x); e.y = __builtin_amdgcn_exp2f(s.y);
    const f32x2 m = v * (q * e), r = v - m;
    f32x2 o; o.x = v.x < 0.f ? m.x : r.x; o.y = v.y < 0.f ? m.y : r.y; return o;
}

template <int ACT  > struct EpiBf16 {
    static constexpr bool PERM = true, AFTER_DRAIN = false; static_assert(ACT == 0 || ACT == 1, "EpiBf16: ACT is 0 (none) or 1 (gelu_pk)");
    bf16_t* O; int ldc; const float* bias; int split_cols; size_t split_stride; float scale0;
    __device__ __forceinline__ void operator()(const f32x4 (&acc)[2][2][4][2], const Unit& u, int wr, int wc, int fr, int fq) const {
        const int row0 = u.pm * BM + wr * 64 + fr; int colt = u.pn * BM; bf16_t* base = O;
        float sc = 1.f; if (split_cols) { const int t = colt / split_cols; base += (size_t)t * split_stride; colt -= t * split_cols; if (t == 0) sc = scale0; }
        const int col0 = colt + wc * 32 + 8 * fq, bcol0 = u.pn * BM + wc * 32 + 8 * fq;
        f32x4 bv[2][2];
#pragma unroll
        for (int bj = 0; bj < 2; ++bj)
#pragma unroll
            for (int n = 0; n < 2; ++n) bv[bj][n] = bias ? *(const f32x4*)(bias + bcol0 + bj * HALF + 4 * n) : (f32x4){0.f, 0.f, 0.f, 0.f};
#pragma unroll
        for (int ai = 0; ai < 2; ++ai)
#pragma unroll
            for (int m = 0; m < 4; ++m) { bf16_t* rowp = base + (size_t)(row0 + ai * HALF + m * 16) * ldc + col0;
#pragma unroll
                for (int bj = 0; bj < 2; ++bj) { f32x4 v0 = acc[ai][bj][m][0] + bv[bj][0], v1 = acc[ai][bj][m][1] + bv[bj][1];
                    if (ACT == 1) { f32x2 a = gelu_pk((f32x2){v0[0], v0[1]}), b = gelu_pk((f32x2){v0[2], v0[3]}), c = gelu_pk((f32x2){v1[0], v1[1]}), d = gelu_pk((f32x2){v1[2], v1[3]});
                        v0 = (f32x4){a.x, a.y, b.x, b.y}; v1 = (f32x4){c.x, c.y, d.x, d.y}; }
                    v0 = v0 * sc; v1 = v1 * sc; u32x4 w; w.x = cvt_pk_bf16(v0[0], v0[1]); w.y = cvt_pk_bf16(v0[2], v0[3]); w.z = cvt_pk_bf16(v1[0], v1[1]); w.w = cvt_pk_bf16(v1[2], v1[3]);
                    *(u32x4*)(rowp + bj * HALF) = w; } }
    }
};
struct EpiF32 {
    static constexpr bool PERM = false, AFTER_DRAIN = false;
    float* O; int ldc;
    __device__ __forceinline__ void operator()(const f32x4 (&acc)[2][2][4][2], const Unit& u, int wr, int wc, int fr, int fq) const {
        const int row0 = u.pm * BM + wr * 64 + fr, col0 = u.pn * BM + wc * 32 + 4 * fq;
#pragma unroll
        for (int ai = 0; ai < 2; ++ai)
#pragma unroll
            for (int m = 0; m < 4; ++m) { float* rowp = O + (size_t)(row0 + ai * HALF + m * 16) * ldc + col0;
#pragma unroll
                for (int bj = 0; bj < 2; ++bj)
#pragma unroll
                    for (int n = 0; n < 2; ++n) *(f32x4*)(rowp + bj * HALF + n * 16) = acc[ai][bj][m][n]; }
    }
};
struct EpiProj {
    static constexpr bool PERM = true, AFTER_DRAIN = false;
    bf16_t* O;
    __device__ __forceinline__ void operator()(const f32x4 (&acc)[2][2][4][2], const Unit& u, int wr, int wc, int fr, int fq) const {
        const int row0 = u.pm * BM + wr * 64 + fr, cl = wc * 32 + 8 * fq;
#pragma unroll
        for (int ai = 0; ai < 2; ++ai)
#pragma unroll
            for (int m = 0; m < 4; ++m) { bf16_t* rowp = O + (size_t)(row0 + ai * HALF + m * 16) * 1536;
                if (u.pn < 4) {
#pragma unroll
                    for (int bj = 0; bj < 2; ++bj) { const f32x4 v0 = acc[ai][bj][m][0], v1 = acc[ai][bj][m][1]; u32x4 w;
                        w.x = cvt_pk_bf16(v0[0], v0[1]); w.y = cvt_pk_bf16(v0[2], v0[3]); w.z = cvt_pk_bf16(v1[0], v1[1]); w.w = cvt_pk_bf16(v1[2], v1[3]);
                        *(u32x4*)(rowp + u.pn * BM + bj * HALF + cl) = w; }
                } else {
                    const f32x4 v0 = acc[ai][0][m][0] * acc[ai][1][m][0], v1 = acc[ai][0][m][1] * acc[ai][1][m][1]; u32x4 w;
                    w.x = cvt_pk_bf16(v0[0], v0[1]); w.y = cvt_pk_bf16(v0[2], v0[3]); w.z = cvt_pk_bf16(v1[0], v1[1]); w.w = cvt_pk_bf16(v1[2], v1[3]);
                    *(u32x4*)(rowp + 1024 + (u.pn - 4) * HALF + cl) = w;
                } }
    }
};
__device__ __forceinline__ f32x4 shfl4(f32x4 v, int src) { f32x4 r; r.x = __shfl(v.x, src); r.y = __shfl(v.y, src); r.z = __shfl(v.z, src); r.w = __shfl(v.w, src); return r; }
template <int N> __device__ __forceinline__ float dpp_ror(float v) { return __builtin_bit_cast(float, __builtin_amdgcn_mov_dpp(__builtin_bit_cast(int, v), 0x120 + N, 0xf, 0xf, true)); }
template <int N> __device__ __forceinline__ f32x4 ror4(f32x4 v) { f32x4 r; r.x = dpp_ror<N>(v.x); r.y = dpp_ror<N>(v.y); r.z = dpp_ror<N>(v.z); r.w = dpp_ror<N>(v.w); return r; }
template <int N> __device__ __forceinline__ float dpp_shr_old(float old, float v) { return __builtin_bit_cast(float, __builtin_amdgcn_update_dpp(__builtin_bit_cast(int, old), __builtin_bit_cast(int, v), 0x110 + N, 0xf, 0xf, false)); }
template <int N> __device__ __forceinline__ f32x4 shr4(f32x4 old, f32x4 v) { f32x4 r; r.x = dpp_shr_old<N>(old.x, v.x); r.y = dpp_shr_old<N>(old.y, v.y); r.z = dpp_shr_old<N>(old.z, v.z); r.w = dpp_shr_old<N>(old.w, v.w); return r; }
struct EpiUpGate {
    static constexpr bool PERM = true, AFTER_DRAIN = false;
    bf16_t* G; const float* cw; const float* st; float* nfp; float* nfs; float* edge; PG8_LAS float* eb;
    __device__ __forceinline__ void operator()(const f32x4 (&acc)[2][2][4][2], const Unit& u, int wr, int wc, int fr, int fq) const {
        const int lane = fq * 16 + fr;
        const int tc0 = wc * 32 + 8 * fq, j0 = u.pn * 128 + tc0;
        const int src1 = (lane & 48) | ((fr + 15) & 15), src2 = (lane & 48) | ((fr + 14) & 15);
        const bool sample = u.pm >= 64;
        PG8_LAS float* wl = eb + 2048;
        { const int t_ = (int)threadIdx.x; if (t_ < 256) { const int c_ = (t_ < 128 ? 0 : 2816 - 128) + u.pn * 128 + t_;
#pragma unroll
            for (int k = 0; k < 3; ++k) wl[k * 256 + t_] = cw[k * 5632 + c_]; } }
        if (!sample && fr >= 14) {
#pragma unroll
            for (int ai = 0; ai < 2; ++ai)
#pragma unroll
                for (int bj = 0; bj < 2; ++bj)
#pragma unroll
                    for (int n = 0; n < 2; ++n) *(PG8_LAS f32x4*)(eb + ((2 * ai + wr) * 2 + (fr - 14)) * 256 + 128 * bj + tc0 + 4 * n) = acc[ai][bj][3][n];
        }
        asm volatile("s_waitcnt lgkmcnt(0)" ::: "memory"); __builtin_amdgcn_s_barrier(); asm volatile("" ::: "memory");
#pragma unroll
        for (int ai = 0; ai < 2; ++ai) {
            const int blk = 2 * ai + wr;
#pragma unroll
            for (int m = 0; m < 4; ++m) {
                const int r = 128 * ai + 64 * wr + 16 * m + fr;
                int wo = tc0; asm volatile("" : "+v"(wo));
                f32x4 uu[2][2];
#pragma unroll
                for (int bj = 0; bj < 2; ++bj)
#pragma unroll
                    for (int n = 0; n < 2; ++n) {
                        const f32x4 x = acc[ai][bj][m][n];
                        f32x4 p1, p2;
                        if (!sample) {
                            if (m > 0) {
                                const f32x4 xp = acc[ai][bj][m > 0 ? m - 1 : 0][n];
                                p1 = shr4<1>(ror4<1>(xp), x); p2 = shr4<2>(ror4<2>(xp), x);
                            } else {
                                f32x4 b1 = (f32x4){0.f, 0.f, 0.f, 0.f}, b2 = b1;
                                if (blk > 0) { b1 = *(const PG8_LAS f32x4*)(eb + ((blk - 1) * 2 + 1) * 256 + 128 * bj + tc0 + 4 * n);
                                               b2 = *(const PG8_LAS f32x4*)(eb + ((blk - 1) * 2 + (fr == 0 ? 0 : 1)) * 256 + 128 * bj + tc0 + 4 * n); }
                                p1 = shr4<1>(b1, x); p2 = shr4<2>(b2, x);
                            }
                        } else {
                            const int srow = (u.pm - 64) * 256 + r, b = srow >> 2, t = fr & 3;
                            p1 = ror4<1>(x); p2 = ror4<2>(x);
                            const size_t so = (size_t)b * 2 * 5632 + bj * 2816 + j0 + 4 * n;
                            if (t < 2) { const f32x4 s0 = *(const f32x4*)(st + so), s1 = *(const f32x4*)(st + so + 5632);
                                if (t == 0) { p1 = s1; p2 = s0; } else { p2 = s1; } }
                            else *(f32x4*)(nfs + so + (size_t)(t - 2) * 5632) = x;
                        }
                        const PG8_LAS float* wp = wl + 128 * bj + wo + 4 * n;
                        uu[bj][n] = *(const PG8_LAS f32x4*)wp * p2 + *(const PG8_LAS f32x4*)(wp + 256) * p1 + *(const PG8_LAS f32x4*)(wp + 512) * x;
                    }
                float gv[8];
#pragma unroll
                for (int n = 0; n < 2; ++n)
#pragma unroll
                    for (int c = 0; c < 4; ++c) { const float a = uu[0][n][c], b = uu[1][n][c]; gv[n * 4 + c] = a * __builtin_amdgcn_rcpf(1.0f + __expf(-a)) * b; }
                u32x4 o; o.x = cvt_pk_bf16(gv[0], gv[1]); o.y = cvt_pk_bf16(gv[2], gv[3]); o.z = cvt_pk_bf16(gv[4], gv[5]); o.w = cvt_pk_bf16(gv[6], gv[7]);
                const bool deferred = (!sample) && (blk == 0) && (m == 0) && (fr < 2) && ((u.pm & 7) != 0);
                if (!deferred) *(u32x4*)(G + (size_t)(u.pm * BM + r) * 2816 + j0) = o;
            }
        }
        if (!sample) {
            float* eg = edge + (size_t)(u.pm * 22 + u.pn) * 1024;
            if (wr == 0 && fr < 2) {
#pragma unroll
                for (int bj = 0; bj < 2; ++bj)
#pragma unroll
                    for (int n = 0; n < 2; ++n) *(f32x4*)(eg + fr * 256 + 128 * bj + tc0 + 4 * n) = acc[0][bj][0][n];
            }
            if (wr == 1 && fr >= 14) {
#pragma unroll
                for (int bj = 0; bj < 2; ++bj)
#pragma unroll
                    for (int n = 0; n < 2; ++n) { *(f32x4*)(eg + (2 + fr - 14) * 256 + 128 * bj + tc0 + 4 * n) = acc[1][bj][3][n];
                        if ((u.pm & 7) == 7) *(f32x4*)(nfp + (size_t)((u.pm >> 3) * 2 + (fr - 14)) * 5632 + bj * 2816 + j0 + 4 * n) = acc[1][bj][3][n]; }
            }
        }
    }
};
struct PanelRms {
    unsigned* xbuf;
    unsigned* cnt;
    float eps;
    __device__ __forceinline__ void run(const f32x4 (&v)[2][2][4][2], const Unit& u, int wr, int wc, int fr, int fq, PG8_LAS unsigned char* lds, int wid, int lane) const {
        PG8_LAS float* P = (PG8_LAS float*)lds;
        PG8_LAS float* S = (PG8_LAS float*)(lds + 8192);
#pragma unroll
        for (int ai = 0; ai < 2; ++ai)
#pragma unroll
            for (int m = 0; m < 4; ++m) {
                float q = 0.f;
#pragma unroll
                for (int bj = 0; bj < 2; ++bj)
#pragma unroll
                    for (int n = 0; n < 2; ++n) { const f32x4 x = v[ai][bj][m][n]; q += (x[0] * x[0] + x[1] * x[1]) + (x[2] * x[2] + x[3] * x[3]); }
                q += __shfl_xor(q, 16); q += __shfl_xor(q, 32);
                if (fq == 0) P[(ai * HALF + wr * 64 + m * 16 + fr) * 4 + wc] = q;
            }
        asm volatile("s_waitcnt lgkmcnt(0)" ::: "memory"); __builtin_amdgcn_s_barrier(); asm volatile("" ::: "memory");
        const int row = wid * 32 + (lane & 31);
        if (lane < 32) {
            const float q = (P[row * 4 + 0] + P[row * 4 + 1]) + (P[row * 4 + 2] + P[row * 4 + 3]);
            __hip_atomic_store(xbuf + ((size_t)(u.pm * BM + row) * 4 + u.pn), __float_as_uint(q), __ATOMIC_RELAXED, __HIP_MEMORY_SCOPE_AGENT);
        }
        asm volatile("s_waitcnt vmcnt(0)" ::: "memory");
        if (lane == 0) __hip_atomic_fetch_add(cnt + 64 * u.pm, 1u, __ATOMIC_RELAXED, __HIP_MEMORY_SCOPE_AGENT);
        if (wid == 0) {
            unsigned spins = 0;
            for (;;) {
                if ((unsigned)__builtin_amdgcn_readfirstlane(__hip_atomic_load(cnt + 64 * u.pm, __ATOMIC_RELAXED, __HIP_MEMORY_SCOPE_AGENT)) >= 32u) break;
                if (++spins > (1u << 22)) break;
                __builtin_amdgcn_s_sleep(2);
            }
            __builtin_amdgcn_fence(__ATOMIC_ACQUIRE, "agent");
        }
        asm volatile("s_waitcnt vmcnt(0) lgkmcnt(0)" ::: "memory"); __builtin_amdgcn_s_barrier(); asm volatile("" ::: "memory");
        if (lane < 32) {
            const unsigned* slot = xbuf + (size_t)(u.pm * BM + row) * 4; float q = 0.f;
#pragma unroll
            for (int t = 0; t < 4; ++t) q += __uint_as_float(__hip_atomic_load(slot + t, __ATOMIC_RELAXED, __HIP_MEMORY_SCOPE_AGENT));
            S[row] = 1.0f / sqrtf(q * (1.0f / 1024.0f) + eps);
        }
        asm volatile("s_waitcnt lgkmcnt(0)" ::: "memory"); __builtin_amdgcn_s_barrier(); asm volatile("" ::: "memory");
    }
};
struct EpiMixNorm {
    static constexpr bool PERM = false, AFTER_DRAIN = true;
    const float* x; bf16_t* X1; bf16_t* H; const float* mod; const float* gpm; const float* gpf; PanelRms st1, st2;
    __device__ __forceinline__ void fused(f32x4 (&acc)[2][2][4][2], const Unit& u, int wr, int wc, int fr, int fq, PG8_LAS unsigned char* lds, int wid, int lane) const {
        typedef unsigned u32x2v __attribute__((ext_vector_type(2)));
        const PG8_LAS float* S = (const PG8_LAS float*)(lds + 8192);
        const float* md = mod + (size_t)(u.pm >> 3) * 6144;
        const int col0 = u.pn * BM + wc * 32 + 4 * fq;
        f32x4 pre[2][2][2];
#pragma unroll
        for (int m = 0; m < 2; ++m) { const size_t off = (size_t)(u.pm * BM + wr * 64 + m * 16 + fr) * 1024 + col0;
#pragma unroll
            for (int bj = 0; bj < 2; ++bj)
#pragma unroll
                for (int n = 0; n < 2; ++n) pre[m][bj][n] = *(const f32x4*)(x + off + bj * HALF + n * 16); }
        st1.run(acc, u, wr, wc, fr, fq, lds, wid, lane);
        f32x4 cf[2][2];
#pragma unroll
        for (int bj = 0; bj < 2; ++bj)
#pragma unroll
            for (int n = 0; n < 2; ++n) { const int c = col0 + bj * HALF + n * 16; cf[bj][n] = *(const f32x4*)(md + 2048 + c) * *(const f32x4*)(gpm + c); }
#pragma unroll
        for (int ai = 0; ai < 2; ++ai)
#pragma unroll
            for (int m = 0; m < 4; ++m) { const int r = ai * HALF + wr * 64 + m * 16 + fr; const float rs = S[r]; const size_t off = (size_t)(u.pm * BM + r) * 1024 + col0;
#pragma unroll
                for (int bj = 0; bj < 2; ++bj)
#pragma unroll
                    for (int n = 0; n < 2; ++n) { const f32x4 bs = (ai == 0 && m < 2) ? pre[m < 2 ? m : 0][bj][n] : *(const f32x4*)(x + off + bj * HALF + n * 16); acc[ai][bj][m][n] = bs + cf[bj][n] * (acc[ai][bj][m][n] * rs); }
                asm volatile("" : "+v"(acc[ai][0][m][0]), "+v"(acc[ai][0][m][1]), "+v"(acc[ai][1][m][0]), "+v"(acc[ai][1][m][1]));
                if (m & 1) asm volatile("" ::: "memory"); }
        st2.run(acc, u, wr, wc, fr, fq, lds, wid, lane);
        f32x4 c2[2][2], sh[2][2];
#pragma unroll
        for (int bj = 0; bj < 2; ++bj)
#pragma unroll
            for (int n = 0; n < 2; ++n) { const int c = col0 + bj * HALF + n * 16; c2[bj][n] = *(const f32x4*)(gpf + c) * (1.0f + *(const f32x4*)(md + 4096 + c)); sh[bj][n] = *(const f32x4*)(md + 3072 + c); }
#pragma unroll
        for (int ai = 0; ai < 2; ++ai)
#pragma unroll
            for (int m = 0; m < 4; ++m) { const int r = ai * HALF + wr * 64 + m * 16 + fr; const float rs = S[r]; const size_t off = (size_t)(u.pm * BM + r) * 1024 + col0;
#pragma unroll
                for (int bj = 0; bj < 2; ++bj)
#pragma unroll
                    for (int n = 0; n < 2; ++n) { const f32x4 x1 = acc[ai][bj][m][n]; { u32x2v w1; w1.x = cvt_pk_bf16(x1[0], x1[1]); w1.y = cvt_pk_bf16(x1[2], x1[3]); *(u32x2v*)(X1 + off + bj * HALF + n * 16) = w1; }
                        const f32x4 o = x1 * rs * c2[bj][n] + sh[bj][n]; u32x2v w; w.x = cvt_pk_bf16(o[0], o[1]); w.y = cvt_pk_bf16(o[2], o[3]);
                        *(u32x2v*)(H + off + bj * HALF + n * 16) = w; }
                asm volatile("" ::: "memory"); }
    }
};
struct EpiFfnNorm {
    static constexpr bool PERM = false, AFTER_DRAIN = true;
    const bf16_t* X1; float* Y; const float* mod; const float* gpo; PanelRms st;
    __device__ __forceinline__ void fused(f32x4 (&acc)[2][2][4][2], const Unit& u, int wr, int wc, int fr, int fq, PG8_LAS unsigned char* lds, int wid, int lane) const {
        typedef unsigned u32x2v __attribute__((ext_vector_type(2)));
        const PG8_LAS float* S = (const PG8_LAS float*)(lds + 8192);
        const float* md = mod + (size_t)(u.pm >> 3) * 6144;
        const int col0 = u.pn * BM + wc * 32 + 4 * fq;
        u32x2v pre[1][4][2][2];
#pragma unroll
        for (int ai = 0; ai < 1; ++ai)
#pragma unroll
            for (int m = 0; m < 4; ++m) { const size_t off = (size_t)(u.pm * BM + ai * HALF + wr * 64 + m * 16 + fr) * 1024 + col0;
#pragma unroll
                for (int bj = 0; bj < 2; ++bj)
#pragma unroll
                    for (int n = 0; n < 2; ++n) pre[ai][m][bj][n] = *(const u32x2v*)(X1 + off + bj * HALF + n * 16); }
        st.run(acc, u, wr, wc, fr, fq, lds, wid, lane);
        f32x4 cf[2][2];
#pragma unroll
        for (int bj = 0; bj < 2; ++bj)
#pragma unroll
            for (int n = 0; n < 2; ++n) { const int c = col0 + bj * HALF + n * 16; cf[bj][n] = *(const f32x4*)(md + 5120 + c) * *(const f32x4*)(gpo + c); }
#pragma unroll
        for (int ai = 0; ai < 2; ++ai)
#pragma unroll
            for (int m = 0; m < 4; ++m) { const int r = ai * HALF + wr * 64 + m * 16 + fr; const float rs = S[r]; const size_t off = (size_t)(u.pm * BM + r) * 1024 + col0;
#pragma unroll
                for (int bj = 0; bj < 2; ++bj)
#pragma unroll
                    for (int n = 0; n < 2; ++n) { const u32x2v p = ai == 0 ? pre[0][m][bj][n] : *(const u32x2v*)(X1 + off + bj * HALF + n * 16);
                        const f32x4 bs = (f32x4){__uint_as_float(p.x << 16), __uint_as_float(p.x & 0xffff0000u), __uint_as_float(p.y << 16), __uint_as_float(p.y & 0xffff0000u)};
                        *(f32x4*)(Y + off + bj * HALF + n * 16) = bs + cf[bj][n] * (acc[ai][bj][m][n] * rs); } }
    }
};
struct SliceOrder {
    int nN, nsl, c;
    __device__ bool next(int i, Unit& u) const { if (i != 0 || c >= 2 * nN * nsl) return false; u.ks = c % nsl; const int r = c / nsl; u.pn = r % nN; u.pm = 64 + r / nN; return true; }
    __device__ __forceinline__ void a_ready(const Unit&) const {}
    __device__ __forceinline__ void done(const Unit&) const {}
};
struct EpiF32Part {
    static constexpr bool PERM = false, AFTER_DRAIN = false;
    float* O; int ldc; size_t pstride;
    __device__ __forceinline__ void operator()(const f32x4 (&acc)[2][2][4][2], const Unit& u, int wr, int wc, int fr, int fq) const {
        const int row0 = (u.pm - 64) * BM + wr * 64 + fr, col0 = u.pn * BM + wc * 32 + 4 * fq;
        float* Ob = O + (size_t)u.ks * pstride;
#pragma unroll
        for (int ai = 0; ai < 2; ++ai)
#pragma unroll
            for (int m = 0; m < 4; ++m) { float* rowp = Ob + (size_t)(row0 + ai * HALF + m * 16) * ldc + col0;
#pragma unroll
                for (int bj = 0; bj < 2; ++bj)
#pragma unroll
                    for (int n = 0; n < 2; ++n) *(f32x4*)(rowp + bj * HALF + n * 16) = acc[ai][bj][m][n]; }
    }
};
struct UpOrder : StaticOrder {
    const unsigned* ready; unsigned need;
    __device__ __forceinline__ void a_ready(const Unit& u) const {
        if (u.pm < 64) return;
        if (threadIdx.x < 64) {
            unsigned spins = 0;
            while ((unsigned)__builtin_amdgcn_readfirstlane(__hip_atomic_load(ready, __ATOMIC_RELAXED, __HIP_MEMORY_SCOPE_AGENT)) < need) { if (++spins > (1u << 22)) break; __builtin_amdgcn_s_sleep(2); }
            __builtin_amdgcn_fence(__ATOMIC_ACQUIRE, "agent");
            asm volatile("s_waitcnt vmcnt(0)" ::: "memory");
        }
        asm volatile("" ::: "memory"); __builtin_amdgcn_s_barrier(); asm volatile("" ::: "memory");
    }
};
template <class Epi, class Sched, bool ALIGN_EPI = false, bool SP2 = false>
__device__ __forceinline__ void gemm_phase(PG8_LAS unsigned char* lds, const Gemm g, const Sched& S, const Epi& E) {
    const int tid = threadIdx.x, wid = __builtin_amdgcn_readfirstlane(tid >> 6), lane = tid & 63, wr = wid >> 2, wc = wid & 3, fr = lane & 15, fq = lane >> 4;
    const int K = g.P ? g.P : g.K, nt = g.K / BK;
    const size_t sstep = (size_t)g.K * 2;
    unsigned voffA[2], voffB[2];
#pragma unroll
    for (int i = 0; i < 2; ++i) { int R, C; stage_rc(tid * 16 + i * 8192, R, C); const int Rb = Epi::PERM ? ((R & ~31) + perm32(R & 31)) : R;
        voffA[i] = (unsigned)(R * K + C) * 2u; voffB[i] = (unsigned)(Rb * K + C) * 2u; }
    const size_t kstep = (size_t)(BK * 2);
    const size_t hstep = (size_t)HALF * K * 2;
    const size_t tstep = 2 * hstep;
    const unsigned ldsw = (unsigned)wid * 1024u;
    const int aoff = lds_byte(wr * 64 + fr, fq * 8), boff = lds_byte(wc * 32 + fr, fq * 8);
#define PG8_SA(b, h) (((b) * 2 + (h)) * HTB)
#define PG8_SB(b, h) ((4 + (b) * 2 + (h)) * HTB)
#define PG8_STAGE(bufoff, gbase, voff) do { _Pragma("unroll") for (int _i = 0; _i < 2; ++_i) \
        __builtin_amdgcn_global_load_lds((const unsigned*)((const char*)(gbase) + (voff)[_i]), (PG8_LAS unsigned*)(lds + (bufoff) + ldsw + _i * 8192), 16, 0, 0); } while (0)
#define PG8_LDA(dst, b, h) do { _Pragma("unroll") for (int m = 0; m < 4; ++m) _Pragma("unroll") for (int k = 0; k < 2; ++k) dst[m][k] = *(const PG8_LAS bf16x8*)(lds + PG8_SA(b, h) + aoff + m * 2048 + k * 1024); } while (0)
#define PG8_LDB(dst, b, h) do { _Pragma("unroll") for (int n = 0; n < 2; ++n) _Pragma("unroll") for (int k = 0; k < 2; ++k) dst[n][k] = *(const PG8_LAS bf16x8*)(lds + PG8_SB(b, h) + boff + n * 2048 + k * 1024); } while (0)
#define PG8_MMA(ai, bj, At, Bt) do { __builtin_amdgcn_s_setprio(1); _Pragma("unroll") for (int m = 0; m < 4; ++m) _Pragma("unroll") for (int n = 0; n < 2; ++n) _Pragma("unroll") for (int k = 0; k < 2; ++k) \
        acc[ai][bj][m][n] = __builtin_amdgcn_mfma_f32_16x16x32_bf16(Bt[n][k], At[m][k], acc[ai][bj][m][n], 0, 0, 0); __builtin_amdgcn_s_setprio(0); } while (0)
#define PG8_WAIT_V(n) asm volatile("s_waitcnt vmcnt(" #n ")" ::: "memory")
#define PG8_WAIT_L(n) asm volatile("s_waitcnt lgkmcnt(" #n ")" ::: "memory")
#define PG8_BAR __builtin_amdgcn_s_barrier()
#define PG8_SCHED __builtin_amdgcn_sched_barrier(0)
    Unit cur, nxt; int ui = 0;
    if (!S.next(0, cur)) return;
    f32x4 acc[2][2][4][2];
#pragma unroll
    for (int a = 0; a < 2; ++a)
#pragma unroll
        for (int b = 0; b < 2; ++b)
#pragma unroll
            for (int m = 0; m < 4; ++m)
#pragma unroll
                for (int n = 0; n < 2; ++n) acc[a][b][m][n] = (f32x4){0.f, 0.f, 0.f, 0.f};
    bf16x8 At[4][2], B0[2][2], B1[2][2];
    const char* cA = (const char*)g.A + (size_t)cur.pm * tstep + cur.ks * sstep; const char* cB = (const char*)g.Bt + (size_t)cur.pn * tstep + cur.ks * sstep;
    S.a_ready(cur);
    if constexpr (SP2) {
        PG8_STAGE(PG8_SB(0, 0), cB, voffB); PG8_STAGE(PG8_SB(0, 1), cB + hstep, voffB); PG8_STAGE(PG8_SA(0, 0), cA, voffA); PG8_STAGE(PG8_SA(0, 1), cA + hstep, voffA);
        if (wr == 1) PG8_BAR;
        PG8_WAIT_V(2); PG8_BAR;
        PG8_STAGE(PG8_SB(1, 0), cB + kstep, voffB); PG8_STAGE(PG8_SA(1, 0), cA + kstep, voffA); PG8_STAGE(PG8_SB(1, 1), cB + hstep + kstep, voffB);
        PG8_WAIT_V(6); PG8_BAR;
    } else {
        PG8_STAGE(PG8_SB(0, 0), cB, voffB); PG8_STAGE(PG8_SA(0, 0), cA, voffA); PG8_STAGE(PG8_SB(0, 1), cB + hstep, voffB); PG8_STAGE(PG8_SA(0, 1), cA + hstep, voffA);
        if (wr == 1) PG8_BAR;
        PG8_WAIT_V(4); PG8_BAR;
        PG8_STAGE(PG8_SB(1, 0), cB + kstep, voffB); PG8_STAGE(PG8_SA(1, 0), cA + kstep, voffA); PG8_STAGE(PG8_SB(1, 1), cB + hstep + kstep, voffB);
        PG8_WAIT_V(6); PG8_BAR;
    }
    for (;;) {
        const bool has_next = S.next(ui + 1, nxt);
        const char* nA = has_next ? (const char*)g.A + (size_t)nxt.pm * tstep + nxt.ks * sstep : cA; const char* nB = has_next ? (const char*)g.Bt + (size_t)nxt.pn * tstep + nxt.ks * sstep : cB;
        for (int t = 0; t < nt; t += 2) {
            const bool last = (t == nt - 2);
            const char* a1 = cA + (size_t)(t + 1) * kstep;
            const char* a2 = last ? nA : cA + (size_t)(t + 2) * kstep; const char* b2 = last ? nB : cB + (size_t)(t + 2) * kstep;
            const char* a3 = a2 + kstep; const char* b3 = b2 + kstep;
            if (last && has_next) S.a_ready(nxt);
            if constexpr (SP2) {
            PG8_LDB(B0, 0, 0); PG8_LDB(B1, 0, 1); PG8_SCHED; PG8_LDA(At, 0, 0); PG8_STAGE(PG8_SA(1, 1), a1 + hstep, voffA);
            PG8_WAIT_V(8); PG8_WAIT_L(0); PG8_BAR; PG8_MMA(0, 0, At, B0); PG8_MMA(0, 1, At, B1); PG8_BAR; PG8_SCHED;
            PG8_LDA(At, 0, 1); PG8_STAGE(PG8_SB(0, 0), b2, voffB); PG8_STAGE(PG8_SB(0, 1), b2 + hstep, voffB); PG8_STAGE(PG8_SA(0, 0), a2, voffA);
            PG8_WAIT_V(8); PG8_WAIT_L(0); PG8_BAR; PG8_MMA(1, 0, At, B0); PG8_MMA(1, 1, At, B1); PG8_BAR; PG8_SCHED;
            PG8_LDB(B0, 1, 0); PG8_LDB(B1, 1, 1); PG8_SCHED; PG8_LDA(At, 1, 0); PG8_STAGE(PG8_SA(0, 1), a2 + hstep, voffA);
            PG8_WAIT_V(8); PG8_WAIT_L(0); PG8_BAR; PG8_MMA(0, 0, At, B0); PG8_MMA(0, 1, At, B1); PG8_BAR; PG8_SCHED;
            PG8_LDA(At, 1, 1); PG8_STAGE(PG8_SB(1, 0), b3, voffB); PG8_STAGE(PG8_SB(1, 1), b3 + hstep, voffB); PG8_STAGE(PG8_SA(1, 0), a3, voffA);
            PG8_WAIT_V(8); PG8_WAIT_L(0); PG8_BAR; PG8_MMA(1, 0, At, B0); PG8_MMA(1, 1, At, B1); PG8_BAR; PG8_SCHED;
            } else {
            PG8_LDB(B0, 0, 0); PG8_SCHED; PG8_LDA(At, 0, 0); PG8_STAGE(PG8_SA(1, 1), a1 + hstep, voffA);
            PG8_WAIT_L(8); PG8_BAR; PG8_WAIT_L(0); PG8_MMA(0, 0, At, B0); PG8_BAR; PG8_SCHED;
            PG8_LDB(B1, 0, 1); PG8_STAGE(PG8_SB(0, 0), b2, voffB);
            PG8_BAR; PG8_WAIT_L(0); PG8_MMA(0, 1, At, B1); PG8_BAR;
            PG8_LDA(At, 0, 1); PG8_STAGE(PG8_SA(0, 0), a2, voffA);
            PG8_BAR; PG8_WAIT_L(0); PG8_MMA(1, 0, At, B0); PG8_BAR; PG8_SCHED;
            PG8_STAGE(PG8_SB(0, 1), b2 + hstep, voffB);
            PG8_WAIT_V(6); PG8_BAR; PG8_MMA(1, 1, At, B1); PG8_BAR;
            PG8_LDB(B0, 1, 0); PG8_SCHED; PG8_LDA(At, 1, 0); PG8_STAGE(PG8_SA(0, 1), a2 + hstep, voffA);
            PG8_WAIT_L(8); PG8_BAR; PG8_WAIT_L(0); PG8_MMA(0, 0, At, B0); PG8_BAR; PG8_SCHED;
            PG8_LDB(B1, 1, 1); PG8_STAGE(PG8_SB(1, 0), b3, voffB);
            PG8_BAR; PG8_WAIT_L(0); PG8_MMA(0, 1, At, B1); PG8_BAR;
            PG8_LDA(At, 1, 1); PG8_STAGE(PG8_SA(1, 0), a3, voffA);
            PG8_BAR; PG8_WAIT_L(0); PG8_MMA(1, 0, At, B0); PG8_BAR; PG8_SCHED;
            PG8_STAGE(PG8_SB(1, 1), b3 + hstep, voffB);
            PG8_WAIT_V(6); PG8_BAR; PG8_MMA(1, 1, At, B1); PG8_BAR;
            }
        }
        if constexpr (ALIGN_EPI) { if (wr == 0) PG8_BAR; }
        if constexpr (!Epi::AFTER_DRAIN) { E(acc, cur, wr, wc, fr, fq); S.done(cur); }
        if (!has_next) break;
#pragma unroll
        for (int a = 0; a < 2; ++a)
#pragma unroll
            for (int b = 0; b < 2; ++b)
#pragma unroll
                for (int m = 0; m < 4; ++m)
#pragma unroll
                    for (int n = 0; n < 2; ++n) acc[a][b][m][n] = (f32x4){0.f, 0.f, 0.f, 0.f};
        cur = nxt; cA = nA; cB = nB; ++ui;
        if constexpr (ALIGN_EPI) { if (wr == 1) PG8_BAR; }
    }
    PG8_WAIT_V(0);
    if constexpr (!ALIGN_EPI) { if (wr == 0) PG8_BAR; }
    PG8_BAR;
    if constexpr (Epi::AFTER_DRAIN) { E.fused(acc, cur, wr, wc, fr, fq, lds, wid, lane); S.done(cur); }
#undef PG8_SA
#undef PG8_SB
#undef PG8_STAGE
#undef PG8_LDA
#undef PG8_LDB
#undef PG8_MMA
#undef PG8_WAIT_V
#undef PG8_WAIT_L
#undef PG8_BAR
#undef PG8_SCHED
}
}
#define LAS __attribute__((address_space(3)))
typedef unsigned short bf16;
typedef unsigned v4u __attribute__((ext_vector_type(4)));
typedef unsigned v2u __attribute__((ext_vector_type(2)));
typedef float f32x4 __attribute__((ext_vector_type(4)));
typedef float f32x2v __attribute__((ext_vector_type(2)));
typedef short bf16x8 __attribute__((ext_vector_type(8)));
#ifndef REPMASK
#define REPMASK 0
#endif
#ifndef MK_COOP
#define MK_COOP 1
#endif
constexpr int NWAVES = 8, NPHASE = 10;
constexpr int PP = 1536;
constexpr int MP = 16384, MS = 512, M = MP + MS, D = 1024, DIN = 2048, DFF = 2816, DUP = 5632, NBATCH = 136, NMOD = 6144;
constexpr float EPS = 1e-6f;
constexpr size_t MiB = 1u << 20;
constexpr size_t WS_CTL = 0, CTL_ZERO_BYTES = 1 * MiB, WS_MOD = 1 * MiB, WS_WIN = 5 * MiB, WS_WOUT = 9 * MiB, WS_WUP = 11 * MiB, WS_WDN = 22 * MiB, WS_EDGE = 28 * MiB,
                 WS_H = 34 * MiB, WS_DY = 67 * MiB, WS_PROJ = 100 * MiB, WS_MIX = 100 * MiB, WS_G = 67 * MiB, WS_F = 160 * MiB, WS_XB = 228 * MiB, WS_PART = 200 * MiB  , WS_X1 = 168 * MiB  , WS_END = 256 * MiB;
constexpr int CNT_BANK_WORDS = 64 * 64;
constexpr size_t O_Y = 0, O_NPP = 17301504, O_NCP = 17362944, O_NFP = 17371136, O_NPS = 17461248, O_NCS = 18444288, O_NFS = 18575360, O_END = 20017152;
constexpr int RING_BYTES = 131072, EB_OFF = 131072, LDS_BYTES = 147456;
#define LDS_WAIT() asm volatile("s_waitcnt lgkmcnt(0)" ::: "memory")

__device__ __forceinline__ unsigned f2bf(float f) { unsigned u = __builtin_bit_cast(unsigned, f); return (u + 0x7fffu + ((u >> 16) & 1u)) >> 16; }
__device__ __forceinline__ unsigned pk2(float lo, float hi) { unsigned r; asm("v_cvt_pk_bf16_f32 %0, %1, %2" : "=v"(r) : "v"(lo), "v"(hi)); return r; }
__device__ __forceinline__ void unpack8(v4u v, float (&f)[8]) {
    f[0] = __builtin_bit_cast(float, v.x << 16); f[1] = __builtin_bit_cast(float, v.x & 0xffff0000u);
    f[2] = __builtin_bit_cast(float, v.y << 16); f[3] = __builtin_bit_cast(float, v.y & 0xffff0000u);
    f[4] = __builtin_bit_cast(float, v.z << 16); f[5] = __builtin_bit_cast(float, v.z & 0xffff0000u);
    f[6] = __builtin_bit_cast(float, v.w << 16); f[7] = __builtin_bit_cast(float, v.w & 0xffff0000u);
}
__device__ __forceinline__ v4u pack8(const float (&f)[8]) { v4u o; o.x = pk2(f[0], f[1]); o.y = pk2(f[2], f[3]); o.z = pk2(f[4], f[5]); o.w = pk2(f[6], f[7]); return o; }
__device__ __forceinline__ float wave_sum(float v) {
#pragma unroll
    for (int o = 1; o < 64; o <<= 1) v += __shfl_xor(v, o);
    return v;
}
__device__ __forceinline__ float silu_f(float a) { return a * __builtin_amdgcn_rcpf(1.0f + __expf(-a)); }

struct Args { const float* in[21]; float* out; unsigned char* ws; int ph_lo, ph_hi; };
enum { I_XP = 0, I_XS, I_SPOOL, I_SCONV, I_SFFN, I_CP, I_CS, I_WADA, I_BADA, I_GPREMIX, I_GPOSTMIX, I_GPREFFN, I_GPOSTFFN, I_WIN, I_POOLW, I_POOLS, I_CONVW, I_WOUT, I_WUP, I_FCONVW, I_WDN };

__device__ __forceinline__ const float* xrow(const Args& a, int m) { return m < MP ? a.in[I_XP] + (size_t)m * D : a.in[I_XS] + (size_t)(m - MP) * D; }
__device__ __forceinline__ int batch_of(int m) { return m < MP ? (m >> 11) : 8 + ((m - MP) >> 2); }

__device__ __forceinline__ void tr_item(const float* W, int ldw, int k0, int n0, bf16* WT, int ldt, int drow0, int dk0, LAS float* scr, int lane) {
    float tv[64];
#pragma unroll
    for (int i = 0; i < 64; ++i) tv[i] = W[(size_t)(k0 + i) * ldw + n0 + lane];
    __builtin_amdgcn_sched_barrier(0);
#pragma unroll
    for (int i = 0; i < 64; ++i) scr[i * 65 + lane] = tv[i];
    LDS_WAIT(); asm volatile("" ::: "memory");
    const int c = lane & 7;
#pragma unroll
    for (int j = 0; j < 8; ++j) { const int n = (lane >> 3) + 8 * j; const LAS float* sp = scr + (8 * c) * 65 + n;
        v4u o; o.x = pk2(sp[0 * 65], sp[1 * 65]); o.y = pk2(sp[2 * 65], sp[3 * 65]); o.z = pk2(sp[4 * 65], sp[5 * 65]); o.w = pk2(sp[6 * 65], sp[7 * 65]);
        *(v4u*)(WT + (size_t)(drow0 + n) * ldt + dk0 + 8 * c) = o; }
    LDS_WAIT(); asm volatile("" ::: "memory");
}

__device__ __forceinline__ void weight_items(const Args& a, LAS unsigned char* lds, int lane, int wave, int it0, int step, int cnt, int lim);
__device__ __forceinline__ void p0_prologue(const Args& a, LAS unsigned char* lds, int tid, int lane, int wave) {
    unsigned char* ws = a.ws;
    bf16* Win_t = (bf16*)(ws + WS_WIN); bf16* Wout_t = (bf16*)(ws + WS_WOUT); bf16* Wup_t = (bf16*)(ws + WS_WUP); bf16* Wdn_t = (bf16*)(ws + WS_WDN);
    float* mod = (float*)(ws + WS_MOD);
    const int G = gridDim.x, gw = blockIdx.x * NWAVES + wave, NGW = G * NWAVES;
    for (int i = blockIdx.x * 512 + tid; i < 16384; i += G * 512) ((unsigned*)(ws + WS_CTL))[i] = 0u;
    {
        LAS float* red = (LAS float*)lds;
        const int fr = lane & 15, fq = lane >> 4;
        for (int wi = blockIdx.x; wi < NMOD / 32; wi += G) {
            const int n0 = wi * 32, kb = wave * 128 + fq * 8;
            f32x4 acc[9][2];
#pragma unroll
            for (int rb = 0; rb < 9; ++rb) { acc[rb][0] = (f32x4){0.f, 0.f, 0.f, 0.f}; acc[rb][1] = acc[rb][0]; }
            LAS unsigned char* sa = lds + 32768 + wave * 12288;
            const int arow = lane >> 3, akk = (lane & 7) * 4;
            f32x2v wn[8];
#pragma unroll
            for (int i = 0; i < 8; ++i) wn[i] = *(const f32x2v*)(a.in[I_WADA] + (size_t)(kb + i) * NMOD + n0 + 2 * fr);
#pragma unroll 1
            for (int ks = 0; ks < 4; ++ks) {
                float wv[2][8];
#pragma unroll
                for (int i = 0; i < 8; ++i) { wv[0][i] = wn[i].x; wv[1][i] = wn[i].y; }
                { const int k1 = kb + (ks < 3 ? ks + 1 : 3) * 32;
#pragma unroll
                  for (int i = 0; i < 8; ++i) wn[i] = *(const f32x2v*)(a.in[I_WADA] + (size_t)(k1 + i) * NMOD + n0 + 2 * fr); }
                f32x4 cl[18];
#pragma unroll
                for (int j = 0; j < 18; ++j) { int row = 8 * j + arow; row = row < NBATCH ? row : NBATCH - 1;
                    cl[j] = *(const f32x4*)((row < 8 ? a.in[I_CP] + (size_t)row * D : a.in[I_CS] + (size_t)(row - 8) * D) + wave * 128 + ks * 32 + akk); }
                __builtin_amdgcn_sched_barrier(0);
#pragma unroll
                for (int j = 0; j < 18; ++j) { v2u w; w.x = pk2(silu_f(cl[j].x), silu_f(cl[j].y)); w.y = pk2(silu_f(cl[j].z), silu_f(cl[j].w));
                    *(LAS v2u*)(sa + (8 * j + arow) * 80 + akk * 2) = w; }
                const bf16x8 b0 = __builtin_bit_cast(bf16x8, pack8(wv[0])), b1 = __builtin_bit_cast(bf16x8, pack8(wv[1]));
                LDS_WAIT(); asm volatile("" ::: "memory");
#pragma unroll
                for (int rb = 0; rb < 9; ++rb) {
                    const bf16x8 af = *(const LAS bf16x8*)(sa + (rb * 16 + fr) * 80 + fq * 16);
                    acc[rb][0] = __builtin_amdgcn_mfma_f32_16x16x32_bf16(b0, af, acc[rb][0], 0, 0, 0);
                    acc[rb][1] = __builtin_amdgcn_mfma_f32_16x16x32_bf16(b1, af, acc[rb][1], 0, 0, 0);
                }
                LDS_WAIT(); asm volatile("" ::: "memory");
            }
            __syncthreads();
#pragma unroll
            for (int st = 4; st >= 1; st >>= 1) {
                LAS float* slot = (LAS float*)(lds + 32768) + (wave & (st - 1)) * (18 * 256);
                if (wave >= st && wave < 2 * st) {
#pragma unroll
                    for (int rb = 0; rb < 9; ++rb)
#pragma unroll
                        for (int cb = 0; cb < 2; ++cb)
#pragma unroll
                            for (int e = 0; e < 4; ++e) slot[((rb * 2 + cb) * 4 + e) * 64 + lane] = acc[rb][cb][e];
                }
                __syncthreads();
                if (wave < st) {
#pragma unroll
                    for (int rb = 0; rb < 9; ++rb)
#pragma unroll
                        for (int cb = 0; cb < 2; ++cb)
#pragma unroll
                            for (int e = 0; e < 4; ++e) acc[rb][cb][e] += slot[((rb * 2 + cb) * 4 + e) * 64 + lane];
                }
                __syncthreads();
            }
            if (wave == 0) {
#pragma unroll
                for (int rb = 0; rb < 9; ++rb) { const int row = rb * 16 + fr, col = n0 + 8 * fq;
                    const f32x4 lo = (f32x4){acc[rb][0][0], acc[rb][1][0], acc[rb][0][1], acc[rb][1][1]} + *(const f32x4*)(a.in[I_BADA] + col);
                    const f32x4 hi = (f32x4){acc[rb][0][2], acc[rb][1][2], acc[rb][0][3], acc[rb][1][3]} + *(const f32x4*)(a.in[I_BADA] + col + 4);
                    if (row < NBATCH) { *(f32x4*)(mod + (size_t)row * NMOD + col) = lo; *(f32x4*)(mod + (size_t)row * NMOD + col + 4) = hi; } }
            }
            __syncthreads();
        }
    }
    if (G == 256) { if (blockIdx.x >= 192) weight_items(a, lds, lane, wave, ((int)blockIdx.x - 192) * 8 + wave, 512, 6, 2688); }
    else weight_items(a, lds, lane, wave, gw, NGW, (4800 + NGW - 1) / NGW, 4800);
}

__device__ __forceinline__ void weight_items(const Args& a, LAS unsigned char* lds, int lane, int wave, int it0, int step, int cnt, int lim) {
    unsigned char* ws = a.ws;
    bf16* Win_t = (bf16*)(ws + WS_WIN); bf16* Wout_t = (bf16*)(ws + WS_WOUT); bf16* Wup_t = (bf16*)(ws + WS_WUP); bf16* Wdn_t = (bf16*)(ws + WS_WDN);
    LAS float* scr = (LAS float*)(lds + wave * 17408);
    constexpr int I_FOLD = 2048, I_IN = 16 * 32, I_OUT = 8 * 16, I_UP = 16 * 88;
        for (int ii = 0; ii < cnt; ++ii) {
            int r = it0 + ii * step; if (r >= lim) break;
            if (r < I_FOLD) {
                const int k0 = (r >> 6) * 16, n0 = (r & 63) * 16, gb = (k0 >> 7) * 128, rr = lane & 15, q = lane >> 4;
                f32x4 pw[8], ps[8]; float wo[32];
                const f32x4* pwp = (const f32x4*)(a.in[I_POOLW] + (size_t)(k0 + rr) * 128 + q * 32); const f32x4* psp = (const f32x4*)(a.in[I_POOLS] + gb + q * 32);
#pragma unroll
                for (int i = 0; i < 8; ++i) { pw[i] = pwp[i]; ps[i] = psp[i]; }
#pragma unroll
                for (int sidx = 0; sidx < 32; ++sidx) wo[sidx] = a.in[I_WOUT][(size_t)(gb + q * 32 + sidx) * D + n0 + rr];
                __builtin_amdgcn_sched_barrier(0);
                f32x4 acc = (f32x4){0.f, 0.f, 0.f, 0.f};
#pragma unroll
                for (int sidx = 0; sidx < 32; ++sidx) acc = __builtin_amdgcn_mfma_f32_16x16x4f32(pw[sidx >> 2][sidx & 3], ps[sidx >> 2][sidx & 3] * wo[sidx], acc, 0, 0, 0);
                v2u o; o.x = pk2(acc[0], acc[1]); o.y = pk2(acc[2], acc[3]);
                *(v2u*)(Wout_t + (size_t)(n0 + rr) * D + k0 + 4 * q) = o;
                continue;
            } r -= I_FOLD;
            if (r < I_IN) { const int kb = r / 32, nb = r % 32, n0 = 64 * nb;
                const int jx = (n0 - 512) & 511, drow0 = n0 < 512 ? n0 : (n0 < 1024 ? 1024 + (jx >> 7) * 256 + (jx & 127) : (n0 < 1536 ? n0 - 512 : 1024 + (((n0 - 1536) >> 7) * 256) + 128 + ((n0 - 1536) & 127)));
                tr_item(a.in[I_WIN], DIN, 64 * kb, n0, Win_t, D, drow0, 64 * kb, scr, lane); continue; } r -= I_IN;
            if (r < I_OUT) { const int kb = r / 16, nb = r % 16; tr_item(a.in[I_WOUT] + (size_t)512 * D, D, 64 * kb, 64 * nb, Wout_t, D, 64 * nb, 512 + 64 * kb, scr, lane); continue; } r -= I_OUT;
            if (r < I_UP) { const int kb = r / 88, nb = r % 88, n0 = 64 * nb;
                const int drow0 = n0 < DFF ? (n0 / 128) * 256 + (n0 % 128) : ((n0 - DFF) / 128) * 256 + 128 + ((n0 - DFF) % 128);
                tr_item(a.in[I_WUP], DUP, 64 * kb, n0, Wup_t, D, drow0, 64 * kb, scr, lane); continue; } r -= I_UP;
            { const int kb = r / 16, nb = r % 16; tr_item(a.in[I_WDN], D, 64 * kb, 64 * nb, Wdn_t, DFF, 64 * nb, 64 * kb, scr, lane); }
        }
}

__device__ __forceinline__ void p1_norm(const Args& a, int lane, int wave) {
    bf16* H = (bf16*)(a.ws + WS_H); const float* mod = (const float*)(a.ws + WS_MOD);
    const int gw = blockIdx.x * NWAVES + wave, NGW = gridDim.x * NWAVES;
    for (int mb = gw; mb < M; mb += 4 * NGW) {
        f32x4 v[4][4];
#pragma unroll
        for (int r = 0; r < 4; ++r) { const int m = mb + r * NGW; const float* xr = xrow(a, m < M ? m : mb);
#pragma unroll
            for (int j = 0; j < 4; ++j) v[r][j] = *(const f32x4*)(xr + 4 * lane + 256 * j); }
        __builtin_amdgcn_sched_barrier(0);
#pragma unroll
        for (int r = 0; r < 4; ++r) {
            const int m = mb + r * NGW; if (m >= M) break;
            const float* md = mod + (size_t)batch_of(m) * NMOD;
            float ss = 0.f;
#pragma unroll
            for (int j = 0; j < 4; ++j) ss += (v[r][j].x * v[r][j].x + v[r][j].y * v[r][j].y) + (v[r][j].z * v[r][j].z + v[r][j].w * v[r][j].w);
            const float rstd = 1.0f / sqrtf(wave_sum(ss) * (1.0f / D) + EPS);
#pragma unroll
            for (int j = 0; j < 4; ++j) { const int col = 4 * lane + 256 * j;
                const f32x4 g = *(const f32x4*)(a.in[I_GPREMIX] + col), sc = *(const f32x4*)(md + 1024 + col), sh = *(const f32x4*)(md + col);
                const f32x4 o = v[r][j] * rstd * g * (1.0f + sc) + sh;
                v2u w; w.x = pk2(o.x, o.y); w.y = pk2(o.z, o.w); *(v2u*)(H + (size_t)m * D + col) = w; }
        }
    }
}

__device__ __forceinline__ void ldpart8(const float* part, size_t sstride, int nsl, size_t off, float (&v)[8]) {
    f32x4 a = (f32x4){0.f, 0.f, 0.f, 0.f}, b = a;
    for (int sl = 0; sl < nsl; ++sl) { a += *(const f32x4*)(part + sl * sstride + off); b += *(const f32x4*)(part + sl * sstride + off + 4); }
    v[0] = a.x; v[1] = a.y; v[2] = a.z; v[3] = a.w; v[4] = b.x; v[5] = b.y; v[6] = b.z; v[7] = b.w;
}
__device__ __forceinline__ void st8(float* o, const float (&v)[8]) { *(f32x4*)o = (f32x4){v[0], v[1], v[2], v[3]}; *(f32x4*)(o + 4) = (f32x4){v[4], v[5], v[6], v[7]}; }
__device__ __forceinline__ void ld8(const float* p, float (&v)[8]) { const f32x4 a = *(const f32x4*)p, b = *(const f32x4*)(p + 4); v[0] = a.x; v[1] = a.y; v[2] = a.z; v[3] = a.w; v[4] = b.x; v[5] = b.y; v[6] = b.z; v[7] = b.w; }
template <int W>
__device__ __forceinline__ void pool_pair(const bf16* PROJ, bf16* DY, float* npp, const int (&rows)[2], int j0, bool hasB) {
    v4u cv[2], hv[2][W - 1];
#pragma unroll
    for (int r = 0; r < 2; ++r) { const int t = rows[r] & 2047; const bf16* pr = PROJ + (size_t)rows[r] * PP + j0; cv[r] = *(const v4u*)pr;
#pragma unroll
        for (int i = 1; i < W; ++i) hv[r][i - 1] = *(const v4u*)(pr - (size_t)(i <= t ? i : 0) * PP); }
    __builtin_amdgcn_sched_barrier(0);
#pragma unroll
    for (int r = 0; r < 2; ++r) { if (r == 1 && !hasB) break;
        const int m = rows[r], b = m >> 11, t = m & 2047; float cur[8], s[8];
        unpack8(cv[r], cur);
#pragma unroll
        for (int e = 0; e < 8; ++e) s[e] = cur[e];
#pragma unroll
        for (int i = 1; i < W; ++i) { float tmp[8]; unpack8(hv[r][i - 1], tmp);
#pragma unroll
            for (int e = 0; e < 8; ++e) s[e] += (i <= t) ? tmp[e] : 0.f; }
        const float inv = 1.0f / (float)((t + 1) < W ? (t + 1) : W); float d[8];
        if (t >= 2033) st8(npp + (size_t)(b * 15 + (t - 2033)) * 512 + j0, cur);
#pragma unroll
        for (int e = 0; e < 8; ++e) d[e] = s[e] * inv - cur[e];
        *(v4u*)(DY + (size_t)m * D + j0) = pack8(d); }
}
template <int W>
__device__ __forceinline__ void pool_adj(const bf16* PROJ, bf16* DY, float* npp, int r0, int j0) {
    const int r1 = r0 + 1, t1 = r1 & 2047, b = r1 >> 11;
    const bf16* p1 = PROJ + (size_t)r1 * PP + j0;
    v4u hv[W + 1];
#pragma unroll
    for (int k = 0; k <= W; ++k) hv[k] = *(const v4u*)(p1 - (size_t)(k <= t1 ? k : 0) * PP);
    __builtin_amdgcn_sched_barrier(0);
    float c1[8], c0[8], s0[8], vw[8];
    unpack8(hv[0], c1); unpack8(hv[1], c0);
#pragma unroll
    for (int e = 0; e < 8; ++e) s0[e] = c0[e];
#pragma unroll
    for (int k = 2; k <= W; ++k) { float tmp[8]; unpack8(hv[k], tmp);
#pragma unroll
        for (int e = 0; e < 8; ++e) { const float v = (k <= t1) ? tmp[e] : 0.f; s0[e] += v; if (k == W) vw[e] = v; } }
    const int t0 = t1 - 1;
    const float i0 = 1.0f / (float)((t0 + 1) < W ? (t0 + 1) : W), i1 = 1.0f / (float)((t1 + 1) < W ? (t1 + 1) : W);
    float d0[8], d1[8];
#pragma unroll
    for (int e = 0; e < 8; ++e) { d0[e] = s0[e] * i0 - c0[e]; d1[e] = (s0[e] + c1[e] - vw[e]) * i1 - c1[e]; }
    if (t0 >= 2033) st8(npp + (size_t)(b * 15 + (t0 - 2033)) * 512 + j0, c0);
    if (t1 >= 2033) st8(npp + (size_t)(b * 15 + (t1 - 2033)) * 512 + j0, c1);
    *(v4u*)(DY + (size_t)r0 * D + j0) = pack8(d0);
    *(v4u*)(DY + (size_t)r1 * D + j0) = pack8(d1);
}
__device__ __forceinline__ void p3_mixer(const Args& a, int tid) {
    const bf16* PROJ = (const bf16*)(a.ws + WS_PROJ); bf16* DY = (bf16*)(a.ws + WS_DY);
    const float* PART = (const float*)(a.ws + WS_PART); constexpr size_t PS = (size_t)MS * DIN;
    float* npp = a.out + O_NPP; float* ncp = a.out + O_NCP; float* nps = a.out + O_NPS; float* ncs = a.out + O_NCS;
    const long NT = (long)gridDim.x * 512;
    const int lane_ = tid & 63, gwv = blockIdx.x * NWAVES + (tid >> 6), NGWV = gridDim.x * NWAVES;
    for (int pw = gwv; pw < MP / 2; pw += NGWV) {
        const int g = pw & 3, r0 = (pw >> 2) * 8 + 2 * (lane_ >> 4), j0 = g * 128 + (lane_ & 15) * 8;
        if (g == 0) pool_adj<2>(PROJ, DY, npp, r0, j0);
        else if (g == 1) pool_adj<4>(PROJ, DY, npp, r0, j0);
        else if (g == 2) pool_adj<8>(PROJ, DY, npp, r0, j0);
        else pool_adj<16>(PROJ, DY, npp, r0, j0);
    }
    for (int cwi = gwv; cwi < MP / 2; cwi += NGWV) {
        const int q = 64 + lane_, mA = cwi, mB = cwi + MP / 2; const bool hasB = true;
        const int mm[2] = {mA, mB};
        {
            const int j0 = 8 * (q - 64);
            v4u rcx[2][3], rb[2];
#pragma unroll
            for (int r = 0; r < 2; ++r) { const int t = mm[r] & 2047; const bf16* pr = PROJ + (size_t)mm[r] * PP + j0; rb[r] = *(const v4u*)(pr + 512);
#pragma unroll
                for (int k = 0; k < 3; ++k) { const int kk = t >= k ? k : 0; rcx[r][k] = *(const v4u*)(pr - (size_t)kk * PP + 1024); } }
            const float* cwp = a.in[I_CONVW] + j0; float w0[8], w1[8], w2[8];
            ld8(cwp, w0); ld8(cwp + 512, w1); ld8(cwp + 1024, w2);
            __builtin_amdgcn_sched_barrier(0);
#pragma unroll
            for (int r = 0; r < 2; ++r) { if (r == 1 && !hasB) break;
                const int m = mm[r], b = m >> 11, t = m & 2047; float bv[8], cx[3][8], y[8];
                unpack8(rb[r], bv);
#pragma unroll
                for (int k = 0; k < 3; ++k) { float c2[8]; unpack8(rcx[r][k], c2);
#pragma unroll
                    for (int e = 0; e < 8; ++e) cx[k][e] = t >= k ? c2[e] : 0.f; }
#pragma unroll
                for (int e = 0; e < 8; ++e) y[e] = bv[e] * (w0[e] * cx[2][e] + w1[e] * cx[1][e] + w2[e] * cx[0][e]);
                *(v4u*)(DY + (size_t)m * D + 512 + j0) = pack8(y);
                if (t >= 2046) st8(ncp + (size_t)(b * 2 + t - 2046) * 512 + j0, cx[0]); }
        }
    }
    for (long it = (long)MP * 128 + (long)blockIdx.x * 512 + tid; it < (long)M * 128; it += NT) {
        const int m = (int)(it >> 7), q = (int)(it & 127);
        {
            const int sr = m - MP, b = sr >> 2, t = sr & 3;
            if (q < 64) {
                const int j0 = 8 * q, w = 2 << (j0 >> 7);
                float cur[8], s[8];
                ldpart8(PART, PS, 4, (size_t)sr * DIN + j0, cur);
#pragma unroll
                for (int e = 0; e < 8; ++e) s[e] = cur[e];
                for (int i = 1; i < w; ++i) { float tmp[8];
                    if (t - i >= 0) ldpart8(PART, PS, 4, (size_t)(sr - i) * DIN + j0, tmp); else ld8(a.in[I_SPOOL] + (size_t)(b * 15 + 15 + t - i) * 512 + j0, tmp);
#pragma unroll
                    for (int e = 0; e < 8; ++e) s[e] += tmp[e]; }
                st8(nps + (size_t)(b * 15 + 11 + t) * 512 + j0, cur);
                for (int i = t; i < 11; i += 4) { float tmp[8]; ld8(a.in[I_SPOOL] + (size_t)(b * 15 + i + 4) * 512 + j0, tmp); st8(nps + (size_t)(b * 15 + i) * 512 + j0, tmp); }
                const float inv = 1.0f / (float)w; float d[8];
#pragma unroll
                for (int e = 0; e < 8; ++e) d[e] = s[e] * inv - cur[e];
                *(v4u*)(DY + (size_t)m * D + j0) = pack8(d);
            } else {
                const int j0 = 8 * (q - 64);
                float xv[8], bv[8], cv[8], cx[3][8];
                const int xcol = 1024 + (j0 >> 7) * 256 + (j0 & 127);
                ldpart8(PART, PS, 4, (size_t)sr * DIN + 512 + j0, bv);
#pragma unroll
                for (int k = 0; k < 3; ++k) {
                    if (t - k >= 0) { ldpart8(PART, PS, 4, (size_t)(sr - k) * DIN + xcol, xv); ldpart8(PART, PS, 4, (size_t)(sr - k) * DIN + xcol + 128, cv);
#pragma unroll
                        for (int e = 0; e < 8; ++e) cx[k][e] = cv[e] * xv[e]; }
                    else ld8(a.in[I_SCONV] + (size_t)(b * 2 + 2 + t - k) * 512 + j0, cx[k]);
                }
                const float* cwp = a.in[I_CONVW] + j0; float w0[8], w1[8], w2[8], y[8];
                ld8(cwp, w0); ld8(cwp + 512, w1); ld8(cwp + 1024, w2);
#pragma unroll
                for (int e = 0; e < 8; ++e) y[e] = bv[e] * (w0[e] * cx[2][e] + w1[e] * cx[1][e] + w2[e] * cx[0][e]);
                *(v4u*)(DY + (size_t)m * D + 512 + j0) = pack8(y);
                if (t >= 2) st8(ncs + (size_t)(b * 2 + t - 2) * 512 + j0, cx[0]);
            }
        }
    }
}

__device__ __forceinline__ void p5_rowwise1(const Args& a, int lane, int wave, unsigned* done_cnt) {
    const float* MIX = (const float*)(a.ws + WS_MIX); bf16* H = (bf16*)(a.ws + WS_H); const float* mod = (const float*)(a.ws + WS_MOD); float* Y = a.out + O_Y;
    const int gw = blockIdx.x * NWAVES + wave, NGW = gridDim.x * NWAVES;
    int m0 = MP + gw, mstep = NGW;
    if (gridDim.x == 256) { m0 = blockIdx.x >= 192 ? MP + ((int)blockIdx.x - 192) * NWAVES + wave : M; mstep = M; }
    for (int m = m0; m < M; m += mstep) {
        const float* xr = xrow(a, m); const float* md = mod + (size_t)batch_of(m) * NMOD; const float* mr = (const float*)(a.ws + WS_PART) + (size_t)(m - MP) * D;
        f32x4 v[4]; float ss = 0.f;
#pragma unroll
        for (int j = 0; j < 4; ++j) { v[j] = (*(const f32x4*)(mr + 4 * lane + 256 * j) + *(const f32x4*)(mr + (size_t)MS * D + 4 * lane + 256 * j)) + (*(const f32x4*)(mr + 2 * (size_t)MS * D + 4 * lane + 256 * j) + *(const f32x4*)(mr + 3 * (size_t)MS * D + 4 * lane + 256 * j)); ss += (v[j].x * v[j].x + v[j].y * v[j].y) + (v[j].z * v[j].z + v[j].w * v[j].w); }
        const float r1 = 1.0f / sqrtf(wave_sum(ss) * (1.0f / D) + EPS);
        float s2 = 0.f;
#pragma unroll
        for (int j = 0; j < 4; ++j) { const int col = 4 * lane + 256 * j;
            const f32x4 x = *(const f32x4*)(xr + col), g = *(const f32x4*)(a.in[I_GPOSTMIX] + col), gt = *(const f32x4*)(md + 2048 + col);
            v[j] = x + gt * (v[j] * r1 * g);
            *(f32x4*)(Y + (size_t)m * D + col) = v[j];
            s2 += (v[j].x * v[j].x + v[j].y * v[j].y) + (v[j].z * v[j].z + v[j].w * v[j].w); }
        const float r2 = 1.0f / sqrtf(wave_sum(s2) * (1.0f / D) + EPS);
#pragma unroll
        for (int j = 0; j < 4; ++j) { const int col = 4 * lane + 256 * j;
            const f32x4 g = *(const f32x4*)(a.in[I_GPREFFN] + col), sc = *(const f32x4*)(md + 4096 + col), sh = *(const f32x4*)(md + 3072 + col);
            const f32x4 o = v[j] * r2 * g * (1.0f + sc) + sh;
            v2u w; w.x = pk2(o.x, o.y); w.y = pk2(o.z, o.w); *(v2u*)(H + (size_t)m * D + col) = w; }
        __threadfence();
        if (lane == 0) __hip_atomic_fetch_add(done_cnt, 1u, __ATOMIC_RELAXED, __HIP_MEMORY_SCOPE_AGENT);
    }
}

__device__ __forceinline__ void fixup_tile(const Args& a, int pm, int tid) {
    if ((pm & 7) == 0 || pm >= 64) return;
    const float* edge = (const float*)(a.ws + WS_EDGE); bf16* Gb = (bf16*)(a.ws + WS_G); const float* cw = a.in[I_FCONVW];
    for (int idx = tid; idx < DFF; idx += 512) {
        const int pn = idx >> 7, rho = idx & 127;
        const float* et = edge + (size_t)(pm * 22 + pn) * 1024; const float* eb = edge + (size_t)((pm - 1) * 22 + pn) * 1024 + 512;
        float u0[2], u1[2];
#pragma unroll
        for (int h = 0; h < 2; ++h) { const int tc = rho + 128 * h, c = h * DFF + idx;
            const float pb0 = eb[tc], pb1 = eb[256 + tc], t0 = et[tc], t1 = et[256 + tc];
            const float w0 = cw[c], w1 = cw[DUP + c], w2 = cw[2 * DUP + c];
            u0[h] = w0 * pb0 + w1 * pb1 + w2 * t0; u1[h] = w0 * pb1 + w1 * t0 + w2 * t1; }
        Gb[(size_t)(pm * 256) * DFF + idx] = (bf16)f2bf(silu_f(u0[0]) * u0[1]);
        Gb[(size_t)(pm * 256 + 1) * DFF + idx] = (bf16)f2bf(silu_f(u1[0]) * u1[1]);
    }
}

__device__ __forceinline__ void p9_rows(const Args& a, int lane, int m0, int m1, int mstep) {
    const float* Fb = (const float*)(a.ws + WS_F); const float* mod = (const float*)(a.ws + WS_MOD); float* Y = a.out + O_Y;
    for (int m = m0; m < m1; m += mstep) {
        const float* md = mod + (size_t)batch_of(m) * NMOD; const float* fr = (const float*)(a.ws + WS_PART) + (size_t)(m - MP) * D;
        f32x4 v[4]; float ss = 0.f;
#pragma unroll
        for (int j = 0; j < 4; ++j) { v[j] = *(const f32x4*)(fr + 4 * lane + 256 * j);
#pragma unroll
            for (int sl = 1; sl < 11; ++sl) v[j] += *(const f32x4*)(fr + sl * (size_t)MS * D + 4 * lane + 256 * j); ss += (v[j].x * v[j].x + v[j].y * v[j].y) + (v[j].z * v[j].z + v[j].w * v[j].w); }
        const float r1 = 1.0f / sqrtf(wave_sum(ss) * (1.0f / D) + EPS);
#pragma unroll
        for (int j = 0; j < 4; ++j) { const int col = 4 * lane + 256 * j;
            const f32x4 x = *(const f32x4*)(Y + (size_t)m * D + col), g = *(const f32x4*)(a.in[I_GPOSTFFN] + col), gt = *(const f32x4*)(md + 5120 + col);
            *(f32x4*)(Y + (size_t)m * D + col) = x + gt * (v[j] * r1 * g); }
    }
}

template <int NI, int NJ, int U>
__device__ __forceinline__ void sgemm_block(f32x4 (&acc)[NI][NJ], const bf16* ap, const bf16* bp, int K) {
    bf16x8 af[U][NI], bfr[U][NJ];
#pragma unroll
    for (int u = 0; u < U; ++u) {
#pragma unroll
        for (int i = 0; i < NI; ++i) af[u][i] = *(const bf16x8*)(ap + (size_t)i * 16 * K + u * 32);
#pragma unroll
        for (int j = 0; j < NJ; ++j) bfr[u][j] = *(const bf16x8*)(bp + (size_t)j * 16 * K + u * 32);
    }
    __builtin_amdgcn_sched_barrier(0);
#pragma unroll
    for (int u = 0; u < U; ++u)
#pragma unroll
        for (int i = 0; i < NI; ++i)
#pragma unroll
            for (int j = 0; j < NJ; ++j) acc[i][j] = __builtin_amdgcn_mfma_f32_16x16x32_bf16(bfr[u][j], af[u][i], acc[i][j], 0, 0, 0);
    __builtin_amdgcn_sched_barrier(0);
}
template <int NI, int NJ, int U, int NKS, class Epi>
__device__ __forceinline__ void sgemm_tile(const bf16* A, const bf16* Bt, int K, LAS unsigned char* lds, int tid, int lane, int wave, const Epi& epi) {
    LAS float* red = (LAS float*)lds;
    for (int i = tid; i < NI * NJ * 256; i += 512) red[i] = 0.f;
    __syncthreads();
    const int fr = lane & 15, fq = lane >> 4, kw = K / 8;
    const bf16* ap = A + (size_t)fr * K + wave * kw + fq * 8; const bf16* bp = Bt + (size_t)fr * K + wave * kw + fq * 8;
    f32x4 acc[NI][NJ];
#pragma unroll
    for (int i = 0; i < NI; ++i)
#pragma unroll
        for (int j = 0; j < NJ; ++j) acc[i][j] = (f32x4){0.f, 0.f, 0.f, 0.f};
#pragma unroll 1
    for (int ks = 0; ks + U <= NKS; ks += U) sgemm_block<NI, NJ, U>(acc, ap + ks * 32, bp + ks * 32, K);
    if constexpr (NKS % U != 0) sgemm_block<NI, NJ, NKS % U>(acc, ap + (NKS - NKS % U) * 32, bp + (NKS - NKS % U) * 32, K);
#pragma unroll
    for (int i = 0; i < NI; ++i)
#pragma unroll
        for (int j = 0; j < NJ; ++j)
#pragma unroll
            for (int e = 0; e < 4; ++e) __hip_atomic_fetch_add(red + ((i * NJ + j) * 4 + e) * 64 + lane, acc[i][j][e], __ATOMIC_RELAXED, __HIP_MEMORY_SCOPE_WORKGROUP);
    __syncthreads();
    for (int blk = wave; blk < NI * NJ; blk += 8) { const int i = blk / NJ, j = blk % NJ; const LAS float* rp = red + blk * 256 + lane; epi(i * 16 + fr, j * 16 + 4 * fq, (f32x4){rp[0], rp[64], rp[128], rp[192]}); }
    __syncthreads();
}

#define XB_TMO      128
#define XB_XCNT(j)  (256  + 64 * (j))
#define XB_XSUB(j)  (1280 + 64 * (j))
#define XB_XGEN(j)  (2304 + 64 * (j))
#define XB_TOP      3328
#define XB_TOPGEN   3392
#define XCD_BAR_WORDS 3456
#define XB_SPIN_CAP (1u << 18)

__device__ __forceinline__ unsigned xb_ld(unsigned* p)              { return __hip_atomic_load(p, __ATOMIC_RELAXED, __HIP_MEMORY_SCOPE_AGENT); }
__device__ __forceinline__ unsigned xb_add(unsigned* p, unsigned v) { return __hip_atomic_fetch_add(p, v, __ATOMIC_RELAXED, __HIP_MEMORY_SCOPE_AGENT); }
__device__ __forceinline__ unsigned xb_xcc_id() { return (unsigned)__builtin_amdgcn_s_getreg((3 << 11) | 20) & 0xFu; }
#define XB_SPIN(cond, bar) do { unsigned _sp = 0; while (cond) { __builtin_amdgcn_s_sleep(1); \
    if ((++_sp & 255u) == 0u) { if (xb_ld(&(bar)[XB_TMO])) break; if (_sp > XB_SPIN_CAP) { atomicAdd(&(bar)[XB_TMO], 1u); break; } } } } while (0)

struct XcdBarrier {
    unsigned* bar; unsigned x;
    volatile LAS unsigned* st;
};

__device__ __forceinline__ XcdBarrier xcd_barrier_post(unsigned* bar, volatile LAS unsigned* st) {
    XcdBarrier b; b.bar = bar; b.x = xb_xcc_id(); b.st = st;
    if (threadIdx.x == 0) (void)xb_add(&bar[XB_XCNT(b.x)], 1u);
    return b;
}
__device__ __forceinline__ void xcd_barrier_complete(unsigned* bar, unsigned x, unsigned& nloc, unsigned& nx) {
    const unsigned G = gridDim.x * gridDim.y * gridDim.z;
    unsigned sum, cnt, mine, sp = 0u;
    for (;;) {
        sum = 0u; cnt = 0u; mine = 0u;
#pragma unroll
        for (unsigned j = 0; j < 16; ++j) { const unsigned c = xb_ld(&bar[XB_XCNT(j)]); sum += c; cnt += (c > 0u) ? 1u : 0u; mine = (j == x) ? c : mine; }
        if (sum == G) break;
        __builtin_amdgcn_s_sleep(1);
        if ((++sp & 255u) == 0u) { if (xb_ld(&bar[XB_TMO])) break; if (sp > XB_SPIN_CAP) { atomicAdd(&bar[XB_TMO], 1u); break; } }
    }
    nloc = mine > 0u ? mine : 1u; nx = cnt > 0u ? cnt : 1u;
}

__device__ __forceinline__ void xcd_barrier(const XcdBarrier& b) {
    asm volatile("s_waitcnt vmcnt(0)" ::: "memory");
    __syncthreads();
    if (threadIdx.x == 0) {
        unsigned* bar = b.bar;
        __builtin_amdgcn_s_waitcnt(0);
        unsigned nloc = b.st[0], nx = b.st[1];
        if (nloc == 0u) { xcd_barrier_complete(bar, b.x, nloc, nx); b.st[0] = nloc; b.st[1] = nx; }
        const unsigned old = xb_add(&bar[XB_XSUB(b.x)], 1u);
        const unsigned gen = old / nloc;
        if (old + 1u == (gen + 1u) * nloc) {
            __builtin_amdgcn_fence(__ATOMIC_RELEASE, "agent");
            asm volatile("s_waitcnt vmcnt(0)" ::: "memory");
            const unsigned og = xb_add(&bar[XB_TOP], 1u);
            const unsigned tg = og / nx;
            if (og + 1u == (tg + 1u) * nx) xb_add(&bar[XB_TOPGEN], 1u);
            else XB_SPIN(xb_ld(&bar[XB_TOPGEN]) == tg, bar);
            __builtin_amdgcn_fence(__ATOMIC_ACQUIRE, "agent");
            xb_add(&bar[XB_XGEN(b.x)], 1u);
            asm volatile("s_waitcnt vmcnt(0)" ::: "memory");
        } else {
            XB_SPIN(xb_ld(&bar[XB_XGEN(b.x)]) == gen, bar);
            __builtin_amdgcn_fence(__ATOMIC_ACQUIRE, "agent");
            asm volatile("s_waitcnt vmcnt(0)" ::: "memory");
        }
    }
    __syncthreads();
}

__global__ void __launch_bounds__(NWAVES * 64, 2) fwd_mk(Args args) {
    extern __shared__ __attribute__((aligned(16))) unsigned char lds_raw[];
    LAS unsigned char* lds = (LAS unsigned char*)lds_raw;
    const int tid = threadIdx.x, lane = tid & 63, wave = __builtin_amdgcn_readfirstlane(tid >> 6);
    const int lo = args.ph_lo, hi = args.ph_hi, G = gridDim.x;
    unsigned char* ws = args.ws;
#define IN(k) (lo <= (k) && (k) < hi)
#define REP(k) for (int rep_ = 0; rep_ <= ((REPMASK >> (k)) & 1); ++rep_)
#define SEAM(k) do { if (IN(k) && IN((k) + 1)) xcd_barrier(bar); } while (0)
    volatile LAS unsigned* MISC = (volatile LAS unsigned*)(lds + EB_OFF + 12288);
    if (tid < 2) MISC[tid] = 0u;
    __syncthreads();
    XcdBarrier bar; bar.bar = (unsigned*)(ws + WS_CTL) + 16384; bar.x = 0; bar.st = MISC;
    if (hi - lo > 1) bar = xcd_barrier_post((unsigned*)(ws + WS_CTL) + 16384, MISC);
    if (lo < -1) cg::this_grid().sync();
    if (IN(0)) { p0_prologue(args, lds, tid, lane, wave); } SEAM(0);
    if (IN(1)) { p1_norm(args, lane, wave); } SEAM(1);
    if (IN(2)) {
        pg8::Gemm g{(const bf16*)(ws + WS_H), (const bf16*)(ws + WS_WIN), MP, DIN, D}; pg8::StaticOrder S; S.init(MP, DIN, G, (int)blockIdx.x);
        pg8::EpiProj E{(bf16*)(ws + WS_PROJ)};
        pg8::gemm_phase<pg8::EpiProj, pg8::StaticOrder, true, true>(lds, g, S, E);
        { pg8::Gemm gs{(const bf16*)(ws + WS_H), (const bf16*)(ws + WS_WIN), M, DIN, 256, D}; pg8::SliceOrder Ss{DIN / 256, 4, (int)blockIdx.x};
          pg8::EpiF32Part Es{(float*)(ws + WS_PART), DIN, (size_t)MS * DIN};
          pg8::gemm_phase<pg8::EpiF32Part, pg8::SliceOrder, true, true>(lds, gs, Ss, Es); }
        if (G == 256 && blockIdx.x >= 64) weight_items(args, lds, lane, wave, 2688 + ((int)blockIdx.x - 64) * 8 + wave, 1536, 1, 4096);
    } SEAM(2);
    if (IN(3)) { p3_mixer(args, tid); } SEAM(3);
    if (IN(4)) {
        { pg8::Gemm g{(const bf16*)(ws + WS_DY), (const bf16*)(ws + WS_WOUT), MP, D, D}; pg8::StaticOrder S; S.init(MP, D, G, (int)blockIdx.x);
          unsigned* ctl = (unsigned*)(ws + WS_CTL); unsigned* xb = (unsigned*)(ws + WS_XB);
          pg8::PanelRms st1{xb, ctl, EPS}, st2{xb + 65536, ctl + CNT_BANK_WORDS, EPS};
          pg8::EpiMixNorm E{args.in[I_XP], (bf16*)(ws + WS_X1), (bf16*)(ws + WS_H), (const float*)(ws + WS_MOD), args.in[I_GPOSTMIX], args.in[I_GPREFFN], st1, st2};
          if (G == 256) pg8::gemm_phase<pg8::EpiMixNorm, pg8::StaticOrder, false, true>(lds, g, S, E); }
        __syncthreads();
        { pg8::Gemm gs{(const bf16*)(ws + WS_DY), (const bf16*)(ws + WS_WOUT), M, D, 256, D}; pg8::SliceOrder Ss{D / 256, 4, (int)blockIdx.x};
          pg8::EpiF32Part Es{(float*)(ws + WS_PART), D, (size_t)MS * D};
          pg8::gemm_phase<pg8::EpiF32Part, pg8::SliceOrder, true, true>(lds, gs, Ss, Es); }
        if (G == 256 && blockIdx.x >= 32) weight_items(args, lds, lane, wave, 4096 + ((int)blockIdx.x - 32) * 8 + wave, 1792, 1, 4800);
    } SEAM(4);
    if (IN(6)) {
        unsigned* cnt5 = (unsigned*)(ws + WS_CTL) + 3 * CNT_BANK_WORDS + 64;
        p5_rowwise1(args, lane, wave, cnt5);
        pg8::Gemm g{(const bf16*)(ws + WS_H), (const bf16*)(ws + WS_WUP), M, DUP, D}; pg8::UpOrder S; S.init(M, DUP, G, (int)blockIdx.x); S.ready = cnt5; S.need = MS;
        pg8::EpiUpGate E{(bf16*)(ws + WS_G), args.in[I_FCONVW], args.in[I_SFFN], args.out + O_NFP, args.out + O_NFS, (float*)(ws + WS_EDGE), (LAS float*)(lds + EB_OFF)};
        pg8::gemm_phase<pg8::EpiUpGate, pg8::UpOrder, true, true>(lds, g, S, E);
    } SEAM(6);
    if (IN(8)) {
        { pg8::Gemm g{(const bf16*)(ws + WS_G), (const bf16*)(ws + WS_WDN), MP, D, DFF}; pg8::StaticOrder S; S.init(MP, D, G, (int)blockIdx.x);
          { pg8::Unit u; for (int i = 0; S.next(i, u); ++i) fixup_tile(args, u.pm, tid); asm volatile("s_waitcnt vmcnt(0)" ::: "memory"); __syncthreads(); }
          pg8::PanelRms st{(unsigned*)(ws + WS_XB) + 131072, (unsigned*)(ws + WS_CTL) + 2 * CNT_BANK_WORDS, EPS};
          pg8::EpiFfnNorm E{(const bf16*)(ws + WS_X1), args.out + O_Y, (const float*)(ws + WS_MOD), args.in[I_GPOSTFFN], st};
          if (G == 256) pg8::gemm_phase<pg8::EpiFfnNorm, pg8::StaticOrder, false, true>(lds, g, S, E); }
        __syncthreads();
        { pg8::Gemm gs{(const bf16*)(ws + WS_G), (const bf16*)(ws + WS_WDN), M, D, 256, DFF}; pg8::SliceOrder Ss{D / 256, 11, (int)blockIdx.x};
          pg8::EpiF32Part Es{(float*)(ws + WS_PART), D, (size_t)MS * D};
          pg8::gemm_phase<pg8::EpiF32Part, pg8::SliceOrder, true, true>(lds, gs, Ss, Es); }
    } SEAM(8);
    if (IN(9)) { const int gw = blockIdx.x * NWAVES + wave; p9_rows(args, lane, MP + gw, M, G * NWAVES); }
#undef IN
#undef SEAM
}

extern "C" void kernel_launch(void* const* d_in, const int* in_sizes, int n_in, void* d_out, int out_size, void* d_ws, size_t ws_size, hipStream_t stream) {
    static int grid = 0;
    if (grid == 0) {
        if (n_in != 21 || out_size != (int)O_END || ws_size < WS_END) { fprintf(stderr, "kernel_launch: unexpected shapes (n_in %d out %d ws %zu)\n", n_in, out_size, ws_size); grid = -1; return; }
        int dev = 0, cus = 0, per_cu = 0;
        hipGetDevice(&dev); hipDeviceGetAttribute(&cus, hipDeviceAttributeMultiprocessorCount, dev);
        if (hipFuncSetAttribute((const void*)fwd_mk, hipFuncAttributeMaxDynamicSharedMemorySize, LDS_BYTES) != hipSuccess) { fprintf(stderr, "kernel_launch: hipFuncSetAttribute failed\n"); grid = -1; return; }
        if (hipOccupancyMaxActiveBlocksPerMultiprocessor(&per_cu, (const void*)fwd_mk, NWAVES * 64, LDS_BYTES) != hipSuccess || per_cu < 1) { fprintf(stderr, "kernel_launch: occupancy query says %d\n", per_cu); per_cu = 1; }
        (void)hipGetLastError();
        grid = cus > 0 ? cus : 256;
    }
    if (grid < 0) return;
    if (hipMemsetAsync((char*)d_ws + WS_CTL + 65536, 0, 16384, stream) != hipSuccess) { fprintf(stderr, "kernel_launch: memset failed\n"); return; }
    Args a{};
    for (int i = 0; i < 21; ++i) a.in[i] = (const float*)d_in[i];
    a.out = (float*)d_out; a.ws = (unsigned char*)d_ws;
#if MK_COOP
    a.ph_lo = 0; a.ph_hi = NPHASE;
    void* kargs[] = {&a};
    hipError_t e = hipLaunchCooperativeKernel((const void*)fwd_mk, dim3(grid), dim3(NWAVES * 64), kargs, LDS_BYTES, stream);
    if (e != hipSuccess) fprintf(stderr, "kernel_launch: cooperative launch failed: %s (grid %d)\n", hipGetErrorString(e), grid);
#else
    for (int p = 0; p < NPHASE; ++p) for (int rep_ = 0; rep_ <= ((REPMASK >> p) & 1); ++rep_) { a.ph_lo = p; a.ph_hi = p + 1; hipLaunchKernelGGL(fwd_mk, dim3(grid), dim3(NWAVES * 64), LDS_BYTES, stream, a); }
#endif
}
```

```cpp
#include <hip/hip_runtime.h>
#include <hip/hip_cooperative_groups.h>
#include <cstdio>
#include <cstdint>
namespace cg = cooperative_groups;
namespace pg8 {
#define PG8_LAS __attribute__((address_space(3)))
typedef unsigned short bf16_t;
typedef short bf16x8 __attribute__((ext_vector_type(8)));
typedef float f32x4 __attribute__((ext_vector_type(4)));
typedef unsigned u32x4 __attribute__((ext_vector_type(4)));
constexpr int BM = 256, BK = 64, HALF = 128, HTB = HALF * BK * 2  , STAGE_BYTES = 8 * HTB, NXCD = 8, WGM = 8;

__host__ __device__ __forceinline__ int lds_byte(int r, int c) { const int st = (r >> 4) * 2 + (c >> 5), rr = r & 15, cc = c & 31, ob = rr * 64 + cc * 2; return st * 1024 + (ob ^ (((ob >> 9) & 1) << 5)); }
__host__ __device__ __forceinline__ void stage_rc(int b, int& R, int& C) { const int st = b / 1024, sb = b % 1024, swz = sb ^ (((sb >> 9) & 1) << 5); R = (st >> 1) * 16 + swz / 64; C = (st & 1) * 32 + (swz % 64) / 2; }
__host__ __device__ __forceinline__ int perm32(int rho) { const int n = rho >> 4, i = rho & 15; return 8 * (i >> 2) + 4 * n + (i & 3); }

struct Unit { int pm, pn, ks; };
struct Gemm { const bf16_t* A; const bf16_t* Bt; int M, N, K; int P = 0; };

struct StaticOrder {
    int nM, nN, nwg, G, c;
    __host__ __device__ void init(int M, int N, int G_, int c_) { nM = M / BM; nN = N / BM; nwg = nM * nN; G = G_; c = c_; }
    __host__ __device__ bool next(int i, Unit& u) const {
        const long L = (long)i * G + c; if (L >= nwg) return false;
        int wgid = (int)L; { const int q = nwg / NXCD, r = nwg % NXCD, xcd = wgid % NXCD, off = wgid / NXCD; wgid = (xcd < r ? xcd * (q + 1) : r * (q + 1) + (xcd - r) * q) + off; }
        const int nig = WGM * nN, gid = wgid / nig, fm = gid * WGM, gsz = (nM - fm) < WGM ? (nM - fm) : WGM;
        u.pm = fm + ((wgid % nig) % gsz); u.pn = (wgid % nig) / gsz; u.ks = 0; return true;
    }
    __device__ __forceinline__ void a_ready(const Unit&) const {}
    __device__ __forceinline__ void done(const Unit&) const {}
};

__device__ __forceinline__ unsigned cvt_pk_bf16(float lo, float hi) { unsigned r; asm volatile("v_cvt_pk_bf16_f32 %0, %1, %2" : "=v"(r) : "v"(lo), "v"(hi)); return r; }
typedef float f32x2 __attribute__((ext_vector_type(2)));
__device__ __forceinline__ f32x2 gelu_pk(f32x2 v) {
    const f32x2 av = __builtin_elementwise_abs(v), d = av * 0.2316418882f + 1.0f;
    f32x2 t; t.x = __builtin_amdgcn_rcpf(d.x); t.y = __builtin_amdgcn_rcpf(d.y);
    f32x2 q = t * 0.5307027145f + (-0.7265760135f); q = q * t + 0.7107068705f; q = q * t + (-0.142248368f); q = q * t + 0.127414796f; q = q * t;
    const f32x2 s = (v * v) * (-0.72134752044f);
    f32x2 e; e.x = __builtin_amdgcn_exp2f(s.x); e.y = __builtin_amdgcn_exp2f(s.y);
    const f32x2 m = v * (q * e), r = v - m;
    f32x2 o; o.x = v.x < 0.f ? m.x : r.x; o.y = v.y < 0.f ? m.y : r.y; return o;
}

template <int ACT  > struct EpiBf16 {
    static constexpr bool PERM = true, AFTER_DRAIN = false; static_assert(ACT == 0 || ACT == 1, "EpiBf16: ACT is 0 (none) or 1 (gelu_pk)");
    bf16_t* O; int ldc; const float* bias; int split_cols; size_t split_stride; float scale0;
    __device__ __forceinline__ void operator()(const f32x4 (&acc)[2][2][4][2], const Unit& u, int wr, int wc, int fr, int fq) const {
        const int row0 = u.pm * BM + wr * 64 + fr; int colt = u.pn * BM; bf16_t* base = O;
        float sc = 1.f; if (split_cols) { const int t = colt / split_cols; base += (size_t)t * split_stride; colt -= t * split_cols; if (t == 0) sc = scale0; }
        const int col0 = colt + wc * 32 + 8 * fq, bcol0 = u.pn * BM + wc * 32 + 8 * fq;
        f32x4 bv[2][2];
#pragma unroll
        for (int bj = 0; bj < 2; ++bj)
#pragma unroll
            for (int n = 0; n < 2; ++n) bv[bj][n] = bias ? *(const f32x4*)(bias + bcol0 + bj * HALF + 4 * n) : (f32x4){0.f, 0.f, 0.f, 0.f};
#pragma unroll
        for (int ai = 0; ai < 2; ++ai)
#pragma unroll
            for (int m = 0; m < 4; ++m) { bf16_t* rowp = base + (size_t)(row0 + ai * HALF + m * 16) * ldc + col0;
#pragma unroll
                for (int bj = 0; bj < 2; ++bj) { f32x4 v0 = acc[ai][bj][m][0] + bv[bj][0], v1 = acc[ai][bj][m][1] + bv[bj][1];
                    if (ACT == 1) { f32x2 a = gelu_pk((f32x2){v0[0], v0[1]}), b = gelu_pk((f32x2){v0[2], v0[3]}), c = gelu_pk((f32x2){v1[0], v1[1]}), d = gelu_pk((f32x2){v1[2], v1[3]});
                        v0 = (f32x4){a.x, a.y, b.x, b.y}; v1 = (f32x4){c.x, c.y, d.x, d.y}; }
                    v0 = v0 * sc; v1 = v1 * sc; u32x4 w; w.x = cvt_pk_bf16(v0[0], v0[1]); w.y = cvt_pk_bf16(v0[2], v0[3]); w.z = cvt_pk_bf16(v1[0], v1[1]); w.w = cvt_pk_bf16(v1[2], v1[3]);
                    *(u32x4*)(rowp + bj * HALF) = w; } }
    }
};
struct EpiF32 {
    static constexpr bool PERM = false, AFTER_DRAIN = false;
    float* O; int ldc;
    __device__ __forceinline__ void operator()(const f32x4 (&acc)[2][2][4][2], const Unit& u, int wr, int wc, int fr, int fq) const {
        const int row0 = u.pm * BM + wr * 64 + fr, col0 = u.pn * BM + wc * 32 + 4 * fq;
#pragma unroll
        for (int ai = 0; ai < 2; ++ai)
#pragma unroll
            for (int m = 0; m < 4; ++m) { float* rowp = O + (size_t)(row0 + ai * HALF + m * 16) * ldc + col0;
#pragma unroll
                for (int bj = 0; bj < 2; ++bj)
#pragma unroll
                    for (int n = 0; n < 2; ++n) *(f32x4*)(rowp + bj * HALF + n * 16) = acc[ai][bj][m][n]; }
    }
};
struct EpiProj {
    static constexpr bool PERM = true, AFTER_DRAIN = false;
    bf16_t* O;
    __device__ __forceinline__ void operator()(const f32x4 (&acc)[2][2][4][2], const Unit& u, int wr, int wc, int fr, int fq) const {
        const int row0 = u.pm * BM + wr * 64 + fr, cl = wc * 32 + 8 * fq;
#pragma unroll
        for (int ai = 0; ai < 2; ++ai)
#pragma unroll
            for (int m = 0; m < 4; ++m) { bf16_t* rowp = O + (size_t)(row0 + ai * HALF + m * 16) * 1536;
                if (u.pn < 4) {
#pragma unroll
                    for (int bj = 0; bj < 2; ++bj) { const f32x4 v0 = acc[ai][bj][m][0], v1 = acc[ai][bj][m][1]; u32x4 w;
                        w.x = cvt_pk_bf16(v0[0], v0[1]); w.y = cvt_pk_bf16(v0[2], v0[3]); w.z = cvt_pk_bf16(v1[0], v1[1]); w.w = cvt_pk_bf16(v1[2], v1[3]);
                        *(u32x4*)(rowp + u.pn * BM + bj * HALF + cl) = w; }
                } else {
                    const f32x4 v0 = acc[ai][0][m][0] * acc[ai][1][m][0], v1 = acc[ai][0][m][1] * acc[ai][1][m][1]; u32x4 w;
                    w.x = cvt_pk_bf16(v0[0], v0[1]); w.y = cvt_pk_bf16(v0[2], v0[3]); w.z = cvt_pk_bf16(v1[0], v1[1]); w.w = cvt_pk_bf16(v1[2], v1[3]);
                    *(u32x4*)(rowp + 1024 + (u.pn - 4) * HALF + cl) = w;
                } }
    }
};
__device__ __forceinline__ f32x4 shfl4(f32x4 v, int src) { f32x4 r; r.x = __shfl(v.x, src); r.y = __shfl(v.y, src); r.z = __shfl(v.z, src); r.w = __shfl(v.w, src); return r; }
template <int N> __device__ __forceinline__ float dpp_ror(float v) { return __builtin_bit_cast(float, __builtin_amdgcn_mov_dpp(__builtin_bit_cast(int, v), 0x120 + N, 0xf, 0xf, true)); }
template <int N> __device__ __forceinline__ f32x4 ror4(f32x4 v) { f32x4 r; r.x = dpp_ror<N>(v.x); r.y = dpp_ror<N>(v.y); r.z = dpp_ror<N>(v.z); r.w = dpp_ror<N>(v.w); return r; }
template <int N> __device__ __forceinline__ float dpp_shr_old(float old, float v) { return __builtin_bit_cast(float, __builtin_amdgcn_update_dpp(__builtin_bit_cast(int, old), __builtin_bit_cast(int, v), 0x110 + N, 0xf, 0xf, false)); }
template <int N> __device__ __forceinline__ f32x4 shr4(f32x4 old, f32x4 v) { f32x4 r; r.x = dpp_shr_old<N>(old.x, v.x); r.y = dpp_shr_old<N>(old.y, v.y); r.z = dpp_shr_old<N>(old.z, v.z); r.w = dpp_shr_old<N>(old.w, v.w); return r; }
struct EpiUpGate {
    static constexpr bool PERM = true, AFTER_DRAIN = false;
    bf16_t* G; const float* cw; const float* st; float* nfp; float* nfs; float* edge; PG8_LAS float* eb;
    __device__ __forceinline__ void operator()(const f32x4 (&acc)[2][2][4][2], const Unit& u, int wr, int wc, int fr, int fq) const {
        const int lane = fq * 16 + fr;
        const int tc0 = wc * 32 + 8 * fq, j0 = u.pn * 128 + tc0;
        const int src1 = (lane & 48) | ((fr + 15) & 15), src2 = (lane & 48) | ((fr + 14) & 15);
        const bool sample = u.pm >= 64;
        PG8_LAS float* wl = eb + 2048;
        { const int t_ = (int)threadIdx.x; if (t_ < 256) { const int c_ = (t_ < 128 ? 0 : 2816 - 128) + u.pn * 128 + t_;
#pragma unroll
            for (int k = 0; k < 3; ++k) wl[k * 256 + t_] = cw[k * 5632 + c_]; } }
        if (!sample && fr >= 14) {
#pragma unroll
            for (int ai = 0; ai < 2; ++ai)
#pragma unroll
                for (int bj = 0; bj < 2; ++bj)
#pragma unroll
                    for (int n = 0; n < 2; ++n) *(PG8_LAS f32x4*)(eb + ((2 * ai + wr) * 2 + (fr - 14)) * 256 + 128 * bj + tc0 + 4 * n) = acc[ai][bj][3][n];
        }
        asm volatile("s_waitcnt lgkmcnt(0)" ::: "memory"); __builtin_amdgcn_s_barrier(); asm volatile("" ::: "memory");
#pragma unroll
        for (int ai = 0; ai < 2; ++ai) {
            const int blk = 2 * ai + wr;
#pragma unroll
            for (int m = 0; m < 4; ++m) {
                const int r = 128 * ai + 64 * wr + 16 * m + fr;
                int wo = tc0; asm volatile("" : "+v"(wo));
                f32x4 uu[2][2];
#pragma unroll
                for (int bj = 0; bj < 2; ++bj)
#pragma unroll
                    for (int n = 0; n < 2; ++n) {
                        const f32x4 x = acc[ai][bj][m][n];
                        f32x4 p1, p2;
                        if (!sample) {
                            if (m > 0) {
                                const f32x4 xp = acc[ai][bj][m > 0 ? m - 1 : 0][n];
                                p1 = shr4<1>(ror4<1>(xp), x); p2 = shr4<2>(ror4<2>(xp), x);
                            } else {
                                f32x4 b1 = (f32x4){0.f, 0.f, 0.f, 0.f}, b2 = b1;
                                if (blk > 0) { b1 = *(const PG8_LAS f32x4*)(eb + ((blk - 1) * 2 + 1) * 256 + 128 * bj + tc0 + 4 * n);
                                               b2 = *(const PG8_LAS f32x4*)(eb + ((blk - 1) * 2 + (fr == 0 ? 0 : 1)) * 256 + 128 * bj + tc0 + 4 * n); }
                                p1 = shr4<1>(b1, x); p2 = shr4<2>(b2, x);
                            }
                        } else {
                            const int srow = (u.pm - 64) * 256 + r, b = srow >> 2, t = fr & 3;
                            p1 = ror4<1>(x); p2 = ror4<2>(x);
                            const size_t so = (size_t)b * 2 * 5632 + bj * 2816 + j0 + 4 * n;
                            if (t < 2) { const f32x4 s0 = *(const f32x4*)(st + so), s1 = *(const f32x4*)(st + so + 5632);
                                if (t == 0) { p1 = s1; p2 = s0; } else { p2 = s1; } }
                            else *(f32x4*)(nfs + so + (size_t)(t - 2) * 5632) = x;
                        }
                        const PG8_LAS float* wp = wl + 128 * bj + wo + 4 * n;
                        uu[bj][n] = *(const PG8_LAS f32x4*)wp * p2 + *(const PG8_LAS f32x4*)(wp + 256) * p1 + *(const PG8_LAS f32x4*)(wp + 512) * x;
                    }
                float gv[8];
#pragma unroll
                for (int n = 0; n < 2; ++n)
#pragma unroll
                    for (int c = 0; c < 4; ++c) { const float a = uu[0][n][c], b = uu[1][n][c]; gv[n * 4 + c] = a * __builtin_amdgcn_rcpf(1.0f + __expf(-a)) * b; }
                u32x4 o; o.x = cvt_pk_bf16(gv[0], gv[1]); o.y = cvt_pk_bf16(gv[2], gv[3]); o.z = cvt_pk_bf16(gv[4], gv[5]); o.w = cvt_pk_bf16(gv[6], gv[7]);
                const bool deferred = (!sample) && (blk == 0) && (m == 0) && (fr < 2) && ((u.pm & 7) != 0);
                if (!deferred) *(u32x4*)(G + (size_t)(u.pm * BM + r) * 2816 + j0) = o;
            }
        }
        if (!sample) {
            float* eg = edge + (size_t)(u.pm * 22 + u.pn) * 1024;
            if (wr == 0 && fr < 2) {
#pragma unroll
                for (int bj = 0; bj < 2; ++bj)
#pragma unroll
                    for (int n = 0; n < 2; ++n) *(f32x4*)(eg + fr * 256 + 128 * bj + tc0 + 4 * n) = acc[0][bj][0][n];
            }
            if (wr == 1 && fr >= 14) {
#pragma unroll
                for (int bj = 0; bj < 2; ++bj)
#pragma unroll
                    for (int n = 0; n < 2; ++n) { *(f32x4*)(eg + (2 + fr - 14) * 256 + 128 * bj + tc0 + 4 * n) = acc[1][bj][3][n];
                        if ((u.pm & 7) == 7) *(f32x4*)(nfp + (size_t)((u.pm >> 3) * 2 + (fr - 14)) * 5632 + bj * 2816 + j0 + 4 * n) = acc[1][bj][3][n]; }
            }
        }
    }
};
struct PanelRms {
    unsigned* xbuf;
    unsigned* cnt;
    float eps;
    __device__ __forceinline__ void run(const f32x4 (&v)[2][2][4][2], const Unit& u, int wr, int wc, int fr, int fq, PG8_LAS unsigned char* lds, int wid, int lane) const {
        PG8_LAS float* P = (PG8_LAS float*)lds;
        PG8_LAS float* S = (PG8_LAS float*)(lds + 8192);
#pragma unroll
        for (int ai = 0; ai < 2; ++ai)
#pragma unroll
            for (int m = 0; m < 4; ++m) {
                float q = 0.f;
#pragma unroll
                for (int bj = 0; bj < 2; ++bj)
#pragma unroll
                    for (int n = 0; n < 2; ++n) { const f32x4 x = v[ai][bj][m][n]; q += (x[0] * x[0] + x[1] * x[1]) + (x[2] * x[2] + x[3] * x[3]); }
                q += __shfl_xor(q, 16); q += __shfl_xor(q, 32);
                if (fq == 0) P[(ai * HALF + wr * 64 + m * 16 + fr) * 4 + wc] = q;
            }
        asm volatile("s_waitcnt lgkmcnt(0)" ::: "memory"); __builtin_amdgcn_s_barrier(); asm volatile("" ::: "memory");
        const int row = wid * 32 + (lane & 31);
        if (lane < 32) {
            const float q = (P[row * 4 + 0] + P[row * 4 + 1]) + (P[row * 4 + 2] + P[row * 4 + 3]);
            __hip_atomic_store(xbuf + ((size_t)(u.pm * BM + row) * 4 + u.pn), __float_as_uint(q), __ATOMIC_RELAXED, __HIP_MEMORY_SCOPE_AGENT);
        }
        asm volatile("s_waitcnt vmcnt(0)" ::: "memory");
        if (lane == 0) __hip_atomic_fetch_add(cnt + 64 * u.pm, 1u, __ATOMIC_RELAXED, __HIP_MEMORY_SCOPE_AGENT);
        if (wid == 0) {
            unsigned spins = 0;
            for (;;) {
                if ((unsigned)__builtin_amdgcn_readfirstlane(__hip_atomic_load(cnt + 64 * u.pm, __ATOMIC_RELAXED, __HIP_MEMORY_SCOPE_AGENT)) >= 32u) break;
                if (++spins > (1u << 22)) break;
                __builtin_amdgcn_s_sleep(2);
            }
            __builtin_amdgcn_fence(__ATOMIC_ACQUIRE, "agent");
        }
        asm volatile("s_waitcnt vmcnt(0) lgkmcnt(0)" ::: "memory"); __builtin_amdgcn_s_barrier(); asm volatile("" ::: "memory");
        if (lane < 32) {
            const unsigned* slot = xbuf + (size_t)(u.pm * BM + row) * 4; float q = 0.f;
#pragma unroll
            for (int t = 0; t < 4; ++t) q += __uint_as_float(__hip_atomic_load(slot + t, __ATOMIC_RELAXED, __HIP_MEMORY_SCOPE_AGENT));
            S[row] = 1.0f / sqrtf(q * (1.0f / 1024.0f) + eps);
        }
        asm volatile("s_waitcnt lgkmcnt(0)" ::: "memory"); __builtin_amdgcn_s_barrier(); asm volatile("" ::: "memory");
    }
};
struct EpiMixNorm {
    static constexpr bool PERM = false, AFTER_DRAIN = true;
    const float* x; bf16_t* X1; bf16_t* H; const float* mod; const float* gpm; const float* gpf; PanelRms st1, st2;
    __device__ __forceinline__ void fused(f32x4 (&acc)[2][2][4][2], const Unit& u, int wr, int wc, int fr, int fq, PG8_LAS unsigned char* lds, int wid, int lane) const {
        typedef unsigned u32x2v __attribute__((ext_vector_type(2)));
        const PG8_LAS float* S = (const PG8_LAS float*)(lds + 8192);
        const float* md = mod + (size_t)(u.pm >> 3) * 6144;
        const int col0 = u.pn * BM + wc * 32 + 4 * fq;
        f32x4 pre[2][2][2];
#pragma unroll
        for (int m = 0; m < 2; ++m) { const size_t off = (size_t)(u.pm * BM + wr * 64 + m * 16 + fr) * 1024 + col0;
#pragma unroll
            for (int bj = 0; bj < 2; ++bj)
#pragma unroll
                for (int n = 0; n < 2; ++n) pre[m][bj][n] = *(const f32x4*)(x + off + bj * HALF + n * 16); }
        st1.run(acc, u, wr, wc, fr, fq, lds, wid, lane);
        f32x4 cf[2][2];
#pragma unroll
        for (int bj = 0; bj < 2; ++bj)
#pragma unroll
            for (int n = 0; n < 2; ++n) { const int c = col0 + bj * HALF + n * 16; cf[bj][n] = *(const f32x4*)(md + 2048 + c) * *(const f32x4*)(gpm + c); }
#pragma unroll
        for (int ai = 0; ai < 2; ++ai)
#pragma unroll
            for (int m = 0; m < 4; ++m) { const int r = ai * HALF + wr * 64 + m * 16 + fr; const float rs = S[r]; const size_t off = (size_t)(u.pm * BM + r) * 1024 + col0;
#pragma unroll
                for (int bj = 0; bj < 2; ++bj)
#pragma unroll
                    for (int n = 0; n < 2; ++n) { const f32x4 bs = (ai == 0 && m < 2) ? pre[m < 2 ? m : 0][bj][n] : *(const f32x4*)(x + off + bj * HALF + n * 16); acc[ai][bj][m][n] = bs + cf[bj][n] * (acc[ai][bj][m][n] * rs); }
                asm volatile("" : "+v"(acc[ai][0][m][0]), "+v"(acc[ai][0][m][1]), "+v"(acc[ai][1][m][0]), "+v"(acc[ai][1][m][1]));
                if (m & 1) asm volatile("" ::: "memory"); }
        st2.run(acc, u, wr, wc, fr, fq, lds, wid, lane);
        f32x4 c2[2][2], sh[2][2];
#pragma unroll
        for (int bj = 0; bj < 2; ++bj)
#pragma unroll
            for (int n = 0; n < 2; ++n) { const int c = col0 + bj * HALF + n * 16; c2[bj][n] = *(const f32x4*)(gpf + c) * (1.0f + *(const f32x4*)(md + 4096 + c)); sh[bj][n] = *(const f32x4*)(md + 3072 + c); }
#pragma unroll
        for (int ai = 0; ai < 2; ++ai)
#pragma unroll
            for (int m = 0; m < 4; ++m) { const int r = ai * HALF + wr * 64 + m * 16 + fr; const float rs = S[r]; const size_t off = (size_t)(u.pm * BM + r) * 1024 + col0;
#pragma unroll
                for (int bj = 0; bj < 2; ++bj)
#pragma unroll
                    for (int n = 0; n < 2; ++n) { const f32x4 x1 = acc[ai][bj][m][n]; { u32x2v w1; w1.x = cvt_pk_bf16(x1[0], x1[1]); w1.y = cvt_pk_bf16(x1[2], x1[3]); *(u32x2v*)(X1 + off + bj * HALF + n * 16) = w1; }
                        const f32x4 o = x1 * rs * c2[bj][n] + sh[bj][n]; u32x2v w; w.x = cvt_pk_bf16(o[0], o[1]); w.y = cvt_pk_bf16(o[2], o[3]);
                        *(u32x2v*)(H + off + bj * HALF + n * 16) = w; }
                asm volatile("" ::: "memory"); }
    }
};
struct EpiFfnNorm {
    static constexpr bool PERM = false, AFTER_DRAIN = true;
    const bf16_t* X1; float* Y; const float* mod; const float* gpo; PanelRms st;
    __device__ __forceinline__ void fused(f32x4 (&acc)[2][2][4][2], const Unit& u, int wr, int wc, int fr, int fq, PG8_LAS unsigned char* lds, int wid, int lane) const {
        typedef unsigned u32x2v __attribute__((ext_vector_type(2)));
        const PG8_LAS float* S = (const PG8_LAS float*)(lds + 8192);
        const float* md = mod + (size_t)(u.pm >> 3) * 6144;
        const int col0 = u.pn * BM + wc * 32 + 4 * fq;
        u32x2v pre[1][4][2][2];
#pragma unroll
        for (int ai = 0; ai < 1; ++ai)
#pragma unroll
            for (int m = 0; m < 4; ++m) { const size_t off = (size_t)(u.pm * BM + ai * HALF + wr * 64 + m * 16 + fr) * 1024 + col0;
#pragma unroll
                for (int bj = 0; bj < 2; ++bj)
#pragma unroll
                    for (int n = 0; n < 2; ++n) pre[ai][m][bj][n] = *(const u32x2v*)(X1 + off + bj * HALF + n * 16); }
        st.run(acc, u, wr, wc, fr, fq, lds, wid, lane);
        f32x4 cf[2][2];
#pragma unroll
        for (int bj = 0; bj < 2; ++bj)
#pragma unroll
            for (int n = 0; n < 2; ++n) { const int c = col0 + bj * HALF + n * 16; cf[bj][n] = *(const f32x4*)(md + 5120 + c) * *(const f32x4*)(gpo + c); }
#pragma unroll
        for (int ai = 0; ai < 2; ++ai)
#pragma unroll
            for (int m = 0; m < 4; ++m) { const int r = ai * HALF + wr * 64 + m * 16 + fr; const float rs = S[r]; const size_t off = (size_t)(u.pm * BM + r) * 1024 + col0;
#pragma unroll
                for (int bj = 0; bj < 2; ++bj)
#pragma unroll
                    for (int n = 0; n < 2; ++n) { const u32x2v p = ai == 0 ? pre[0][m][bj][n] : *(const u32x2v*)(X1 + off + bj * HALF + n * 16);
                        const f32x4 bs = (f32x4){__uint_as_float(p.x << 16), __uint_as_float(p.x & 0xffff0000u), __uint_as_float(p.y << 16), __uint_as_float(p.y & 0xffff0000u)};
                        *(f32x4*)(Y + off + bj * HALF + n * 16) = bs + cf[bj][n] * (acc[ai][bj][m][n] * rs); } }
    }
};
struct SliceOrder {
    int nN, nsl, c;
    __device__ bool next(int i, Unit& u) const { if (i != 0 || c >= 2 * nN * nsl) return false; u.ks = c % nsl; const int r = c / nsl; u.pn = r % nN; u.pm = 64 + r / nN; return true; }
    __device__ __forceinline__ void a_ready(const Unit&) const {}
    __device__ __forceinline__ void done(const Unit&) const {}
};
struct EpiF32Part {
    static constexpr bool PERM = false, AFTER_DRAIN = false;
    float* O; int ldc; size_t pstride;
    __device__ __forceinline__ void operator()(const f32x4 (&acc)[2][2][4][2], const Unit& u, int wr, int wc, int fr, int fq) const {
        const int row0 = (u.pm - 64) * BM + wr * 64 + fr, col0 = u.pn * BM + wc * 32 + 4 * fq;
        float* Ob = O + (size_t)u.ks * pstride;
#pragma unroll
        for (int ai = 0; ai < 2; ++ai)
#pragma unroll
            for (int m = 0; m < 4; ++m) { float* rowp = Ob + (size_t)(row0 + ai * HALF + m * 16) * ldc + col0;
#pragma unroll
                for (int bj = 0; bj < 2; ++bj)
#pragma unroll
                    for (int n = 0; n < 2; ++n) *(f32x4*)(rowp + bj * HALF + n * 16) = acc[ai][bj][m][n]; }
    }
};
struct UpOrder : StaticOrder {
    const unsigned* ready; unsigned need;
    __device__ __forceinline__ void a_ready(const Unit& u) const {
        if (u.pm < 64) return;
        if (threadIdx.x < 64) {
            unsigned spins = 0;
            while ((unsigned)__builtin_amdgcn_readfirstlane(__hip_atomic_load(ready, __ATOMIC_RELAXED, __HIP_MEMORY_SCOPE_AGENT)) < need) { if (++spins > (1u << 22)) break; __builtin_amdgcn_s_sleep(2); }
            __builtin_amdgcn_fence(__ATOMIC_ACQUIRE, "agent");
            asm volatile("s_waitcnt vmcnt(0)" ::: "memory");
        }
        asm volatile("" ::: "memory"); __builtin_amdgcn_s_barrier(); asm volatile("" ::: "memory");
    }
};
template <class Epi, class Sched, bool ALIGN_EPI = false, bool SP2 = false>
__device__ __forceinline__ void gemm_phase(PG8_LAS unsigned char* lds, const Gemm g, const Sched& S, const Epi& E) {
    const int tid = threadIdx.x, wid = __builtin_amdgcn_readfirstlane(tid >> 6), lane = tid & 63, wr = wid >> 2, wc = wid & 3, fr = lane & 15, fq = lane >> 4;
    const int K = g.P ? g.P : g.K, nt = g.K / BK;
    const size_t sstep = (size_t)g.K * 2;
    unsigned voffA[2], voffB[2];
#pragma unroll
    for (int i = 0; i < 2; ++i) { int R, C; stage_rc(tid * 16 + i * 8192, R, C); const int Rb = Epi::PERM ? ((R & ~31) + perm32(R & 31)) : R;
        voffA[i] = (unsigned)(R * K + C) * 2u; voffB[i] = (unsigned)(Rb * K + C) * 2u; }
    const size_t kstep = (size_t)(BK * 2);
    const size_t hstep = (size_t)HALF * K * 2;
    const size_t tstep = 2 * hstep;
    const unsigned ldsw = (unsigned)wid * 1024u;
    const int aoff = lds_byte(wr * 64 + fr, fq * 8), boff = lds_byte(wc * 32 + fr, fq * 8);
#define PG8_SA(b, h) (((b) * 2 + (h)) * HTB)
#define PG8_SB(b, h) ((4 + (b) * 2 + (h)) * HTB)
#define PG8_STAGE(bufoff, gbase, voff) do { _Pragma("unroll") for (int _i = 0; _i < 2; ++_i) \
        __builtin_amdgcn_global_load_lds((const unsigned*)((const char*)(gbase) + (voff)[_i]), (PG8_LAS unsigned*)(lds + (bufoff) + ldsw + _i * 8192), 16, 0, 0); } while (0)
#define PG8_LDA(dst, b, h) do { _Pragma("unroll") for (int m = 0; m < 4; ++m) _Pragma("unroll") for (int k = 0; k < 2; ++k) dst[m][k] = *(const PG8_LAS bf16x8*)(lds + PG8_SA(b, h) + aoff + m * 2048 + k * 1024); } while (0)
#define PG8_LDB(dst, b, h) do { _Pragma("unroll") for (int n = 0; n < 2; ++n) _Pragma("unroll") for (int k = 0; k < 2; ++k) dst[n][k] = *(const PG8_LAS bf16x8*)(lds + PG8_SB(b, h) + boff + n * 2048 + k * 1024); } while (0)
#define PG8_MMA(ai, bj, At, Bt) do { __builtin_amdgcn_s_setprio(1); _Pragma("unroll") for (int m = 0; m < 4; ++m) _Pragma("unroll") for (int n = 0; n < 2; ++n) _Pragma("unroll") for (int k = 0; k < 2; ++k) \
        acc[ai][bj][m][n] = __builtin_amdgcn_mfma_f32_16x16x32_bf16(Bt[n][k], At[m][k], acc[ai][bj][m][n], 0, 0, 0); __builtin_amdgcn_s_setprio(0); } while (0)
#define PG8_WAIT_V(n) asm volatile("s_waitcnt vmcnt(" #n ")" ::: "memory")
#define PG8_WAIT_L(n) asm volatile("s_waitcnt lgkmcnt(" #n ")" ::: "memory")
#define PG8_BAR __builtin_amdgcn_s_barrier()
#define PG8_SCHED __builtin_amdgcn_sched_barrier(0)
    Unit cur, nxt; int ui = 0;
    if (!S.next(0, cur)) return;
    f32x4 acc[2][2][4][2];
#pragma unroll
    for (int a = 0; a < 2; ++a)
#pragma unroll
        for (int b = 0; b < 2; ++b)
#pragma unroll
            for (int m = 0; m < 4; ++m)
#pragma unroll
                for (int n = 0; n < 2; ++n) acc[a][b][m][n] = (f32x4){0.f, 0.f, 0.f, 0.f};
    bf16x8 At[4][2], B0[2][2], B1[2][2];
    const char* cA = (const char*)g.A + (size_t)cur.pm * tstep + cur.ks * sstep; const char* cB = (const char*)g.Bt + (size_t)cur.pn * tstep + cur.ks * sstep;
    S.a_ready(cur);
    if constexpr (SP2) {
        PG8_STAGE(PG8_SB(0, 0), cB, voffB); PG8_STAGE(PG8_SB(0, 1), cB + hstep, voffB); PG8_STAGE(PG8_SA(0, 0), cA, voffA); PG8_STAGE(PG8_SA(0, 1), cA + hstep, voffA);
        if (wr == 1) PG8_BAR;
        PG8_WAIT_V(2); PG8_BAR;
        PG8_STAGE(PG8_SB(1, 0), cB + kstep, voffB); PG8_STAGE(PG8_SA(1, 0), cA + kstep, voffA); PG8_STAGE(PG8_SB(1, 1), cB + hstep + kstep, voffB);
        PG8_WAIT_V(6); PG8_BAR;
    } else {
        PG8_STAGE(PG8_SB(0, 0), cB, voffB); PG8_STAGE(PG8_SA(0, 0), cA, voffA); PG8_STAGE(PG8_SB(0, 1), cB + hstep, voffB); PG8_STAGE(PG8_SA(0, 1), cA + hstep, voffA);
        if (wr == 1) PG8_BAR;
        PG8_WAIT_V(4); PG8_BAR;
        PG8_STAGE(PG8_SB(1, 0), cB + kstep, voffB); PG8_STAGE(PG8_SA(1, 0), cA + kstep, voffA); PG8_STAGE(PG8_SB(1, 1), cB + hstep + kstep, voffB);
        PG8_WAIT_V(6); PG8_BAR;
    }
    for (;;) {
        const bool has_next = S.next(ui + 1, nxt);
        const char* nA = has_next ? (const char*)g.A + (size_t)nxt.pm * tstep + nxt.ks * sstep : cA; const char* nB = has_next ? (const char*)g.Bt + (size_t)nxt.pn * tstep + nxt.ks * sstep : cB;
        for (int t = 0; t < nt; t += 2) {
            const bool last = (t == nt - 2);
            const char* a1 = cA + (size_t)(t + 1) * kstep;
            const char* a2 = last ? nA : cA + (size_t)(t + 2) * kstep; const char* b2 = last ? nB : cB + (size_t)(t + 2) * kstep;
            const char* a3 = a2 + kstep; const char* b3 = b2 + kstep;
            if (last && has_next) S.a_ready(nxt);
            if constexpr (SP2) {
            PG8_LDB(B0, 0, 0); PG8_LDB(B1, 0, 1); PG8_SCHED; PG8_LDA(At, 0, 0); PG8_STAGE(PG8_SA(1, 1), a1 + hstep, voffA);
            PG8_WAIT_V(8); PG8_WAIT_L(0); PG8_BAR; PG8_MMA(0, 0, At, B0); PG8_MMA(0, 1, At, B1); PG8_BAR; PG8_SCHED;
            PG8_LDA(At, 0, 1); PG8_STAGE(PG8_SB(0, 0), b2, voffB); PG8_STAGE(PG8_SB(0, 1), b2 + hstep, voffB); PG8_STAGE(PG8_SA(0, 0), a2, voffA);
            PG8_WAIT_V(8); PG8_WAIT_L(0); PG8_BAR; PG8_MMA(1, 0, At, B0); PG8_MMA(1, 1, At, B1); PG8_BAR; PG8_SCHED;
            PG8_LDB(B0, 1, 0); PG8_LDB(B1, 1, 1); PG8_SCHED; PG8_LDA(At, 1, 0); PG8_STAGE(PG8_SA(0, 1), a2 + hstep, voffA);
            PG8_WAIT_V(8); PG8_WAIT_L(0); PG8_BAR; PG8_MMA(0, 0, At, B0); PG8_MMA(0, 1, At, B1); PG8_BAR; PG8_SCHED;
            PG8_LDA(At, 1, 1); PG8_STAGE(PG8_SB(1, 0), b3, voffB); PG8_STAGE(PG8_SB(1, 1), b3 + hstep, voffB); PG8_STAGE(PG8_SA(1, 0), a3, voffA);
            PG8_WAIT_V(8); PG8_WAIT_L(0); PG8_BAR; PG8_MMA(1, 0, At, B0); PG8_MMA(1, 1, At, B1); PG8_BAR; PG8_SCHED;
            } else {
            PG8_LDB(B0, 0, 0); PG8_SCHED; PG8_LDA(At, 0, 0); PG8_STAGE(PG8_SA(1, 1), a1 + hstep, voffA);
            PG8_WAIT_L(8); PG8_BAR; PG8_WAIT_L(0); PG8_MMA(0, 0, At, B0); PG8_BAR; PG8_SCHED;
            PG8_LDB(B1, 0, 1); PG8_STAGE(PG8_SB(0, 0), b2, voffB);
            PG8_BAR; PG8_WAIT_L(0); PG8_MMA(0, 1, At, B1); PG8_BAR;
            PG8_LDA(At, 0, 1); PG8_STAGE(PG8_SA(0, 0), a2, voffA);
            PG8_BAR; PG8_WAIT_L(0); PG8_MMA(1, 0, At, B0); PG8_BAR; PG8_SCHED;
            PG8_STAGE(PG8_SB(0, 1), b2 + hstep, voffB);
            PG8_WAIT_V(6); PG8_BAR; PG8_MMA(1, 1, At, B1); PG8_BAR;
            PG8_LDB(B0, 1, 0); PG8_SCHED; PG8_LDA(At, 1, 0); PG8_STAGE(PG8_SA(0, 1), a2 + hstep, voffA);
            PG8_WAIT_L(8); PG8_BAR; PG8_WAIT_L(0); PG8_MMA(0, 0, At, B0); PG8_BAR; PG8_SCHED;
            PG8_LDB(B1, 1, 1); PG8_STAGE(PG8_SB(1, 0), b3, voffB);
            PG8_BAR; PG8_WAIT_L(0); PG8_MMA(0, 1, At, B1); PG8_BAR;
            PG8_LDA(At, 1, 1); PG8_STAGE(PG8_SA(1, 0), a3, voffA);
            PG8_BAR; PG8_WAIT_L(0); PG8_MMA(1, 0, At, B0); PG8_BAR; PG8_SCHED;
            PG8_STAGE(PG8_SB(1, 1), b3 + hstep, voffB);
            PG8_WAIT_V(6); PG8_BAR; PG8_MMA(1, 1, At, B1); PG8_BAR;
            }
        }
        if constexpr (ALIGN_EPI) { if (wr == 0) PG8_BAR; }
        if constexpr (!Epi::AFTER_DRAIN) { E(acc, cur, wr, wc, fr, fq); S.done(cur); }
        if (!has_next) break;
#pragma unroll
        for (int a = 0; a < 2; ++a)
#pragma unroll
            for (int b = 0; b < 2; ++b)
#pragma unroll
                for (int m = 0; m < 4; ++m)
#pragma unroll
                    for (int n = 0; n < 2; ++n) acc[a][b][m][n] = (f32x4){0.f, 0.f, 0.f, 0.f};
        cur = nxt; cA = nA; cB = nB; ++ui;
        if constexpr (ALIGN_EPI) { if (wr == 1) PG8_BAR; }
    }
    PG8_WAIT_V(0);
    if constexpr (!ALIGN_EPI) { if (wr == 0) PG8_BAR; }
    PG8_BAR;
    if constexpr (Epi::AFTER_DRAIN) { E.fused(acc, cur, wr, wc, fr, fq, lds, wid, lane); S.done(cur); }
#undef PG8_SA
#undef PG8_SB
#undef PG8_STAGE
#undef PG8_LDA
#undef PG8_LDB
#undef PG8_MMA
#undef PG8_WAIT_V
#undef PG8_WAIT_L
#undef PG8_BAR
#undef PG8_SCHED
}
}
#define LAS __attribute__((address_space(3)))
typedef unsigned short bf16;
typedef unsigned v4u __attribute__((ext_vector_type(4)));
typedef unsigned v2u __attribute__((ext_vector_type(2)));
typedef float f32x4 __attribute__((ext_vector_type(4)));
typedef float f32x2v __attribute__((ext_vector_type(2)));
typedef short bf16x8 __attribute__((ext_vector_type(8)));
#ifndef REPMASK
#define REPMASK 0
#endif
#ifndef MK_COOP
#define MK_COOP 1
#endif
constexpr int NWAVES = 8, NPHASE = 10;
constexpr int PP = 1536;
constexpr int MP = 16384, MS = 512, M = MP + MS, D = 1024, DIN = 2048, DFF = 2816, DUP = 5632, NBATCH = 136, NMOD = 6144;
constexpr float EPS = 1e-6f;
constexpr size_t MiB = 1u << 20;
constexpr size_t WS_CTL = 0, CTL_ZERO_BYTES = 1 * MiB, WS_MOD = 1 * MiB, WS_WIN = 5 * MiB, WS_WOUT = 9 * MiB, WS_WUP = 11 * MiB, WS_WDN = 22 * MiB, WS_EDGE = 28 * MiB,
                 WS_H = 34 * MiB, WS_DY = 67 * MiB, WS_PROJ = 100 * MiB, WS_MIX = 100 * MiB, WS_G = 67 * MiB, WS_F = 160 * MiB, WS_XB = 228 * MiB, WS_PART = 200 * MiB  , WS_X1 = 168 * MiB  , WS_END = 256 * MiB;
constexpr int CNT_BANK_WORDS = 64 * 64;
constexpr size_t O_Y = 0, O_NPP = 17301504, O_NCP = 17362944, O_NFP = 17371136, O_NPS = 17461248, O_NCS = 18444288, O_NFS = 18575360, O_END = 20017152;
constexpr int RING_BYTES = 131072, EB_OFF = 131072, LDS_BYTES = 147456;
#define LDS_WAIT() asm volatile("s_waitcnt lgkmcnt(0)" ::: "memory")

__device__ __forceinline__ unsigned f2bf(float f) { unsigned u = __builtin_bit_cast(unsigned, f); return (u + 0x7fffu + ((u >> 16) & 1u)) >> 16; }
__device__ __forceinline__ unsigned pk2(float lo, float hi) { unsigned r; asm("v_cvt_pk_bf16_f32 %0, %1, %2" : "=v"(r) : "v"(lo), "v"(hi)); return r; }
__device__ __forceinline__ void unpack8(v4u v, float (&f)[8]) {
    f[0] = __builtin_bit_cast(float, v.x << 16); f[1] = __builtin_bit_cast(float, v.x & 0xffff0000u);
    f[2] = __builtin_bit_cast(float, v.y << 16); f[3] = __builtin_bit_cast(float, v.y & 0xffff0000u);
    f[4] = __builtin_bit_cast(float, v.z << 16); f[5] = __builtin_bit_cast(float, v.z & 0xffff0000u);
    f[6] = __builtin_bit_cast(float, v.w << 16); f[7] = __builtin_bit_cast(float, v.w & 0xffff0000u);
}
__device__ __forceinline__ v4u pack8(const float (&f)[8]) { v4u o; o.x = pk2(f[0], f[1]); o.y = pk2(f[2], f[3]); o.z = pk2(f[4], f[5]); o.w = pk2(f[6], f[7]); return o; }
__device__ __forceinline__ float wave_sum(float v) {
#pragma unroll
    for (int o = 1; o < 64; o <<= 1) v += __shfl_xor(v, o);
    return v;
}
__device__ __forceinline__ float silu_f(float a) { return a * __builtin_amdgcn_rcpf(1.0f + __expf(-a)); }

struct Args { const float* in[21]; float* out; unsigned char* ws; int ph_lo, ph_hi; };
enum { I_XP = 0, I_XS, I_SPOOL, I_SCONV, I_SFFN, I_CP, I_CS, I_WADA, I_BADA, I_GPREMIX, I_GPOSTMIX, I_GPREFFN, I_GPOSTFFN, I_WIN, I_POOLW, I_POOLS, I_CONVW, I_WOUT, I_WUP, I_FCONVW, I_WDN };

__device__ __forceinline__ const float* xrow(const Args& a, int m) { return m < MP ? a.in[I_XP] + (size_t)m * D : a.in[I_XS] + (size_t)(m - MP) * D; }
__device__ __forceinline__ int batch_of(int m) { return m < MP ? (m >> 11) : 8 + ((m - MP) >> 2); }

__device__ __forceinline__ void tr_item(const float* W, int ldw, int k0, int n0, bf16* WT, int ldt, int drow0, int dk0, LAS float* scr, int lane) {
    float tv[64];
#pragma unroll
    for (int i = 0; i < 64; ++i) tv[i] = W[(size_t)(k0 + i) * ldw + n0 + lane];
    __builtin_amdgcn_sched_barrier(0);
#pragma unroll
    for (int i = 0; i < 64; ++i) scr[i * 65 + lane] = tv[i];
    LDS_WAIT(); asm volatile("" ::: "memory");
    const int c = lane & 7;
#pragma unroll
    for (int j = 0; j < 8; ++j) { const int n = (lane >> 3) + 8 * j; const LAS float* sp = scr + (8 * c) * 65 + n;
        v4u o; o.x = pk2(sp[0 * 65], sp[1 * 65]); o.y = pk2(sp[2 * 65], sp[3 * 65]); o.z = pk2(sp[4 * 65], sp[5 * 65]); o.w = pk2(sp[6 * 65], sp[7 * 65]);
        *(v4u*)(WT + (size_t)(drow0 + n) * ldt + dk0 + 8 * c) = o; }
    LDS_WAIT(); asm volatile("" ::: "memory");
}

__device__ __forceinline__ void weight_items(const Args& a, LAS unsigned char* lds, int lane, int wave, int it0, int step, int cnt, int lim);
__device__ __forceinline__ void p0_prologue(const Args& a, LAS unsigned char* lds, int tid, int lane, int wave) {
    unsigned char* ws = a.ws;
    bf16* Win_t = (bf16*)(ws + WS_WIN); bf16* Wout_t = (bf16*)(ws + WS_WOUT); bf16* Wup_t = (bf16*)(ws + WS_WUP); bf16* Wdn_t = (bf16*)(ws + WS_WDN);
    float* mod = (float*)(ws + WS_MOD);
    const int G = gridDim.x, gw = blockIdx.x * NWAVES + wave, NGW = G * NWAVES;
    for (int i = blockIdx.x * 512 + tid; i < 16384; i += G * 512) ((unsigned*)(ws + WS_CTL))[i] = 0u;
    {
        LAS float* red = (LAS float*)lds;
        const int fr = lane & 15, fq = lane >> 4;
        for (int wi = blockIdx.x; wi < NMOD / 32; wi += G) {
            const int n0 = wi * 32, kb = wave * 128 + fq * 8;
            f32x4 acc[9][2];
#pragma unroll
            for (int rb = 0; rb < 9; ++rb) { acc[rb][0] = (f32x4){0.f, 0.f, 0.f, 0.f}; acc[rb][1] = acc[rb][0]; }
            LAS unsigned char* sa = lds + 32768 + wave * 12288;
            const int arow = lane >> 3, akk = (lane & 7) * 4;
            f32x2v wn[8];
#pragma unroll
            for (int i = 0; i < 8; ++i) wn[i] = *(const f32x2v*)(a.in[I_WADA] + (size_t)(kb + i) * NMOD + n0 + 2 * fr);
#pragma unroll 1
            for (int ks = 0; ks < 4; ++ks) {
                float wv[2][8];
#pragma unroll
                for (int i = 0; i < 8; ++i) { wv[0][i] = wn[i].x; wv[1][i] = wn[i].y; }
                { const int k1 = kb + (ks < 3 ? ks + 1 : 3) * 32;
#pragma unroll
                  for (int i = 0; i < 8; ++i) wn[i] = *(const f32x2v*)(a.in[I_WADA] + (size_t)(k1 + i) * NMOD + n0 + 2 * fr); }
                f32x4 cl[18];
#pragma unroll
                for (int j = 0; j < 18; ++j) { int row = 8 * j + arow; row = row < NBATCH ? row : NBATCH - 1;
                    cl[j] = *(const f32x4*)((row < 8 ? a.in[I_CP] + (size_t)row * D : a.in[I_CS] + (size_t)(row - 8) * D) + wave * 128 + ks * 32 + akk); }
                __builtin_amdgcn_sched_barrier(0);
#pragma unroll
                for (int j = 0; j < 18; ++j) { v2u w; w.x = pk2(silu_f(cl[j].x), silu_f(cl[j].y)); w.y = pk2(silu_f(cl[j].z), silu_f(cl[j].w));
                    *(LAS v2u*)(sa + (8 * j + arow) * 80 + akk * 2) = w; }
                const bf16x8 b0 = __builtin_bit_cast(bf16x8, pack8(wv[0])), b1 = __builtin_bit_cast(bf16x8, pack8(wv[1]));
                LDS_WAIT(); asm volatile("" ::: "memory");
#pragma unroll
                for (int rb = 0; rb < 9; ++rb) {
                    const bf16x8 af = *(const LAS bf16x8*)(sa + (rb * 16 + fr) * 80 + fq * 16);
                    acc[rb][0] = __builtin_amdgcn_mfma_f32_16x16x32_bf16(b0, af, acc[rb][0], 0, 0, 0);
                    acc[rb][1] = __builtin_amdgcn_mfma_f32_16x16x32_bf16(b1, af, acc[rb][1], 0, 0, 0);
                }
                LDS_WAIT(); asm volatile("" ::: "memory");
            }
            __syncthreads();
#pragma unroll
            for (int st = 4; st >= 1; st >>= 1) {
                LAS float* slot = (LAS float*)(lds + 32768) + (wave & (st - 1)) * (18 * 256);
                if (wave >= st && wave < 2 * st) {
#pragma unroll
                    for (int rb = 0; rb < 9; ++rb)
#pragma unroll
                        for (int cb = 0; cb < 2; ++cb)
#pragma unroll
                            for (int e = 0; e < 4; ++e) slot[((rb * 2 + cb) * 4 + e) * 64 + lane] = acc[rb][cb][e];
                }
                __syncthreads();
                if (wave < st) {
#pragma unroll
                    for (int rb = 0; rb < 9; ++rb)
#pragma unroll
                        for (int cb = 0; cb < 2; ++cb)
#pragma unroll
                            for (int e = 0; e < 4; ++e) acc[rb][cb][e] += slot[((rb * 2 + cb) * 4 + e) * 64 + lane];
                }
                __syncthreads();
            }
            if (wave == 0) {
#pragma unroll
                for (int rb = 0; rb < 9; ++rb) { const int row = rb * 16 + fr, col = n0 + 8 * fq;
                    const f32x4 lo = (f32x4){acc[rb][0][0], acc[rb][1][0], acc[rb][0][1], acc[rb][1][1]} + *(const f32x4*)(a.in[I_BADA] + col);
                    const f32x4 hi = (f32x4){acc[rb][0][2], acc[rb][1][2], acc[rb][0][3], acc[rb][1][3]} + *(const f32x4*)(a.in[I_BADA] + col + 4);
                    if (row < NBATCH) { *(f32x4*)(mod + (size_t)row * NMOD + col) = lo; *(f32x4*)(mod + (size_t)row * NMOD + col + 4) = hi; } }
            }
            __syncthreads();
        }
    }
    if (G == 256) { if (blockIdx.x >= 192) weight_items(a, lds, lane, wave, ((int)blockIdx.x - 192) * 8 + wave, 512, 6, 2688); }
    else weight_items(a, lds, lane, wave, gw, NGW, (4800 + NGW - 1) / NGW, 4800);
}

__device__ __forceinline__ void weight_items(const Args& a, LAS unsigned char* lds, int lane, int wave, int it0, int step, int cnt, int lim) {
    unsigned char* ws = a.ws;
    bf16* Win_t = (bf16*)(ws + WS_WIN); bf16* Wout_t = (bf16*)(ws + WS_WOUT); bf16* Wup_t = (bf16*)(ws + WS_WUP); bf16* Wdn_t = (bf16*)(ws + WS_WDN);
    LAS float* scr = (LAS float*)(lds + wave * 17408);
    constexpr int I_FOLD = 2048, I_IN = 16 * 32, I_OUT = 8 * 16, I_UP = 16 * 88;
        for (int ii = 0; ii < cnt; ++ii) {
            int r = it0 + ii * step; if (r >= lim) break;
            if (r < I_FOLD) {
                const int k0 = (r >> 6) * 16, n0 = (r & 63) * 16, gb = (k0 >> 7) * 128, rr = lane & 15, q = lane >> 4;
                f32x4 pw[8], ps[8]; float wo[32];
                const f32x4* pwp = (const f32x4*)(a.in[I_POOLW] + (size_t)(k0 + rr) * 128 + q * 32); const f32x4* psp = (const f32x4*)(a.in[I_POOLS] + gb + q * 32);
#pragma unroll
                for (int i = 0; i < 8; ++i) { pw[i] = pwp[i]; ps[i] = psp[i]; }
#pragma unroll
                for (int sidx = 0; sidx < 32; ++sidx) wo[sidx] = a.in[I_WOUT][(size_t)(gb + q * 32 + sidx) * D + n0 + rr];
                __builtin_amdgcn_sched_barrier(0);
                f32x4 acc = (f32x4){0.f, 0.f, 0.f, 0.f};
#pragma unroll
                for (int sidx = 0; sidx < 32; ++sidx) acc = __builtin_amdgcn_mfma_f32_16x16x4f32(pw[sidx >> 2][sidx & 3], ps[sidx >> 2][sidx & 3] * wo[sidx], acc, 0, 0, 0);
                v2u o; o.x = pk2(acc[0], acc[1]); o.y = pk2(acc[2], acc[3]);
                *(v2u*)(Wout_t + (size_t)(n0 + rr) * D + k0 + 4 * q) = o;
                continue;
            } r -= I_FOLD;
            if (r < I_IN) { const int kb = r / 32, nb = r % 32, n0 = 64 * nb;
                const int jx = (n0 - 512) & 511, drow0 = n0 < 512 ? n0 : (n0 < 1024 ? 1024 + (jx >> 7) * 256 + (jx & 127) : (n0 < 1536 ? n0 - 512 : 1024 + (((n0 - 1536) >> 7) * 256) + 128 + ((n0 - 1536) & 127)));
                tr_item(a.in[I_WIN], DIN, 64 * kb, n0, Win_t, D, drow0, 64 * kb, scr, lane); continue; } r -= I_IN;
            if (r < I_OUT) { const int kb = r / 16, nb = r % 16; tr_item(a.in[I_WOUT] + (size_t)512 * D, D, 64 * kb, 64 * nb, Wout_t, D, 64 * nb, 512 + 64 * kb, scr, lane); continue; } r -= I_OUT;
            if (r < I_UP) { const int kb = r / 88, nb = r % 88, n0 = 64 * nb;
                const int drow0 = n0 < DFF ? (n0 / 128) * 256 + (n0 % 128) : ((n0 - DFF) / 128) * 256 + 128 + ((n0 - DFF) % 128);
                tr_item(a.in[I_WUP], DUP, 64 * kb, n0, Wup_t, D, drow0, 64 * kb, scr, lane); continue; } r -= I_UP;
            { const int kb = r / 16, nb = r % 16; tr_item(a.in[I_WDN], D, 64 * kb, 64 * nb, Wdn_t, DFF, 64 * nb, 64 * kb, scr, lane); }
        }
}

__device__ __forceinline__ void p1_norm(const Args& a, int lane, int wave) {
    bf16* H = (bf16*)(a.ws + WS_H); const float* mod = (const float*)(a.ws + WS_MOD);
    const int gw = blockIdx.x * NWAVES + wave, NGW = gridDim.x * NWAVES;
    for (int mb = gw; mb < M; mb += 4 * NGW) {
        f32x4 v[4][4];
#pragma unroll
        for (int r = 0; r < 4; ++r) { const int m = mb + r * NGW; const float* xr = xrow(a, m < M ? m : mb);
#pragma unroll
            for (int j = 0; j < 4; ++j) v[r][j] = *(const f32x4*)(xr + 4 * lane + 256 * j); }
        __builtin_amdgcn_sched_barrier(0);
#pragma unroll
        for (int r = 0; r < 4; ++r) {
            const int m = mb + r * NGW; if (m >= M) break;
            const float* md = mod + (size_t)batch_of(m) * NMOD;
            float ss = 0.f;
#pragma unroll
            for (int j = 0; j < 4; ++j) ss += (v[r][j].x * v[r][j].x + v[r][j].y * v[r][j].y) + (v[r][j].z * v[r][j].z + v[r][j].w * v[r][j].w);
            const float rstd = 1.0f / sqrtf(wave_sum(ss) * (1.0f / D) + EPS);
#pragma unroll
            for (int j = 0; j < 4; ++j) { const int col = 4 * lane + 256 * j;
                const f32x4 g = *(const f32x4*)(a.in[I_GPREMIX] + col), sc = *(const f32x4*)(md + 1024 + col), sh = *(const f32x4*)(md + col);
                const f32x4 o = v[r][j] * rstd * g * (1.0f + sc) + sh;
                v2u w; w.x = pk2(o.x, o.y); w.y = pk2(o.z, o.w); *(v2u*)(H + (size_t)m * D + col) = w; }
        }
    }
}

__device__ __forceinline__ void ldpart8(const float* part, size_t sstride, int nsl, size_t off, float (&v)[8]) {
    f32x4 a = (f32x4){0.f, 0.f, 0.f, 0.f}, b = a;
    for (int sl = 0; sl < nsl; ++sl) { a += *(const f32x4*)(part + sl * sstride + off); b += *(const f32x4*)(part + sl * sstride + off + 4); }
    v[0] = a.x; v[1] = a.y; v[2] = a.z; v[3] = a.w; v[4] = b.x; v[5] = b.y; v[6] = b.z; v[7] = b.w;
}
__device__ __forceinline__ void st8(float* o, const float (&v)[8]) { *(f32x4*)o = (f32x4){v[0], v[1], v[2], v[3]}; *(f32x4*)(o + 4) = (f32x4){v[4], v[5], v[6], v[7]}; }
__device__ __forceinline__ void ld8(const float* p, float (&v)[8]) { const f32x4 a = *(const f32x4*)p, b = *(const f32x4*)(p + 4); v[0] = a.x; v[1] = a.y; v[2] = a.z; v[3] = a.w; v[4] = b.x; v[5] = b.y; v[6] = b.z; v[7] = b.w; }
template <int W>
__device__ __forceinline__ void pool_pair(const bf16* PROJ, bf16* DY, float* npp, const int (&rows)[2], int j0, bool hasB) {
    v4u cv[2], hv[2][W - 1];
#pragma unroll
    for (int r = 0; r < 2; ++r) { const int t = rows[r] & 2047; const bf16* pr = PROJ + (size_t)rows[r] * PP + j0; cv[r] = *(const v4u*)pr;
#pragma unroll
        for (int i = 1; i < W; ++i) hv[r][i - 1] = *(const v4u*)(pr - (size_t)(i <= t ? i : 0) * PP); }
    __builtin_amdgcn_sched_barrier(0);
#pragma unroll
    for (int r = 0; r < 2; ++r) { if (r == 1 && !hasB) break;
        const int m = rows[r], b = m >> 11, t = m & 2047; float cur[8], s[8];
        unpack8(cv[r], cur);
#pragma unroll
        for (int e = 0; e < 8; ++e) s[e] = cur[e];
#pragma unroll
        for (int i = 1; i < W; ++i) { float tmp[8]; unpack8(hv[r][i - 1], tmp);
#pragma unroll
            for (int e = 0; e < 8; ++e) s[e] += (i <= t) ? tmp[e] : 0.f; }
        const float inv = 1.0f / (float)((t + 1) < W ? (t + 1) : W); float d[8];
        if (t >= 2033) st8(npp + (size_t)(b * 15 + (t - 2033)) * 512 + j0, cur);
#pragma unroll
        for (int e = 0; e < 8; ++e) d[e] = s[e] * inv - cur[e];
        *(v4u*)(DY + (size_t)m * D + j0) = pack8(d); }
}
template <int W>
__device__ __forceinline__ void pool_adj(const bf16* PROJ, bf16* DY, float* npp, int r0, int j0) {
    const int r3 = r0 + 3, t3 = r3 & 2047, b = r3 >> 11;
    const bf16* p3 = PROJ + (size_t)r3 * PP + j0;
    v4u hv[W + 3];
#pragma unroll
    for (int k = 0; k < W + 3; ++k) hv[k] = *(const v4u*)(p3 - (size_t)(k <= t3 ? k : 0) * PP);
    __builtin_amdgcn_sched_barrier(0);
    float v[W + 3][8];
#pragma unroll
    for (int k = 0; k < W + 3; ++k) { float tmp[8]; unpack8(hv[k], tmp);
#pragma unroll
        for (int e = 0; e < 8; ++e) v[k][e] = (k <= t3) ? tmp[e] : 0.f; }
    float sw[8];
#pragma unroll
    for (int e = 0; e < 8; ++e) { float acc = v[0][e];
#pragma unroll
        for (int k = 1; k < W; ++k) acc += v[k][e];
        sw[e] = acc; }
#pragma unroll
    for (int j = 3; j >= 0; --j) {
        const int tj = t3 - (3 - j); const float inv = 1.0f / (float)((tj + 1) < W ? (tj + 1) : W); float d[8];
#pragma unroll
        for (int e = 0; e < 8; ++e) d[e] = sw[e] * inv - v[3 - j][e];
        if (tj >= 2033) st8(npp + (size_t)(b * 15 + (tj - 2033)) * 512 + j0, v[3 - j]);
        *(v4u*)(DY + (size_t)(r0 + j) * D + j0) = pack8(d);
        if (j > 0) {
#pragma unroll
            for (int e = 0; e < 8; ++e) sw[e] += v[3 - j + W][e] - v[3 - j][e]; }
    }
}
__device__ __forceinline__ void p3_mixer(const Args& a, int tid) {
    const bf16* PROJ = (const bf16*)(a.ws + WS_PROJ); bf16* DY = (bf16*)(a.ws + WS_DY);
    const float* PART = (const float*)(a.ws + WS_PART); constexpr size_t PS = (size_t)MS * DIN;
    float* npp = a.out + O_NPP; float* ncp = a.out + O_NCP; float* nps = a.out + O_NPS; float* ncs = a.out + O_NCS;
    const long NT = (long)gridDim.x * 512;
    const int lane_ = tid & 63, gwv = blockIdx.x * NWAVES + (tid >> 6), NGWV = gridDim.x * NWAVES;
    for (int pw = gwv; pw < MP / 4; pw += NGWV) {
        const int g = pw & 3, r0 = (pw >> 2) * 16 + 4 * (lane_ >> 4), j0 = g * 128 + (lane_ & 15) * 8;
        if (g == 0) pool_adj<2>(PROJ, DY, npp, r0, j0);
        else if (g == 1) pool_adj<4>(PROJ, DY, npp, r0, j0);
        else if (g == 2) pool_adj<8>(PROJ, DY, npp, r0, j0);
        else pool_adj<16>(PROJ, DY, npp, r0, j0);
    }
    for (int cwi = gwv; cwi < MP / 2; cwi += NGWV) {
        const int m0 = 2 * cwi, m1 = m0 + 1, t1 = m1 & 2047, b = m1 >> 11, j0 = 8 * lane_;
        const bf16* p1 = PROJ + (size_t)m1 * PP + j0;
        const v4u rb1 = *(const v4u*)(p1 + 512), rb0 = *(const v4u*)(p1 - PP + 512);
        v4u rcx[4];
#pragma unroll
        for (int k = 0; k < 4; ++k) rcx[k] = *(const v4u*)(p1 - (size_t)(k <= t1 ? k : 0) * PP + 1024);
        const float* cwp = a.in[I_CONVW] + j0; float w0[8], w1[8], w2[8];
        ld8(cwp, w0); ld8(cwp + 512, w1); ld8(cwp + 1024, w2);
        __builtin_amdgcn_sched_barrier(0);
        float c[4][8], b0[8], b1[8], y0[8], y1[8];
        unpack8(rb0, b0); unpack8(rb1, b1);
#pragma unroll
        for (int k = 0; k < 4; ++k) { float tmp[8]; unpack8(rcx[k], tmp);
#pragma unroll
            for (int e = 0; e < 8; ++e) c[k][e] = (k <= t1) ? tmp[e] : 0.f; }
#pragma unroll
        for (int e = 0; e < 8; ++e) { y1[e] = b1[e] * (w0[e] * c[2][e] + w1[e] * c[1][e] + w2[e] * c[0][e]); y0[e] = b0[e] * (w0[e] * c[3][e] + w1[e] * c[2][e] + w2[e] * c[1][e]); }
        *(v4u*)(DY + (size_t)m0 * D + 512 + j0) = pack8(y0);
        *(v4u*)(DY + (size_t)m1 * D + 512 + j0) = pack8(y1);
        if (t1 == 2047) { st8(ncp + (size_t)(b * 2 + 0) * 512 + j0, c[1]); st8(ncp + (size_t)(b * 2 + 1) * 512 + j0, c[0]); }
    }
    for (long it = (long)MP * 128 + (long)blockIdx.x * 512 + tid; it < (long)M * 128; it += NT) {
        const int m = (int)(it >> 7), q = (int)(it & 127);
        {
            const int sr = m - MP, b = sr >> 2, t = sr & 3;
            if (q < 64) {
                const int j0 = 8 * q, w = 2 << (j0 >> 7);
                float cur[8], s[8];
                ldpart8(PART, PS, 4, (size_t)sr * DIN + j0, cur);
#pragma unroll
                for (int e = 0; e < 8; ++e) s[e] = cur[e];
                for (int i = 1; i < w; ++i) { float tmp[8];
                    if (t - i >= 0) ldpart8(PART, PS, 4, (size_t)(sr - i) * DIN + j0, tmp); else ld8(a.in[I_SPOOL] + (size_t)(b * 15 + 15 + t - i) * 512 + j0, tmp);
#pragma unroll
                    for (int e = 0; e < 8; ++e) s[e] += tmp[e]; }
                st8(nps + (size_t)(b * 15 + 11 + t) * 512 + j0, cur);
                for (int i = t; i < 11; i += 4) { float tmp[8]; ld8(a.in[I_SPOOL] + (size_t)(b * 15 + i + 4) * 512 + j0, tmp); st8(nps + (size_t)(b * 15 + i) * 512 + j0, tmp); }
                const float inv = 1.0f / (float)w; float d[8];
#pragma unroll
                for (int e = 0; e < 8; ++e) d[e] = s[e] * inv - cur[e];
                *(v4u*)(DY + (size_t)m * D + j0) = pack8(d);
            } else {
                const int j0 = 8 * (q - 64);
                float xv[8], bv[8], cv[8], cx[3][8];
                const int xcol = 1024 + (j0 >> 7) * 256 + (j0 & 127);
                ldpart8(PART, PS, 4, (size_t)sr * DIN + 512 + j0, bv);
#pragma unroll
                for (int k = 0; k < 3; ++k) {
                    if (t - k >= 0) { ldpart8(PART, PS, 4, (size_t)(sr - k) * DIN + xcol, xv); ldpart8(PART, PS, 4, (size_t)(sr - k) * DIN + xcol + 128, cv);
#pragma unroll
                        for (int e = 0; e < 8; ++e) cx[k][e] = cv[e] * xv[e]; }
                    else ld8(a.in[I_SCONV] + (size_t)(b * 2 + 2 + t - k) * 512 + j0, cx[k]);
                }
                const float* cwp = a.in[I_CONVW] + j0; float w0[8], w1[8], w2[8], y[8];
                ld8(cwp, w0); ld8(cwp + 512, w1); ld8(cwp + 1024, w2);
#pragma unroll
                for (int e = 0; e < 8; ++e) y[e] = bv[e] * (w0[e] * cx[2][e] + w1[e] * cx[1][e] + w2[e] * cx[0][e]);
                *(v4u*)(DY + (size_t)m * D + 512 + j0) = pack8(y);
                if (t >= 2) st8(ncs + (size_t)(b * 2 + t - 2) * 512 + j0, cx[0]);
            }
        }
    }
}

__device__ __forceinline__ void p5_rowwise1(const Args& a, int lane, int wave, unsigned* done_cnt) {
    const float* MIX = (const float*)(a.ws + WS_MIX); bf16* H = (bf16*)(a.ws + WS_H); const float* mod = (const float*)(a.ws + WS_MOD); float* Y = a.out + O_Y;
    const int gw = blockIdx.x * NWAVES + wave, NGW = gridDim.x * NWAVES;
    int m0 = MP + gw, mstep = NGW;
    if (gridDim.x == 256) { m0 = blockIdx.x >= 192 ? MP + ((int)blockIdx.x - 192) * NWAVES + wave : M; mstep = M; }
    for (int m = m0; m < M; m += mstep) {
        const float* xr = xrow(a, m); const float* md = mod + (size_t)batch_of(m) * NMOD; const float* mr = (const float*)(a.ws + WS_PART) + (size_t)(m - MP) * D;
        f32x4 v[4]; float ss = 0.f;
#pragma unroll
        for (int j = 0; j < 4; ++j) { v[j] = (*(const f32x4*)(mr + 4 * lane + 256 * j) + *(const f32x4*)(mr + (size_t)MS * D + 4 * lane + 256 * j)) + (*(const f32x4*)(mr + 2 * (size_t)MS * D + 4 * lane + 256 * j) + *(const f32x4*)(mr + 3 * (size_t)MS * D + 4 * lane + 256 * j)); ss += (v[j].x * v[j].x + v[j].y * v[j].y) + (v[j].z * v[j].z + v[j].w * v[j].w); }
        const float r1 = 1.0f / sqrtf(wave_sum(ss) * (1.0f / D) + EPS);
        float s2 = 0.f;
#pragma unroll
        for (int j = 0; j < 4; ++j) { const int col = 4 * lane + 256 * j;
            const f32x4 x = *(const f32x4*)(xr + col), g = *(const f32x4*)(a.in[I_GPOSTMIX] + col), gt = *(const f32x4*)(md + 2048 + col);
            v[j] = x + gt * (v[j] * r1 * g);
            *(f32x4*)(Y + (size_t)m * D + col) = v[j];
            s2 += (v[j].x * v[j].x + v[j].y * v[j].y) + (v[j].z * v[j].z + v[j].w * v[j].w); }
        const float r2 = 1.0f / sqrtf(wave_sum(s2) * (1.0f / D) + EPS);
#pragma unroll
        for (int j = 0; j < 4; ++j) { const int col = 4 * lane + 256 * j;
            const f32x4 g = *(const f32x4*)(a.in[I_GPREFFN] + col), sc = *(const f32x4*)(md + 4096 + col), sh = *(const f32x4*)(md + 3072 + col);
            const f32x4 o = v[j] * r2 * g * (1.0f + sc) + sh;
            v2u w; w.x = pk2(o.x, o.y); w.y = pk2(o.z, o.w); *(v2u*)(H + (size_t)m * D + col) = w; }
        __threadfence();
        if (lane == 0) __hip_atomic_fetch_add(done_cnt, 1u, __ATOMIC_RELAXED, __HIP_MEMORY_SCOPE_AGENT);
    }
}

__device__ __forceinline__ void fixup_tile(const Args& a, int pm, int tid) {
    if ((pm & 7) == 0 || pm >= 64) return;
    const float* edge = (const float*)(a.ws + WS_EDGE); bf16* Gb = (bf16*)(a.ws + WS_G); const float* cw = a.in[I_FCONVW];
    for (int idx = tid; idx < DFF; idx += 512) {
        const int pn = idx >> 7, rho = idx & 127;
        const float* et = edge + (size_t)(pm * 22 + pn) * 1024; const float* eb = edge + (size_t)((pm - 1) * 22 + pn) * 1024 + 512;
        float u0[2], u1[2];
#pragma unroll
        for (int h = 0; h < 2; ++h) { const int tc = rho + 128 * h, c = h * DFF + idx;
            const float pb0 = eb[tc], pb1 = eb[256 + tc], t0 = et[tc], t1 = et[256 + tc];
            const float w0 = cw[c], w1 = cw[DUP + c], w2 = cw[2 * DUP + c];
            u0[h] = w0 * pb0 + w1 * pb1 + w2 * t0; u1[h] = w0 * pb1 + w1 * t0 + w2 * t1; }
        Gb[(size_t)(pm * 256) * DFF + idx] = (bf16)f2bf(silu_f(u0[0]) * u0[1]);
        Gb[(size_t)(pm * 256 + 1) * DFF + idx] = (bf16)f2bf(silu_f(u1[0]) * u1[1]);
    }
}

__device__ __forceinline__ void p9_rows(const Args& a, int lane, int m0, int m1, int mstep) {
    const float* Fb = (const float*)(a.ws + WS_F); const float* mod = (const float*)(a.ws + WS_MOD); float* Y = a.out + O_Y;
    for (int m = m0; m < m1; m += mstep) {
        const float* md = mod + (size_t)batch_of(m) * NMOD; const float* fr = (const float*)(a.ws + WS_PART) + (size_t)(m - MP) * D;
        f32x4 v[4]; float ss = 0.f;
#pragma unroll
        for (int j = 0; j < 4; ++j) { v[j] = *(const f32x4*)(fr + 4 * lane + 256 * j);
#pragma unroll
            for (int sl = 1; sl < 11; ++sl) v[j] += *(const f32x4*)(fr + sl * (size_t)MS * D + 4 * lane + 256 * j); ss += (v[j].x * v[j].x + v[j].y * v[j].y) + (v[j].z * v[j].z + v[j].w * v[j].w); }
        const float r1 = 1.0f / sqrtf(wave_sum(ss) * (1.0f / D) + EPS);
#pragma unroll
        for (int j = 0; j < 4; ++j) { const int col = 4 * lane + 256 * j;
            const f32x4 x = *(const f32x4*)(Y + (size_t)m * D + col), g = *(const f32x4*)(a.in[I_GPOSTFFN] + col), gt = *(const f32x4*)(md + 5120 + col);
            *(f32x4*)(Y + (size_t)m * D + col) = x + gt * (v[j] * r1 * g); }
    }
}

template <int NI, int NJ, int U>
__device__ __forceinline__ void sgemm_block(f32x4 (&acc)[NI][NJ], const bf16* ap, const bf16* bp, int K) {
    bf16x8 af[U][NI], bfr[U][NJ];
#pragma unroll
    for (int u = 0; u < U; ++u) {
#pragma unroll
        for (int i = 0; i < NI; ++i) af[u][i] = *(const bf16x8*)(ap + (size_t)i * 16 * K + u * 32);
#pragma unroll
        for (int j = 0; j < NJ; ++j) bfr[u][j] = *(const bf16x8*)(bp + (size_t)j * 16 * K + u * 32);
    }
    __builtin_amdgcn_sched_barrier(0);
#pragma unroll
    for (int u = 0; u < U; ++u)
#pragma unroll
        for (int i = 0; i < NI; ++i)
#pragma unroll
            for (int j = 0; j < NJ; ++j) acc[i][j] = __builtin_amdgcn_mfma_f32_16x16x32_bf16(bfr[u][j], af[u][i], acc[i][j], 0, 0, 0);
    __builtin_amdgcn_sched_barrier(0);
}
template <int NI, int NJ, int U, int NKS, class Epi>
__device__ __forceinline__ void sgemm_tile(const bf16* A, const bf16* Bt, int K, LAS unsigned char* lds, int tid, int lane, int wave, const Epi& epi) {
    LAS float* red = (LAS float*)lds;
    for (int i = tid; i < NI * NJ * 256; i += 512) red[i] = 0.f;
    __syncthreads();
    const int fr = lane & 15, fq = lane >> 4, kw = K / 8;
    const bf16* ap = A + (size_t)fr * K + wave * kw + fq * 8; const bf16* bp = Bt + (size_t)fr * K + wave * kw + fq * 8;
    f32x4 acc[NI][NJ];
#pragma unroll
    for (int i = 0; i < NI; ++i)
#pragma unroll
        for (int j = 0; j < NJ; ++j) acc[i][j] = (f32x4){0.f, 0.f, 0.f, 0.f};
#pragma unroll 1
    for (int ks = 0; ks + U <= NKS; ks += U) sgemm_block<NI, NJ, U>(acc, ap + ks * 32, bp + ks * 32, K);
    if constexpr (NKS % U != 0) sgemm_block<NI, NJ, NKS % U>(acc, ap + (NKS - NKS % U) * 32, bp + (NKS - NKS % U) * 32, K);
#pragma unroll
    for (int i = 0; i < NI; ++i)
#pragma unroll
        for (int j = 0; j < NJ; ++j)
#pragma unroll
            for (int e = 0; e < 4; ++e) __hip_atomic_fetch_add(red + ((i * NJ + j) * 4 + e) * 64 + lane, acc[i][j][e], __ATOMIC_RELAXED, __HIP_MEMORY_SCOPE_WORKGROUP);
    __syncthreads();
    for (int blk = wave; blk < NI * NJ; blk += 8) { const int i = blk / NJ, j = blk % NJ; const LAS float* rp = red + blk * 256 + lane; epi(i * 16 + fr, j * 16 + 4 * fq, (f32x4){rp[0], rp[64], rp[128], rp[192]}); }
    __syncthreads();
}

#define XB_TMO      128
#define XB_XCNT(j)  (256  + 64 * (j))
#define XB_XSUB(j)  (1280 + 64 * (j))
#define XB_XGEN(j)  (2304 + 64 * (j))
#define XB_TOP      3328
#define XB_TOPGEN   3392
#define XCD_BAR_WORDS 3456
#define XB_SPIN_CAP (1u << 18)

__device__ __forceinline__ unsigned xb_ld(unsigned* p)              { return __hip_atomic_load(p, __ATOMIC_RELAXED, __HIP_MEMORY_SCOPE_AGENT); }
__device__ __forceinline__ unsigned xb_add(unsigned* p, unsigned v) { return __hip_atomic_fetch_add(p, v, __ATOMIC_RELAXED, __HIP_MEMORY_SCOPE_AGENT); }
__device__ __forceinline__ unsigned xb_xcc_id() { return (unsigned)__builtin_amdgcn_s_getreg((3 << 11) | 20) & 0xFu; }
#define XB_SPIN(cond, bar) do { unsigned _sp = 0; while (cond) { __builtin_amdgcn_s_sleep(1); \
    if ((++_sp & 255u) == 0u) { if (xb_ld(&(bar)[XB_TMO])) break; if (_sp > XB_SPIN_CAP) { atomicAdd(&(bar)[XB_TMO], 1u); break; } } } } while (0)

struct XcdBarrier {
    unsigned* bar; unsigned x;
    volatile LAS unsigned* st;
};

__device__ __forceinline__ XcdBarrier xcd_barrier_post(unsigned* bar, volatile LAS unsigned* st) {
    XcdBarrier b; b.bar = bar; b.x = xb_xcc_id(); b.st = st;
    if (threadIdx.x == 0) (void)xb_add(&bar[XB_XCNT(b.x)], 1u);
    return b;
}
__device__ __forceinline__ void xcd_barrier_complete(unsigned* bar, unsigned x, unsigned& nloc, unsigned& nx) {
    const unsigned G = gridDim.x * gridDim.y * gridDim.z;
    unsigned sum, cnt, mine, sp = 0u;
    for (;;) {
        sum = 0u; cnt = 0u; mine = 0u;
#pragma unroll
        for (unsigned j = 0; j < 16; ++j) { const unsigned c = xb_ld(&bar[XB_XCNT(j)]); sum += c; cnt += (c > 0u) ? 1u : 0u; mine = (j == x) ? c : mine; }
        if (sum == G) break;
        __builtin_amdgcn_s_sleep(1);
        if ((++sp & 255u) == 0u) { if (xb_ld(&bar[XB_TMO])) break; if (sp > XB_SPIN_CAP) { atomicAdd(&bar[XB_TMO], 1u); break; } }
    }
    nloc = mine > 0u ? mine : 1u; nx = cnt > 0u ? cnt : 1u;
}

__device__ __forceinline__ void xcd_barrier(const XcdBarrier& b) {
    asm volatile("s_waitcnt vmcnt(0)" ::: "memory");
    __syncthreads();
    if (threadIdx.x == 0) {
        unsigned* bar = b.bar;
        __builtin_amdgcn_s_waitcnt(0);
        unsigned nloc = b.st[0], nx = b.st[1];
        if (nloc == 0u) { xcd_barrier_complete(bar, b.x, nloc, nx); b.st[0] = nloc; b.st[1] = nx; }
        const unsigned old = xb_add(&bar[XB_XSUB(b.x)], 1u);
        const unsigned gen = old / nloc;
        if (old + 1u == (gen + 1u) * nloc) {
            __builtin_amdgcn_fence(__ATOMIC_RELEASE, "agent");
            asm volatile("s_waitcnt vmcnt(0)" ::: "memory");
            const unsigned og = xb_add(&bar[XB_TOP], 1u);
            const unsigned tg = og / nx;
            if (og + 1u == (tg + 1u) * nx) xb_add(&bar[XB_TOPGEN], 1u);
            else XB_SPIN(xb_ld(&bar[XB_TOPGEN]) == tg, bar);
            __builtin_amdgcn_fence(__ATOMIC_ACQUIRE, "agent");
            xb_add(&bar[XB_XGEN(b.x)], 1u);
            asm volatile("s_waitcnt vmcnt(0)" ::: "memory");
        } else {
            XB_SPIN(xb_ld(&bar[XB_XGEN(b.x)]) == gen, bar);
            __builtin_amdgcn_fence(__ATOMIC_ACQUIRE, "agent");
            asm volatile("s_waitcnt vmcnt(0)" ::: "memory");
        }
    }
    __syncthreads();
}

__global__ void __launch_bounds__(NWAVES * 64, 2) fwd_mk(Args args) {
    extern __shared__ __attribute__((aligned(16))) unsigned char lds_raw[];
    LAS unsigned char* lds = (LAS unsigned char*)lds_raw;
    const int tid = threadIdx.x, lane = tid & 63, wave = __builtin_amdgcn_readfirstlane(tid >> 6);
    const int lo = args.ph_lo, hi = args.ph_hi, G = gridDim.x;
    unsigned char* ws = args.ws;
#define IN(k) (lo <= (k) && (k) < hi)
#define REP(k) for (int rep_ = 0; rep_ <= ((REPMASK >> (k)) & 1); ++rep_)
#define SEAM(k) do { if (IN(k) && IN((k) + 1)) xcd_barrier(bar); } while (0)
    volatile LAS unsigned* MISC = (volatile LAS unsigned*)(lds + EB_OFF + 12288);
    if (tid < 2) MISC[tid] = 0u;
    __syncthreads();
    XcdBarrier bar; bar.bar = (unsigned*)(ws + WS_CTL) + 16384; bar.x = 0; bar.st = MISC;
    if (hi - lo > 1) bar = xcd_barrier_post((unsigned*)(ws + WS_CTL) + 16384, MISC);
    if (lo < -1) cg::this_grid().sync();
    if (IN(0)) { p0_prologue(args, lds, tid, lane, wave); } SEAM(0);
    if (IN(1)) { p1_norm(args, lane, wave); } SEAM(1);
    if (IN(2)) {
        pg8::Gemm g{(const bf16*)(ws + WS_H), (const bf16*)(ws + WS_WIN), MP, DIN, D}; pg8::StaticOrder S; S.init(MP, DIN, G, (int)blockIdx.x);
        pg8::EpiProj E{(bf16*)(ws + WS_PROJ)};
        pg8::gemm_phase<pg8::EpiProj, pg8::StaticOrder, true, true>(lds, g, S, E);
        { pg8::Gemm gs{(const bf16*)(ws + WS_H), (const bf16*)(ws + WS_WIN), M, DIN, 256, D}; pg8::SliceOrder Ss{DIN / 256, 4, (int)blockIdx.x};
          pg8::EpiF32Part Es{(float*)(ws + WS_PART), DIN, (size_t)MS * DIN};
          pg8::gemm_phase<pg8::EpiF32Part, pg8::SliceOrder, true, true>(lds, gs, Ss, Es); }
        if (G == 256 && blockIdx.x >= 64) weight_items(args, lds, lane, wave, 2688 + ((int)blockIdx.x - 64) * 8 + wave, 1536, 1, 4096);
    } SEAM(2);
    if (IN(3)) { p3_mixer(args, tid); } SEAM(3);
    if (IN(4)) {
        { pg8::Gemm g{(const bf16*)(ws + WS_DY), (const bf16*)(ws + WS_WOUT), MP, D, D}; pg8::StaticOrder S; S.init(MP, D, G, (int)blockIdx.x);
          unsigned* ctl = (unsigned*)(ws + WS_CTL); unsigned* xb = (unsigned*)(ws + WS_XB);
          pg8::PanelRms st1{xb, ctl, EPS}, st2{xb + 65536, ctl + CNT_BANK_WORDS, EPS};
          pg8::EpiMixNorm E{args.in[I_XP], (bf16*)(ws + WS_X1), (bf16*)(ws + WS_H), (const float*)(ws + WS_MOD), args.in[I_GPOSTMIX], args.in[I_GPREFFN], st1, st2};
          if (G == 256) pg8::gemm_phase<pg8::EpiMixNorm, pg8::StaticOrder, false, true>(lds, g, S, E); }
        __syncthreads();
        { pg8::Gemm gs{(const bf16*)(ws + WS_DY), (const bf16*)(ws + WS_WOUT), M, D, 256, D}; pg8::SliceOrder Ss{D / 256, 4, (int)blockIdx.x};
          pg8::EpiF32Part Es{(float*)(ws + WS_PART), D, (size_t)MS * D};
          pg8::gemm_phase<pg8::EpiF32Part, pg8::SliceOrder, true, true>(lds, gs, Ss, Es); }
        if (G == 256 && blockIdx.x >= 32) weight_items(args, lds, lane, wave, 4096 + ((int)blockIdx.x - 32) * 8 + wave, 1792, 1, 4800);
    } SEAM(4);
    if (IN(6)) {
        unsigned* cnt5 = (unsigned*)(ws + WS_CTL) + 3 * CNT_BANK_WORDS + 64;
        p5_rowwise1(args, lane, wave, cnt5);
        pg8::Gemm g{(const bf16*)(ws + WS_H), (const bf16*)(ws + WS_WUP), M, DUP, D}; pg8::UpOrder S; S.init(M, DUP, G, (int)blockIdx.x); S.ready = cnt5; S.need = MS;
        pg8::EpiUpGate E{(bf16*)(ws + WS_G), args.in[I_FCONVW], args.in[I_SFFN], args.out + O_NFP, args.out + O_NFS, (float*)(ws + WS_EDGE), (LAS float*)(lds + EB_OFF)};
        pg8::gemm_phase<pg8::EpiUpGate, pg8::UpOrder, true, true>(lds, g, S, E);
    } SEAM(6);
    if (IN(8)) {
        { pg8::Gemm g{(const bf16*)(ws + WS_G), (const bf16*)(ws + WS_WDN), MP, D, DFF}; pg8::StaticOrder S; S.init(MP, D, G, (int)blockIdx.x);
          { pg8::Unit u; for (int i = 0; S.next(i, u); ++i) fixup_tile(args, u.pm, tid); asm volatile("s_waitcnt vmcnt(0)" ::: "memory"); __syncthreads(); }
          pg8::PanelRms st{(unsigned*)(ws + WS_XB) + 131072, (unsigned*)(ws + WS_CTL) + 2 * CNT_BANK_WORDS, EPS};
          pg8::EpiFfnNorm E{(const bf16*)(ws + WS_X1), args.out + O_Y, (const float*)(ws + WS_MOD), args.in[I_GPOSTFFN], st};
          if (G == 256) pg8::gemm_phase<pg8::EpiFfnNorm, pg8::StaticOrder, false, true>(lds, g, S, E); }
        __syncthreads();
        { pg8::Gemm gs{(const bf16*)(ws + WS_G), (const bf16*)(ws + WS_WDN), M, D, 256, DFF}; pg8::SliceOrder Ss{D / 256, 11, (int)blockIdx.x};
          pg8::EpiF32Part Es{(float*)(ws + WS_PART), D, (size_t)MS * D};
          pg8::gemm_phase<pg8::EpiF32Part, pg8::SliceOrder, true, true>(lds, gs, Ss, Es); }
    } SEAM(8);
    if (IN(9)) { const int gw = blockIdx.x * NWAVES + wave; p9_rows(args, lane, MP + gw, M, G * NWAVES); }
#undef IN
#undef SEAM
}

extern "C" void kernel_launch(void* const* d_in, const int* in_sizes, int n_in, void* d_out, int out_size, void* d_ws, size_t ws_size, hipStream_t stream) {
    static int grid = 0;
    if (grid == 0) {
        if (n_in != 21 || out_size != (int)O_END || ws_size < WS_END) { fprintf(stderr, "kernel_launch: unexpected shapes (n_in %d out %d ws %zu)\n", n_in, out_size, ws_size); grid = -1; return; }
        int dev = 0, cus = 0, per_cu = 0;
        hipGetDevice(&dev); hipDeviceGetAttribute(&cus, hipDeviceAttributeMultiprocessorCount, dev);
        if (hipFuncSetAttribute((const void*)fwd_mk, hipFuncAttributeMaxDynamicSharedMemorySize, LDS_BYTES) != hipSuccess) { fprintf(stderr, "kernel_launch: hipFuncSetAttribute failed\n"); grid = -1; return; }
        if (hipOccupancyMaxActiveBlocksPerMultiprocessor(&per_cu, (const void*)fwd_mk, NWAVES * 64, LDS_BYTES) != hipSuccess || per_cu < 1) { fprintf(stderr, "kernel_launch: occupancy query says %d\n", per_cu); per_cu = 1; }
        (void)hipGetLastError();
        grid = cus > 0 ? cus : 256;
    }
    if (grid < 0) return;
    if (hipMemsetAsync((char*)d_ws + WS_CTL + 65536, 0, 16384, stream) != hipSuccess) { fprintf(stderr, "kernel_launch: memset failed\n"); return; }
    Args a{};
    for (int i = 0; i < 21; ++i) a.in[i] = (const float*)d_in[i];
    a.out = (float*)d_out; a.ws = (unsigned char*)d_ws;
#if MK_COOP
    a.ph_lo = 0; a.ph_hi = NPHASE;
    void* kargs[] = {&a};
    hipError_t e = hipLaunchCooperativeKernel((const void*)fwd_mk, dim3(grid), dim3(NWAVES * 64), kargs, LDS_BYTES, stream);
    if (e != hipSuccess) fprintf(stderr, "kernel_launch: cooperative launch failed: %s (grid %d)\n", hipGetErrorString(e), grid);
#else
    for (int p = 0; p < NPHASE; ++p) for (int rep_ = 0; rep_ <= ((REPMASK >> p) & 1); ++rep_) { a.ph_lo = p; a.ph_hi = p + 1; hipLaunchKernelGGL(fwd_mk, dim3(grid), dim3(NWAVES * 64), LDS_BYTES, stream, a); }
#endif
}
```

```cpp
#include <hip/hip_runtime.h>
#include <hip/hip_cooperative_groups.h>
#include <cstdio>
#include <cstdint>
namespace cg = cooperative_groups;
namespace pg8 {
#define PG8_LAS __attribute__((address_space(3)))
typedef unsigned short bf16_t;
typedef short bf16x8 __attribute__((ext_vector_type(8)));
typedef float f32x4 __attribute__((ext_vector_type(4)));
typedef unsigned u32x4 __attribute__((ext_vector_type(4)));
constexpr int BM = 256, BK = 64, HALF = 128, HTB = HALF * BK * 2  , STAGE_BYTES = 8 * HTB, NXCD = 8, WGM = 8;

__host__ __device__ __forceinline__ int lds_byte(int r, int c) { const int st = (r >> 4) * 2 + (c >> 5), rr = r & 15, cc = c & 31, ob = rr * 64 + cc * 2; return st * 1024 + (ob ^ (((ob >> 9) & 1) << 5)); }
__host__ __device__ __forceinline__ void stage_rc(int b, int& R, int& C) { const int st = b / 1024, sb = b % 1024, swz = sb ^ (((sb >> 9) & 1) << 5); R = (st >> 1) * 16 + swz / 64; C = (st & 1) * 32 + (swz % 64) / 2; }
__host__ __device__ __forceinline__ int perm32(int rho) { const int n = rho >> 4, i = rho & 15; return 8 * (i >> 2) + 4 * n + (i & 3); }

struct Unit { int pm, pn, ks; };
struct Gemm { const bf16_t* A; const bf16_t* Bt; int M, N, K; int P = 0; };

struct StaticOrder {
    int nM, nN, nwg, G, c;
    __host__ __device__ void init(int M, int N, int G_, int c_) { nM = M / BM; nN = N / BM; nwg = nM * nN; G = G_; c = c_; }
    __host__ __device__ bool next(int i, Unit& u) const { return at((long)i * G + c, u); }
    __host__ __device__ bool at(long L, Unit& u) const {
        if (L >= nwg) return false;
        int wgid = (int)L; { const int q = nwg / NXCD, r = nwg % NXCD, xcd = wgid % NXCD, off = wgid / NXCD; wgid = (xcd < r ? xcd * (q + 1) : r * (q + 1) + (xcd - r) * q) + off; }
        const int nig = WGM * nN, gid = wgid / nig, fm = gid * WGM, gsz = (nM - fm) < WGM ? (nM - fm) : WGM;
        u.pm = fm + ((wgid % nig) % gsz); u.pn = (wgid % nig) / gsz; u.ks = 0; return true;
    }
    __device__ __forceinline__ void a_ready(const Unit&) const {}
    __device__ __forceinline__ void done(const Unit&) const {}
};

__device__ __forceinline__ unsigned cvt_pk_bf16(float lo, float hi) { unsigned r; asm volatile("v_cvt_pk_bf16_f32 %0, %1, %2" : "=v"(r) : "v"(lo), "v"(hi)); return r; }
typedef float f32x2 __attribute__((ext_vector_type(2)));
__device__ __forceinline__ f32x2 gelu_pk(f32x2 v) {
    const f32x2 av = __builtin_elementwise_abs(v), d = av * 0.2316418882f + 1.0f;
    f32x2 t; t.x = __builtin_amdgcn_rcpf(d.x); t.y = __builtin_amdgcn_rcpf(d.y);
    f32x2 q = t * 0.5307027145f + (-0.7265760135f); q = q * t + 0.7107068705f; q = q * t + (-0.142248368f); q = q * t + 0.127414796f; q = q * t;
    const f32x2 s = (v * v) * (-0.72134752044f);
    f32x2 e; e.x = __builtin_amdgcn_exp2f(s.x); e.y = __builtin_amdgcn_exp2f(s.y);
    const f32x2 m = v * (q * e), r = v - m;
    f32x2 o; o.x = v.x < 0.f ? m.x : r.x; o.y = v.y < 0.f ? m.y : r.y; return o;
}

template <int ACT  > struct EpiBf16 {
    static constexpr bool PERM = true, AFTER_DRAIN = false; static_assert(ACT == 0 || ACT == 1, "EpiBf16: ACT is 0 (none) or 1 (gelu_pk)");
    bf16_t* O; int ldc; const float* bias; int split_cols; size_t split_stride; float scale0;
    __device__ __forceinline__ void operator()(const f32x4 (&acc)[2][2][4][2], const Unit& u, int wr, int wc, int fr, int fq) const {
        const int row0 = u.pm * BM + wr * 64 + fr; int colt = u.pn * BM; bf16_t* base = O;
        float sc = 1.f; if (split_cols) { const int t = colt / split_cols; base += (size_t)t * split_stride; colt -= t * split_cols; if (t == 0) sc = scale0; }
        const int col0 = colt + wc * 32 + 8 * fq, bcol0 = u.pn * BM + wc * 32 + 8 * fq;
        f32x4 bv[2][2];
#pragma unroll
        for (int bj = 0; bj < 2; ++bj)
#pragma unroll
            for (int n = 0; n < 2; ++n) bv[bj][n] = bias ? *(const f32x4*)(bias + bcol0 + bj * HALF + 4 * n) : (f32x4){0.f, 0.f, 0.f, 0.f};
#pragma unroll
        for (int ai = 0; ai < 2; ++ai)
#pragma unroll
            for (int m = 0; m < 4; ++m) { bf16_t* rowp = base + (size_t)(row0 + ai * HALF + m * 16) * ldc + col0;
#pragma unroll
                for (int bj = 0; bj < 2; ++bj) { f32x4 v0 = acc[ai][bj][m][0] + bv[bj][0], v1 = acc[ai][bj][m][1] + bv[bj][1];
                    if (ACT == 1) { f32x2 a = gelu_pk((f32x2){v0[0], v0[1]}), b = gelu_pk((f32x2){v0[2], v0[3]}), c = gelu_pk((f32x2){v1[0], v1[1]}), d = gelu_pk((f32x2){v1[2], v1[3]});
                        v0 = (f32x4){a.x, a.y, b.x, b.y}; v1 = (f32x4){c.x, c.y, d.x, d.y}; }
                    v0 = v0 * sc; v1 = v1 * sc; u32x4 w; w.x = cvt_pk_bf16(v0[0], v0[1]); w.y = cvt_pk_bf16(v0[2], v0[3]); w.z = cvt_pk_bf16(v1[0], v1[1]); w.w = cvt_pk_bf16(v1[2], v1[3]);
                    *(u32x4*)(rowp + bj * HALF) = w; } }
    }
};
struct EpiF32 {
    static constexpr bool PERM = false, AFTER_DRAIN = false;
    float* O; int ldc;
    __device__ __forceinline__ void operator()(const f32x4 (&acc)[2][2][4][2], const Unit& u, int wr, int wc, int fr, int fq) const {
        const int row0 = u.pm * BM + wr * 64 + fr, col0 = u.pn * BM + wc * 32 + 4 * fq;
#pragma unroll
        for (int ai = 0; ai < 2; ++ai)
#pragma unroll
            for (int m = 0; m < 4; ++m) { float* rowp = O + (size_t)(row0 + ai * HALF + m * 16) * ldc + col0;
#pragma unroll
                for (int bj = 0; bj < 2; ++bj)
#pragma unroll
                    for (int n = 0; n < 2; ++n) *(f32x4*)(rowp + bj * HALF + n * 16) = acc[ai][bj][m][n]; }
    }
};
struct EpiProj {
    static constexpr bool PERM = true, AFTER_DRAIN = false;
    bf16_t* O;
    __device__ __forceinline__ void operator()(const f32x4 (&acc)[2][2][4][2], const Unit& u, int wr, int wc, int fr, int fq) const {
        const int row0 = u.pm * BM + wr * 64 + fr, cl = wc * 32 + 8 * fq;
#pragma unroll
        for (int ai = 0; ai < 2; ++ai)
#pragma unroll
            for (int m = 0; m < 4; ++m) { bf16_t* rowp = O + (size_t)(row0 + ai * HALF + m * 16) * 1536;
                if (u.pn < 4) {
#pragma unroll
                    for (int bj = 0; bj < 2; ++bj) { const f32x4 v0 = acc[ai][bj][m][0], v1 = acc[ai][bj][m][1]; u32x4 w;
                        w.x = cvt_pk_bf16(v0[0], v0[1]); w.y = cvt_pk_bf16(v0[2], v0[3]); w.z = cvt_pk_bf16(v1[0], v1[1]); w.w = cvt_pk_bf16(v1[2], v1[3]);
                        *(u32x4*)(rowp + u.pn * BM + bj * HALF + cl) = w; }
                } else {
                    const f32x4 v0 = acc[ai][0][m][0] * acc[ai][1][m][0], v1 = acc[ai][0][m][1] * acc[ai][1][m][1]; u32x4 w;
                    w.x = cvt_pk_bf16(v0[0], v0[1]); w.y = cvt_pk_bf16(v0[2], v0[3]); w.z = cvt_pk_bf16(v1[0], v1[1]); w.w = cvt_pk_bf16(v1[2], v1[3]);
                    *(u32x4*)(rowp + 1024 + (u.pn - 4) * HALF + cl) = w;
                } }
    }
};
__device__ __forceinline__ f32x4 shfl4(f32x4 v, int src) { f32x4 r; r.x = __shfl(v.x, src); r.y = __shfl(v.y, src); r.z = __shfl(v.z, src); r.w = __shfl(v.w, src); return r; }
template <int N> __device__ __forceinline__ float dpp_ror(float v) { return __builtin_bit_cast(float, __builtin_amdgcn_mov_dpp(__builtin_bit_cast(int, v), 0x120 + N, 0xf, 0xf, true)); }
template <int N> __device__ __forceinline__ f32x4 ror4(f32x4 v) { f32x4 r; r.x = dpp_ror<N>(v.x); r.y = dpp_ror<N>(v.y); r.z = dpp_ror<N>(v.z); r.w = dpp_ror<N>(v.w); return r; }
template <int N> __device__ __forceinline__ float dpp_shr_old(float old, float v) { return __builtin_bit_cast(float, __builtin_amdgcn_update_dpp(__builtin_bit_cast(int, old), __builtin_bit_cast(int, v), 0x110 + N, 0xf, 0xf, false)); }
template <int N> __device__ __forceinline__ f32x4 shr4(f32x4 old, f32x4 v) { f32x4 r; r.x = dpp_shr_old<N>(old.x, v.x); r.y = dpp_shr_old<N>(old.y, v.y); r.z = dpp_shr_old<N>(old.z, v.z); r.w = dpp_shr_old<N>(old.w, v.w); return r; }
struct EpiUpGate {
    static constexpr bool PERM = true, AFTER_DRAIN = false;
    bf16_t* G; const float* cw; const float* st; float* nfp; float* nfs; float* edge; PG8_LAS float* eb;
    __device__ __forceinline__ void operator()(const f32x4 (&acc)[2][2][4][2], const Unit& u, int wr, int wc, int fr, int fq) const {
        const int lane = fq * 16 + fr;
        const int tc0 = wc * 32 + 8 * fq, j0 = u.pn * 128 + tc0;
        const int src1 = (lane & 48) | ((fr + 15) & 15), src2 = (lane & 48) | ((fr + 14) & 15);
        const bool sample = u.pm >= 64;
        PG8_LAS float* wl = eb + 2048;
        { const int t_ = (int)threadIdx.x; if (t_ < 256) { const int c_ = (t_ < 128 ? 0 : 2816 - 128) + u.pn * 128 + t_;
#pragma unroll
            for (int k = 0; k < 3; ++k) wl[k * 256 + t_] = cw[k * 5632 + c_]; } }
        if (!sample && fr >= 14) {
#pragma unroll
            for (int ai = 0; ai < 2; ++ai)
#pragma unroll
                for (int bj = 0; bj < 2; ++bj)
#pragma unroll
                    for (int n = 0; n < 2; ++n) *(PG8_LAS f32x4*)(eb + ((2 * ai + wr) * 2 + (fr - 14)) * 256 + 128 * bj + tc0 + 4 * n) = acc[ai][bj][3][n];
        }
        asm volatile("s_waitcnt lgkmcnt(0)" ::: "memory"); __builtin_amdgcn_s_barrier(); asm volatile("" ::: "memory");
#pragma unroll
        for (int ai = 0; ai < 2; ++ai) {
            const int blk = 2 * ai + wr;
#pragma unroll
            for (int m = 0; m < 4; ++m) {
                const int r = 128 * ai + 64 * wr + 16 * m + fr;
                int wo = tc0; asm volatile("" : "+v"(wo));
                f32x4 uu[2][2];
#pragma unroll
                for (int bj = 0; bj < 2; ++bj)
#pragma unroll
                    for (int n = 0; n < 2; ++n) {
                        const f32x4 x = acc[ai][bj][m][n];
                        f32x4 p1, p2;
                        if (!sample) {
                            if (m > 0) {
                                const f32x4 xp = acc[ai][bj][m > 0 ? m - 1 : 0][n];
                                p1 = shr4<1>(ror4<1>(xp), x); p2 = shr4<2>(ror4<2>(xp), x);
                            } else {
                                f32x4 b1 = (f32x4){0.f, 0.f, 0.f, 0.f}, b2 = b1;
                                if (blk > 0) { b1 = *(const PG8_LAS f32x4*)(eb + ((blk - 1) * 2 + 1) * 256 + 128 * bj + tc0 + 4 * n);
                                               b2 = *(const PG8_LAS f32x4*)(eb + ((blk - 1) * 2 + (fr == 0 ? 0 : 1)) * 256 + 128 * bj + tc0 + 4 * n); }
                                p1 = shr4<1>(b1, x); p2 = shr4<2>(b2, x);
                            }
                        } else {
                            const int srow = (u.pm - 64) * 256 + r, b = srow >> 2, t = fr & 3;
                            p1 = ror4<1>(x); p2 = ror4<2>(x);
                            const size_t so = (size_t)b * 2 * 5632 + bj * 2816 + j0 + 4 * n;
                            if (t < 2) { const f32x4 s0 = *(const f32x4*)(st + so), s1 = *(const f32x4*)(st + so + 5632);
                                if (t == 0) { p1 = s1; p2 = s0; } else { p2 = s1; } }
                            else *(f32x4*)(nfs + so + (size_t)(t - 2) * 5632) = x;
                        }
                        const PG8_LAS float* wp = wl + 128 * bj + wo + 4 * n;
                        uu[bj][n] = *(const PG8_LAS f32x4*)wp * p2 + *(const PG8_LAS f32x4*)(wp + 256) * p1 + *(const PG8_LAS f32x4*)(wp + 512) * x;
                    }
                float gv[8];
#pragma unroll
                for (int n = 0; n < 2; ++n)
#pragma unroll
                    for (int c = 0; c < 4; ++c) { const float a = uu[0][n][c], b = uu[1][n][c]; gv[n * 4 + c] = a * __builtin_amdgcn_rcpf(1.0f + __expf(-a)) * b; }
                u32x4 o; o.x = cvt_pk_bf16(gv[0], gv[1]); o.y = cvt_pk_bf16(gv[2], gv[3]); o.z = cvt_pk_bf16(gv[4], gv[5]); o.w = cvt_pk_bf16(gv[6], gv[7]);
                const bool deferred = (!sample) && (blk == 0) && (m == 0) && (fr < 2) && ((u.pm & 7) != 0);
                if (!deferred) *(u32x4*)(G + (size_t)(u.pm * BM + r) * 2816 + j0) = o;
            }
        }
        if (!sample) {
            float* eg = edge + (size_t)(u.pm * 22 + u.pn) * 1024;
            if (wr == 0 && fr < 2) {
#pragma unroll
                for (int bj = 0; bj < 2; ++bj)
#pragma unroll
                    for (int n = 0; n < 2; ++n) *(f32x4*)(eg + fr * 256 + 128 * bj + tc0 + 4 * n) = acc[0][bj][0][n];
            }
            if (wr == 1 && fr >= 14) {
#pragma unroll
                for (int bj = 0; bj < 2; ++bj)
#pragma unroll
                    for (int n = 0; n < 2; ++n) { *(f32x4*)(eg + (2 + fr - 14) * 256 + 128 * bj + tc0 + 4 * n) = acc[1][bj][3][n];
                        if ((u.pm & 7) == 7) *(f32x4*)(nfp + (size_t)((u.pm >> 3) * 2 + (fr - 14)) * 5632 + bj * 2816 + j0 + 4 * n) = acc[1][bj][3][n]; }
            }
        }
    }
};
struct PanelRms {
    unsigned* xbuf;
    unsigned* cnt;
    float eps;
    __device__ __forceinline__ void run(const f32x4 (&v)[2][2][4][2], const Unit& u, int wr, int wc, int fr, int fq, PG8_LAS unsigned char* lds, int wid, int lane) const {
        PG8_LAS float* P = (PG8_LAS float*)lds;
        PG8_LAS float* S = (PG8_LAS float*)(lds + 8192);
#pragma unroll
        for (int ai = 0; ai < 2; ++ai)
#pragma unroll
            for (int m = 0; m < 4; ++m) {
                float q = 0.f;
#pragma unroll
                for (int bj = 0; bj < 2; ++bj)
#pragma unroll
                    for (int n = 0; n < 2; ++n) { const f32x4 x = v[ai][bj][m][n]; q += (x[0] * x[0] + x[1] * x[1]) + (x[2] * x[2] + x[3] * x[3]); }
                q += __shfl_xor(q, 16); q += __shfl_xor(q, 32);
                if (fq == 0) P[(ai * HALF + wr * 64 + m * 16 + fr) * 4 + wc] = q;
            }
        asm volatile("s_waitcnt lgkmcnt(0)" ::: "memory"); __builtin_amdgcn_s_barrier(); asm volatile("" ::: "memory");
        const int row = wid * 32 + (lane & 31);
        if (lane < 32) {
            const float q = (P[row * 4 + 0] + P[row * 4 + 1]) + (P[row * 4 + 2] + P[row * 4 + 3]);
            __hip_atomic_store(xbuf + ((size_t)(u.pm * BM + row) * 4 + u.pn), __float_as_uint(q), __ATOMIC_RELAXED, __HIP_MEMORY_SCOPE_AGENT);
        }
        asm volatile("s_waitcnt vmcnt(0)" ::: "memory");
        if (lane == 0) __hip_atomic_fetch_add(cnt + 64 * u.pm, 1u, __ATOMIC_RELAXED, __HIP_MEMORY_SCOPE_AGENT);
        if (wid == 0) {
            unsigned spins = 0;
            for (;;) {
                if ((unsigned)__builtin_amdgcn_readfirstlane(__hip_atomic_load(cnt + 64 * u.pm, __ATOMIC_RELAXED, __HIP_MEMORY_SCOPE_AGENT)) >= 32u) break;
                if (++spins > (1u << 22)) break;
                __builtin_amdgcn_s_sleep(2);
            }
            __builtin_amdgcn_fence(__ATOMIC_ACQUIRE, "agent");
        }
        asm volatile("s_waitcnt vmcnt(0) lgkmcnt(0)" ::: "memory"); __builtin_amdgcn_s_barrier(); asm volatile("" ::: "memory");
        if (lane < 32) {
            const unsigned* slot = xbuf + (size_t)(u.pm * BM + row) * 4; float q = 0.f;
#pragma unroll
            for (int t = 0; t < 4; ++t) q += __uint_as_float(__hip_atomic_load(slot + t, __ATOMIC_RELAXED, __HIP_MEMORY_SCOPE_AGENT));
            S[row] = 1.0f / sqrtf(q * (1.0f / 1024.0f) + eps);
        }
        asm volatile("s_waitcnt lgkmcnt(0)" ::: "memory"); __builtin_amdgcn_s_barrier(); asm volatile("" ::: "memory");
    }
};
struct EpiMixNorm {
    static constexpr bool PERM = false, AFTER_DRAIN = true;
    const float* x; bf16_t* X1; bf16_t* H; const float* mod; const float* gpm; const float* gpf; PanelRms st1, st2;
    __device__ __forceinline__ void fused(f32x4 (&acc)[2][2][4][2], const Unit& u, int wr, int wc, int fr, int fq, PG8_LAS unsigned char* lds, int wid, int lane) const {
        typedef unsigned u32x2v __attribute__((ext_vector_type(2)));
        const PG8_LAS float* S = (const PG8_LAS float*)(lds + 8192);
        const float* md = mod + (size_t)(u.pm >> 3) * 6144;
        const int col0 = u.pn * BM + wc * 32 + 4 * fq;
        f32x4 pre[2][2][2];
#pragma unroll
        for (int m = 0; m < 2; ++m) { const size_t off = (size_t)(u.pm * BM + wr * 64 + m * 16 + fr) * 1024 + col0;
#pragma unroll
            for (int bj = 0; bj < 2; ++bj)
#pragma unroll
                for (int n = 0; n < 2; ++n) pre[m][bj][n] = *(const f32x4*)(x + off + bj * HALF + n * 16); }
        st1.run(acc, u, wr, wc, fr, fq, lds, wid, lane);
        f32x4 cf[2][2];
#pragma unroll
        for (int bj = 0; bj < 2; ++bj)
#pragma unroll
            for (int n = 0; n < 2; ++n) { const int c = col0 + bj * HALF + n * 16; cf[bj][n] = *(const f32x4*)(md + 2048 + c) * *(const f32x4*)(gpm + c); }
#pragma unroll
        for (int ai = 0; ai < 2; ++ai)
#pragma unroll
            for (int m = 0; m < 4; ++m) { const int r = ai * HALF + wr * 64 + m * 16 + fr; const float rs = S[r]; const size_t off = (size_t)(u.pm * BM + r) * 1024 + col0;
#pragma unroll
                for (int bj = 0; bj < 2; ++bj)
#pragma unroll
                    for (int n = 0; n < 2; ++n) { const f32x4 bs = (ai == 0 && m < 2) ? pre[m < 2 ? m : 0][bj][n] : *(const f32x4*)(x + off + bj * HALF + n * 16); acc[ai][bj][m][n] = bs + cf[bj][n] * (acc[ai][bj][m][n] * rs); }
                asm volatile("" : "+v"(acc[ai][0][m][0]), "+v"(acc[ai][0][m][1]), "+v"(acc[ai][1][m][0]), "+v"(acc[ai][1][m][1]));
                if (m & 1) asm volatile("" ::: "memory"); }
        st2.run(acc, u, wr, wc, fr, fq, lds, wid, lane);
        f32x4 c2[2][2], sh[2][2];
#pragma unroll
        for (int bj = 0; bj < 2; ++bj)
#pragma unroll
            for (int n = 0; n < 2; ++n) { const int c = col0 + bj * HALF + n * 16; c2[bj][n] = *(const f32x4*)(gpf + c) * (1.0f + *(const f32x4*)(md + 4096 + c)); sh[bj][n] = *(const f32x4*)(md + 3072 + c); }
#pragma unroll
        for (int ai = 0; ai < 2; ++ai)
#pragma unroll
            for (int m = 0; m < 4; ++m) { const int r = ai * HALF + wr * 64 + m * 16 + fr; const float rs = S[r]; const size_t off = (size_t)(u.pm * BM + r) * 1024 + col0;
#pragma unroll
                for (int bj = 0; bj < 2; ++bj)
#pragma unroll
                    for (int n = 0; n < 2; ++n) { const f32x4 x1 = acc[ai][bj][m][n]; { u32x2v w1; w1.x = cvt_pk_bf16(x1[0], x1[1]); w1.y = cvt_pk_bf16(x1[2], x1[3]); *(u32x2v*)(X1 + off + bj * HALF + n * 16) = w1; }
                        const f32x4 o = x1 * rs * c2[bj][n] + sh[bj][n]; u32x2v w; w.x = cvt_pk_bf16(o[0], o[1]); w.y = cvt_pk_bf16(o[2], o[3]);
                        *(u32x2v*)(H + off + bj * HALF + n * 16) = w; }
                asm volatile("" ::: "memory"); }
    }
};
struct EpiFfnNorm {
    static constexpr bool PERM = false, AFTER_DRAIN = true;
    const bf16_t* X1; float* Y; const float* mod; const float* gpo; PanelRms st;
    __device__ __forceinline__ void fused(f32x4 (&acc)[2][2][4][2], const Unit& u, int wr, int wc, int fr, int fq, PG8_LAS unsigned char* lds, int wid, int lane) const {
        typedef unsigned u32x2v __attribute__((ext_vector_type(2)));
        const PG8_LAS float* S = (const PG8_LAS float*)(lds + 8192);
        const float* md = mod + (size_t)(u.pm >> 3) * 6144;
        const int col0 = u.pn * BM + wc * 32 + 4 * fq;
        u32x2v pre[1][4][2][2];
#pragma unroll
        for (int ai = 0; ai < 1; ++ai)
#pragma unroll
            for (int m = 0; m < 4; ++m) { const size_t off = (size_t)(u.pm * BM + ai * HALF + wr * 64 + m * 16 + fr) * 1024 + col0;
#pragma unroll
                for (int bj = 0; bj < 2; ++bj)
#pragma unroll
                    for (int n = 0; n < 2; ++n) pre[ai][m][bj][n] = *(const u32x2v*)(X1 + off + bj * HALF + n * 16); }
        st.run(acc, u, wr, wc, fr, fq, lds, wid, lane);
        f32x4 cf[2][2];
#pragma unroll
        for (int bj = 0; bj < 2; ++bj)
#pragma unroll
            for (int n = 0; n < 2; ++n) { const int c = col0 + bj * HALF + n * 16; cf[bj][n] = *(const f32x4*)(md + 5120 + c) * *(const f32x4*)(gpo + c); }
#pragma unroll
        for (int ai = 0; ai < 2; ++ai)
#pragma unroll
            for (int m = 0; m < 4; ++m) { const int r = ai * HALF + wr * 64 + m * 16 + fr; const float rs = S[r]; const size_t off = (size_t)(u.pm * BM + r) * 1024 + col0;
#pragma unroll
                for (int bj = 0; bj < 2; ++bj)
#pragma unroll
                    for (int n = 0; n < 2; ++n) { const u32x2v p = ai == 0 ? pre[0][m][bj][n] : *(const u32x2v*)(X1 + off + bj * HALF + n * 16);
                        const f32x4 bs = (f32x4){__uint_as_float(p.x << 16), __uint_as_float(p.x & 0xffff0000u), __uint_as_float(p.y << 16), __uint_as_float(p.y & 0xffff0000u)};
                        *(f32x4*)(Y + off + bj * HALF + n * 16) = bs + cf[bj][n] * (acc[ai][bj][m][n] * rs); } }
    }
};
struct SliceOrder {
    int nN, nsl, c, stride = 1 << 30;
    __device__ bool next(int i, Unit& u) const { if (c < 0 || i > 1) return false; const long idl = (long)c + (long)i * stride; if (idl >= 2 * nN * nsl) return false; const int id = (int)idl;
        u.ks = id % nsl; const int r = id / nsl; u.pn = r % nN; u.pm = 64 + r / nN; return true; }
    __device__ __forceinline__ void a_ready(const Unit&) const {}
    __device__ __forceinline__ void done(const Unit&) const {}
};
struct EpiF32Part {
    static constexpr bool PERM = false, AFTER_DRAIN = false;
    float* O; int ldc; size_t pstride;
    __device__ __forceinline__ void operator()(const f32x4 (&acc)[2][2][4][2], const Unit& u, int wr, int wc, int fr, int fq) const {
        const int row0 = (u.pm - 64) * BM + wr * 64 + fr, col0 = u.pn * BM + wc * 32 + 4 * fq;
        float* Ob = O + (size_t)u.ks * pstride;
#pragma unroll
        for (int ai = 0; ai < 2; ++ai)
#pragma unroll
            for (int m = 0; m < 4; ++m) { float* rowp = Ob + (size_t)(row0 + ai * HALF + m * 16) * ldc + col0;
#pragma unroll
                for (int bj = 0; bj < 2; ++bj)
#pragma unroll
                    for (int n = 0; n < 2; ++n) *(f32x4*)(rowp + bj * HALF + n * 16) = acc[ai][bj][m][n]; }
    }
};
struct UpOrder : StaticOrder {
    const unsigned* ready; unsigned need;
    __device__ bool next(int i, Unit& u) const {
        const int L = i * G + c; constexpr int ns = 44;
        if (L >= 256 && L < 256 + ns) { const int id = L - 256; u.pm = id >= 22 ? 65 : 64; u.pn = id >= 22 ? id - 22 : id; u.ks = 0; return true; }
        return at(L < 256 ? L : L - ns, u);
    }
    __device__ __forceinline__ void done(const Unit& u) const {
        if (u.pm < 64) return;
        asm volatile("s_waitcnt vmcnt(0)" ::: "memory"); __builtin_amdgcn_fence(__ATOMIC_RELEASE, "agent");
        if ((threadIdx.x & 63) == 0) __hip_atomic_fetch_add(const_cast<unsigned*>(ready) + 256, 1u, __ATOMIC_RELAXED, __HIP_MEMORY_SCOPE_AGENT);
    }
    __device__ __forceinline__ void a_ready(const Unit& u) const {
        if (u.pm < 64) return;
        if (threadIdx.x < 64) {
            unsigned spins = 0;
            while ((unsigned)__builtin_amdgcn_readfirstlane(__hip_atomic_load(ready, __ATOMIC_RELAXED, __HIP_MEMORY_SCOPE_AGENT)) < need) { if (++spins > (1u << 22)) break; __builtin_amdgcn_s_sleep(2); }
            __builtin_amdgcn_fence(__ATOMIC_ACQUIRE, "agent");
            asm volatile("s_waitcnt vmcnt(0)" ::: "memory");
        }
        asm volatile("" ::: "memory"); __builtin_amdgcn_s_barrier(); asm volatile("" ::: "memory");
    }
};
template <class Epi, class Sched, bool ALIGN_EPI = false, bool SP2 = false>
__device__ __forceinline__ void gemm_phase(PG8_LAS unsigned char* lds, const Gemm g, const Sched& S, const Epi& E) {
    const int tid = threadIdx.x, wid = __builtin_amdgcn_readfirstlane(tid >> 6), lane = tid & 63, wr = wid >> 2, wc = wid & 3, fr = lane & 15, fq = lane >> 4;
    const int K = g.P ? g.P : g.K, nt = g.K / BK;
    const size_t sstep = (size_t)g.K * 2;
    unsigned voffA[2], voffB[2];
#pragma unroll
    for (int i = 0; i < 2; ++i) { int R, C; stage_rc(tid * 16 + i * 8192, R, C); const int Rb = Epi::PERM ? ((R & ~31) + perm32(R & 31)) : R;
        voffA[i] = (unsigned)(R * K + C) * 2u; voffB[i] = (unsigned)(Rb * K + C) * 2u; }
    const size_t kstep = (size_t)(BK * 2);
    const size_t hstep = (size_t)HALF * K * 2;
    const size_t tstep = 2 * hstep;
    const unsigned ldsw = (unsigned)wid * 1024u;
    const int aoff = lds_byte(wr * 64 + fr, fq * 8), boff = lds_byte(wc * 32 + fr, fq * 8);
#define PG8_SA(b, h) (((b) * 2 + (h)) * HTB)
#define PG8_SB(b, h) ((4 + (b) * 2 + (h)) * HTB)
#define PG8_STAGE(bufoff, gbase, voff) do { _Pragma("unroll") for (int _i = 0; _i < 2; ++_i) \
        __builtin_amdgcn_global_load_lds((const unsigned*)((const char*)(gbase) + (voff)[_i]), (PG8_LAS unsigned*)(lds + (bufoff) + ldsw + _i * 8192), 16, 0, 0); } while (0)
#define PG8_LDA(dst, b, h) do { _Pragma("unroll") for (int m = 0; m < 4; ++m) _Pragma("unroll") for (int k = 0; k < 2; ++k) dst[m][k] = *(const PG8_LAS bf16x8*)(lds + PG8_SA(b, h) + aoff + m * 2048 + k * 1024); } while (0)
#define PG8_LDB(dst, b, h) do { _Pragma("unroll") for (int n = 0; n < 2; ++n) _Pragma("unroll") for (int k = 0; k < 2; ++k) dst[n][k] = *(const PG8_LAS bf16x8*)(lds + PG8_SB(b, h) + boff + n * 2048 + k * 1024); } while (0)
#define PG8_MMA(ai, bj, At, Bt) do { __builtin_amdgcn_s_setprio(1); _Pragma("unroll") for (int m = 0; m < 4; ++m) _Pragma("unroll") for (int n = 0; n < 2; ++n) _Pragma("unroll") for (int k = 0; k < 2; ++k) \
        acc[ai][bj][m][n] = __builtin_amdgcn_mfma_f32_16x16x32_bf16(Bt[n][k], At[m][k], acc[ai][bj][m][n], 0, 0, 0); __builtin_amdgcn_s_setprio(0); } while (0)
#define PG8_WAIT_V(n) asm volatile("s_waitcnt vmcnt(" #n ")" ::: "memory")
#define PG8_WAIT_L(n) asm volatile("s_waitcnt lgkmcnt(" #n ")" ::: "memory")
#define PG8_BAR __builtin_amdgcn_s_barrier()
#define PG8_SCHED __builtin_amdgcn_sched_barrier(0)
    Unit cur, nxt; int ui = 0;
    if (!S.next(0, cur)) return;
    f32x4 acc[2][2][4][2];
#pragma unroll
    for (int a = 0; a < 2; ++a)
#pragma unroll
        for (int b = 0; b < 2; ++b)
#pragma unroll
            for (int m = 0; m < 4; ++m)
#pragma unroll
                for (int n = 0; n < 2; ++n) acc[a][b][m][n] = (f32x4){0.f, 0.f, 0.f, 0.f};
    bf16x8 At[4][2], B0[2][2], B1[2][2];
    const char* cA = (const char*)g.A + (size_t)cur.pm * tstep + cur.ks * sstep; const char* cB = (const char*)g.Bt + (size_t)cur.pn * tstep + cur.ks * sstep;
    S.a_ready(cur);
    if constexpr (SP2) {
        PG8_STAGE(PG8_SB(0, 0), cB, voffB); PG8_STAGE(PG8_SB(0, 1), cB + hstep, voffB); PG8_STAGE(PG8_SA(0, 0), cA, voffA); PG8_STAGE(PG8_SA(0, 1), cA + hstep, voffA);
        if (wr == 1) PG8_BAR;
        PG8_WAIT_V(2); PG8_BAR;
        PG8_STAGE(PG8_SB(1, 0), cB + kstep, voffB); PG8_STAGE(PG8_SA(1, 0), cA + kstep, voffA); PG8_STAGE(PG8_SB(1, 1), cB + hstep + kstep, voffB);
        PG8_WAIT_V(6); PG8_BAR;
    } else {
        PG8_STAGE(PG8_SB(0, 0), cB, voffB); PG8_STAGE(PG8_SA(0, 0), cA, voffA); PG8_STAGE(PG8_SB(0, 1), cB + hstep, voffB); PG8_STAGE(PG8_SA(0, 1), cA + hstep, voffA);
        if (wr == 1) PG8_BAR;
        PG8_WAIT_V(4); PG8_BAR;
        PG8_STAGE(PG8_SB(1, 0), cB + kstep, voffB); PG8_STAGE(PG8_SA(1, 0), cA + kstep, voffA); PG8_STAGE(PG8_SB(1, 1), cB + hstep + kstep, voffB);
        PG8_WAIT_V(6); PG8_BAR;
    }
    for (;;) {
        const bool has_next = S.next(ui + 1, nxt);
        const char* nA = has_next ? (const char*)g.A + (size_t)nxt.pm * tstep + nxt.ks * sstep : cA; const char* nB = has_next ? (const char*)g.Bt + (size_t)nxt.pn * tstep + nxt.ks * sstep : cB;
        for (int t = 0; t < nt; t += 2) {
            const bool last = (t == nt - 2);
            const char* a1 = cA + (size_t)(t + 1) * kstep;
            const char* a2 = last ? nA : cA + (size_t)(t + 2) * kstep; const char* b2 = last ? nB : cB + (size_t)(t + 2) * kstep;
            const char* a3 = a2 + kstep; const char* b3 = b2 + kstep;
            if (last && has_next) S.a_ready(nxt);
            if constexpr (SP2) {
            PG8_LDB(B0, 0, 0); PG8_LDB(B1, 0, 1); PG8_SCHED; PG8_LDA(At, 0, 0); PG8_STAGE(PG8_SA(1, 1), a1 + hstep, voffA);
            PG8_WAIT_V(8); PG8_WAIT_L(0); PG8_BAR; PG8_MMA(0, 0, At, B0); PG8_MMA(0, 1, At, B1); PG8_BAR; PG8_SCHED;
            PG8_LDA(At, 0, 1); PG8_STAGE(PG8_SB(0, 0), b2, voffB); PG8_STAGE(PG8_SB(0, 1), b2 + hstep, voffB); PG8_STAGE(PG8_SA(0, 0), a2, voffA);
            PG8_WAIT_V(8); PG8_WAIT_L(0); PG8_BAR; PG8_MMA(1, 0, At, B0); PG8_MMA(1, 1, At, B1); PG8_BAR; PG8_SCHED;
            PG8_LDB(B0, 1, 0); PG8_LDB(B1, 1, 1); PG8_SCHED; PG8_LDA(At, 1, 0); PG8_STAGE(PG8_SA(0, 1), a2 + hstep, voffA);
            PG8_WAIT_V(8); PG8_WAIT_L(0); PG8_BAR; PG8_MMA(0, 0, At, B0); PG8_MMA(0, 1, At, B1); PG8_BAR; PG8_SCHED;
            PG8_LDA(At, 1, 1); PG8_STAGE(PG8_SB(1, 0), b3, voffB); PG8_STAGE(PG8_SB(1, 1), b3 + hstep, voffB); PG8_STAGE(PG8_SA(1, 0), a3, voffA);
            PG8_WAIT_V(8); PG8_WAIT_L(0); PG8_BAR; PG8_MMA(1, 0, At, B0); PG8_MMA(1, 1, At, B1); PG8_BAR; PG8_SCHED;
            } else {
            PG8_LDB(B0, 0, 0); PG8_SCHED; PG8_LDA(At, 0, 0); PG8_STAGE(PG8_SA(1, 1), a1 + hstep, voffA);
            PG8_WAIT_L(8); PG8_BAR; PG8_WAIT_L(0); PG8_MMA(0, 0, At, B0); PG8_BAR; PG8_SCHED;
            PG8_LDB(B1, 0, 1); PG8_STAGE(PG8_SB(0, 0), b2, voffB);
            PG8_BAR; PG8_WAIT_L(0); PG8_MMA(0, 1, At, B1); PG8_BAR;
            PG8_LDA(At, 0, 1); PG8_STAGE(PG8_SA(0, 0), a2, voffA);
            PG8_BAR; PG8_WAIT_L(0); PG8_MMA(1, 0, At, B0); PG8_BAR; PG8_SCHED;
            PG8_STAGE(PG8_SB(0, 1), b2 + hstep, voffB);
            PG8_WAIT_V(6); PG8_BAR; PG8_MMA(1, 1, At, B1); PG8_BAR;
            PG8_LDB(B0, 1, 0); PG8_SCHED; PG8_LDA(At, 1, 0); PG8_STAGE(PG8_SA(0, 1), a2 + hstep, voffA);
            PG8_WAIT_L(8); PG8_BAR; PG8_WAIT_L(0); PG8_MMA(0, 0, At, B0); PG8_BAR; PG8_SCHED;
            PG8_LDB(B1, 1, 1); PG8_STAGE(PG8_SB(1, 0), b3, voffB);
            PG8_BAR; PG8_WAIT_L(0); PG8_MMA(0, 1, At, B1); PG8_BAR;
            PG8_LDA(At, 1, 1); PG8_STAGE(PG8_SA(1, 0), a3, voffA);
            PG8_BAR; PG8_WAIT_L(0); PG8_MMA(1, 0, At, B0); PG8_BAR; PG8_SCHED;
            PG8_STAGE(PG8_SB(1, 1), b3 + hstep, voffB);
            PG8_WAIT_V(6); PG8_BAR; PG8_MMA(1, 1, At, B1); PG8_BAR;
            }
        }
        if constexpr (ALIGN_EPI) { if (wr == 0) PG8_BAR; }
        if constexpr (!Epi::AFTER_DRAIN) { E(acc, cur, wr, wc, fr, fq); S.done(cur); }
        if (!has_next) break;
#pragma unroll
        for (int a = 0; a < 2; ++a)
#pragma unroll
            for (int b = 0; b < 2; ++b)
#pragma unroll
                for (int m = 0; m < 4; ++m)
#pragma unroll
                    for (int n = 0; n < 2; ++n) acc[a][b][m][n] = (f32x4){0.f, 0.f, 0.f, 0.f};
        cur = nxt; cA = nA; cB = nB; ++ui;
        if constexpr (ALIGN_EPI) { if (wr == 1) PG8_BAR; }
    }
    PG8_WAIT_V(0);
    if constexpr (!ALIGN_EPI) { if (wr == 0) PG8_BAR; }
    PG8_BAR;
    if constexpr (Epi::AFTER_DRAIN) { E.fused(acc, cur, wr, wc, fr, fq, lds, wid, lane); S.done(cur); }
#undef PG8_SA
#undef PG8_SB
#undef PG8_STAGE
#undef PG8_LDA
#undef PG8_LDB
#undef PG8_MMA
#undef PG8_WAIT_V
#undef PG8_WAIT_L
#undef PG8_BAR
#undef PG8_SCHED
}
}
#define LAS __attribute__((address_space(3)))
typedef unsigned short bf16;
typedef unsigned v4u __attribute__((ext_vector_type(4)));
typedef unsigned v2u __attribute__((ext_vector_type(2)));
typedef float f32x4 __attribute__((ext_vector_type(4)));
typedef float f32x2v __attribute__((ext_vector_type(2)));
typedef short bf16x8 __attribute__((ext_vector_type(8)));
#ifndef REPMASK
#define REPMASK 0
#endif
#ifndef MK_COOP
#define MK_COOP 1
#endif
constexpr int NWAVES = 8, NPHASE = 9;
constexpr int PP = 1536;
constexpr int MP = 16384, MS = 512, M = MP + MS, D = 1024, DIN = 2048, DFF = 2816, DUP = 5632, NBATCH = 136, NMOD = 6144;
constexpr float EPS = 1e-6f;
constexpr size_t MiB = 1u << 20;
constexpr size_t WS_CTL = 0, CTL_ZERO_BYTES = 1 * MiB, WS_MOD = 1 * MiB, WS_WIN = 5 * MiB, WS_WOUT = 9 * MiB, WS_WUP = 11 * MiB, WS_WDN = 22 * MiB, WS_EDGE = 28 * MiB,
                 WS_H = 34 * MiB, WS_DY = 67 * MiB, WS_PROJ = 100 * MiB, WS_MIX = 100 * MiB, WS_G = 67 * MiB, WS_F = 160 * MiB, WS_XB = 228 * MiB, WS_PART = 200 * MiB  , WS_X1 = 168 * MiB  , WS_END = 256 * MiB;
constexpr int CNT_BANK_WORDS = 64 * 64;
constexpr size_t O_Y = 0, O_NPP = 17301504, O_NCP = 17362944, O_NFP = 17371136, O_NPS = 17461248, O_NCS = 18444288, O_NFS = 18575360, O_END = 20017152;
constexpr int RING_BYTES = 131072, EB_OFF = 131072, LDS_BYTES = 147456;
#define LDS_WAIT() asm volatile("s_waitcnt lgkmcnt(0)" ::: "memory")

__device__ __forceinline__ unsigned f2bf(float f) { unsigned u = __builtin_bit_cast(unsigned, f); return (u + 0x7fffu + ((u >> 16) & 1u)) >> 16; }
__device__ __forceinline__ unsigned pk2(float lo, float hi) { unsigned r; asm("v_cvt_pk_bf16_f32 %0, %1, %2" : "=v"(r) : "v"(lo), "v"(hi)); return r; }
__device__ __forceinline__ void unpack8(v4u v, float (&f)[8]) {
    f[0] = __builtin_bit_cast(float, v.x << 16); f[1] = __builtin_bit_cast(float, v.x & 0xffff0000u);
    f[2] = __builtin_bit_cast(float, v.y << 16); f[3] = __builtin_bit_cast(float, v.y & 0xffff0000u);
    f[4] = __builtin_bit_cast(float, v.z << 16); f[5] = __builtin_bit_cast(float, v.z & 0xffff0000u);
    f[6] = __builtin_bit_cast(float, v.w << 16); f[7] = __builtin_bit_cast(float, v.w & 0xffff0000u);
}
__device__ __forceinline__ v4u pack8(const float (&f)[8]) { v4u o; o.x = pk2(f[0], f[1]); o.y = pk2(f[2], f[3]); o.z = pk2(f[4], f[5]); o.w = pk2(f[6], f[7]); return o; }
__device__ __forceinline__ float wave_sum(float v) {
#pragma unroll
    for (int o = 1; o < 64; o <<= 1) v += __shfl_xor(v, o);
    return v;
}
__device__ __forceinline__ float silu_f(float a) { return a * __builtin_amdgcn_rcpf(1.0f + __expf(-a)); }

struct Args { const float* in[21]; float* out; unsigned char* ws; int ph_lo, ph_hi; };
enum { I_XP = 0, I_XS, I_SPOOL, I_SCONV, I_SFFN, I_CP, I_CS, I_WADA, I_BADA, I_GPREMIX, I_GPOSTMIX, I_GPREFFN, I_GPOSTFFN, I_WIN, I_POOLW, I_POOLS, I_CONVW, I_WOUT, I_WUP, I_FCONVW, I_WDN };

__device__ __forceinline__ const float* xrow(const Args& a, int m) { return m < MP ? a.in[I_XP] + (size_t)m * D : a.in[I_XS] + (size_t)(m - MP) * D; }
__device__ __forceinline__ int batch_of(int m) { return m < MP ? (m >> 11) : 8 + ((m - MP) >> 2); }

__device__ __forceinline__ void tr_item(const float* W, int ldw, int k0, int n0, bf16* WT, int ldt, int drow0, int dk0, LAS float* scr, int lane) {
    float tv[64];
#pragma unroll
    for (int i = 0; i < 64; ++i) tv[i] = W[(size_t)(k0 + i) * ldw + n0 + lane];
    __builtin_amdgcn_sched_barrier(0);
#pragma unroll
    for (int i = 0; i < 64; ++i) scr[i * 65 + lane] = tv[i];
    LDS_WAIT(); asm volatile("" ::: "memory");
    const int c = lane & 7;
#pragma unroll
    for (int j = 0; j < 8; ++j) { const int n = (lane >> 3) + 8 * j; const LAS float* sp = scr + (8 * c) * 65 + n;
        v4u o; o.x = pk2(sp[0 * 65], sp[1 * 65]); o.y = pk2(sp[2 * 65], sp[3 * 65]); o.z = pk2(sp[4 * 65], sp[5 * 65]); o.w = pk2(sp[6 * 65], sp[7 * 65]);
        *(v4u*)(WT + (size_t)(drow0 + n) * ldt + dk0 + 8 * c) = o; }
    LDS_WAIT(); asm volatile("" ::: "memory");
}

__device__ __forceinline__ void weight_items(const Args& a, LAS unsigned char* lds, int lane, int wave, int it0, int step, int cnt, int lim);
__device__ __forceinline__ void p0_prologue(const Args& a, LAS unsigned char* lds, int tid, int lane, int wave) {
    unsigned char* ws = a.ws;
    bf16* Win_t = (bf16*)(ws + WS_WIN); bf16* Wout_t = (bf16*)(ws + WS_WOUT); bf16* Wup_t = (bf16*)(ws + WS_WUP); bf16* Wdn_t = (bf16*)(ws + WS_WDN);
    float* mod = (float*)(ws + WS_MOD);
    const int G = gridDim.x, gw = blockIdx.x * NWAVES + wave, NGW = G * NWAVES;
    for (int i = blockIdx.x * 512 + tid; i < 16384; i += G * 512) ((unsigned*)(ws + WS_CTL))[i] = 0u;
    {
        LAS float* red = (LAS float*)lds;
        const int fr = lane & 15, fq = lane >> 4;
        for (int wi = blockIdx.x; wi < NMOD / 32; wi += G) {
            const int n0 = wi * 32, kb = wave * 128 + fq * 8;
            f32x4 acc[9][2];
#pragma unroll
            for (int rb = 0; rb < 9; ++rb) { acc[rb][0] = (f32x4){0.f, 0.f, 0.f, 0.f}; acc[rb][1] = acc[rb][0]; }
            LAS unsigned char* sa = lds + 32768 + wave * 12288;
            const int arow = lane >> 3, akk = (lane & 7) * 4;
            f32x2v wn[8];
#pragma unroll
            for (int i = 0; i < 8; ++i) wn[i] = *(const f32x2v*)(a.in[I_WADA] + (size_t)(kb + i) * NMOD + n0 + 2 * fr);
#pragma unroll 1
            for (int ks = 0; ks < 4; ++ks) {
                float wv[2][8];
#pragma unroll
                for (int i = 0; i < 8; ++i) { wv[0][i] = wn[i].x; wv[1][i] = wn[i].y; }
                { const int k1 = kb + (ks < 3 ? ks + 1 : 3) * 32;
#pragma unroll
                  for (int i = 0; i < 8; ++i) wn[i] = *(const f32x2v*)(a.in[I_WADA] + (size_t)(k1 + i) * NMOD + n0 + 2 * fr); }
                f32x4 cl[18];
#pragma unroll
                for (int j = 0; j < 18; ++j) { int row = 8 * j + arow; row = row < NBATCH ? row : NBATCH - 1;
                    cl[j] = *(const f32x4*)((row < 8 ? a.in[I_CP] + (size_t)row * D : a.in[I_CS] + (size_t)(row - 8) * D) + wave * 128 + ks * 32 + akk); }
                __builtin_amdgcn_sched_barrier(0);
#pragma unroll
                for (int j = 0; j < 18; ++j) { v2u w; w.x = pk2(silu_f(cl[j].x), silu_f(cl[j].y)); w.y = pk2(silu_f(cl[j].z), silu_f(cl[j].w));
                    *(LAS v2u*)(sa + (8 * j + arow) * 80 + akk * 2) = w; }
                const bf16x8 b0 = __builtin_bit_cast(bf16x8, pack8(wv[0])), b1 = __builtin_bit_cast(bf16x8, pack8(wv[1]));
                LDS_WAIT(); asm volatile("" ::: "memory");
#pragma unroll
                for (int rb = 0; rb < 9; ++rb) {
                    const bf16x8 af = *(const LAS bf16x8*)(sa + (rb * 16 + fr) * 80 + fq * 16);
                    acc[rb][0] = __builtin_amdgcn_mfma_f32_16x16x32_bf16(b0, af, acc[rb][0], 0, 0, 0);
                    acc[rb][1] = __builtin_amdgcn_mfma_f32_16x16x32_bf16(b1, af, acc[rb][1], 0, 0, 0);
                }
                LDS_WAIT(); asm volatile("" ::: "memory");
            }
            __syncthreads();
#pragma unroll
            for (int st = 4; st >= 1; st >>= 1) {
                LAS float* slot = (LAS float*)(lds + 32768) + (wave & (st - 1)) * (18 * 256);
                if (wave >= st && wave < 2 * st) {
#pragma unroll
                    for (int rb = 0; rb < 9; ++rb)
#pragma unroll
                        for (int cb = 0; cb < 2; ++cb)
#pragma unroll
                            for (int e = 0; e < 4; ++e) slot[((rb * 2 + cb) * 4 + e) * 64 + lane] = acc[rb][cb][e];
                }
                __syncthreads();
                if (wave < st) {
#pragma unroll
                    for (int rb = 0; rb < 9; ++rb)
#pragma unroll
                        for (int cb = 0; cb < 2; ++cb)
#pragma unroll
                            for (int e = 0; e < 4; ++e) acc[rb][cb][e] += slot[((rb * 2 + cb) * 4 + e) * 64 + lane];
                }
                __syncthreads();
            }
            if (wave == 0) {
#pragma unroll
                for (int rb = 0; rb < 9; ++rb) { const int row = rb * 16 + fr, col = n0 + 8 * fq;
                    const f32x4 lo = (f32x4){acc[rb][0][0], acc[rb][1][0], acc[rb][0][1], acc[rb][1][1]} + *(const f32x4*)(a.in[I_BADA] + col);
                    const f32x4 hi = (f32x4){acc[rb][0][2], acc[rb][1][2], acc[rb][0][3], acc[rb][1][3]} + *(const f32x4*)(a.in[I_BADA] + col + 4);
                    if (row < NBATCH) { *(f32x4*)(mod + (size_t)row * NMOD + col) = lo; *(f32x4*)(mod + (size_t)row * NMOD + col + 4) = hi; } }
            }
            __syncthreads();
        }
    }
    if (G == 256) { if (blockIdx.x >= 192) weight_items(a, lds, lane, wave, ((int)blockIdx.x - 192) * 8 + wave, 512, 6, 2688); }
    else weight_items(a, lds, lane, wave, gw, NGW, (4800 + NGW - 1) / NGW, 4800);
}

__device__ __forceinline__ void weight_items(const Args& a, LAS unsigned char* lds, int lane, int wave, int it0, int step, int cnt, int lim) {
    unsigned char* ws = a.ws;
    bf16* Win_t = (bf16*)(ws + WS_WIN); bf16* Wout_t = (bf16*)(ws + WS_WOUT); bf16* Wup_t = (bf16*)(ws + WS_WUP); bf16* Wdn_t = (bf16*)(ws + WS_WDN);
    LAS float* scr = (LAS float*)(lds + wave * 17408);
    constexpr int I_FOLD = 2048, I_IN = 16 * 32, I_OUT = 8 * 16, I_UP = 16 * 88;
        for (int ii = 0; ii < cnt; ++ii) {
            int r = it0 + ii * step; if (r >= lim) break;
            if (r < I_FOLD) {
                const int k0 = (r >> 6) * 16, n0 = (r & 63) * 16, gb = (k0 >> 7) * 128, rr = lane & 15, q = lane >> 4;
                f32x4 pw[8], ps[8]; float wo[32];
                const f32x4* pwp = (const f32x4*)(a.in[I_POOLW] + (size_t)(k0 + rr) * 128 + q * 32); const f32x4* psp = (const f32x4*)(a.in[I_POOLS] + gb + q * 32);
#pragma unroll
                for (int i = 0; i < 8; ++i) { pw[i] = pwp[i]; ps[i] = psp[i]; }
#pragma unroll
                for (int sidx = 0; sidx < 32; ++sidx) wo[sidx] = a.in[I_WOUT][(size_t)(gb + q * 32 + sidx) * D + n0 + rr];
                __builtin_amdgcn_sched_barrier(0);
                f32x4 acc = (f32x4){0.f, 0.f, 0.f, 0.f};
#pragma unroll
                for (int sidx = 0; sidx < 32; ++sidx) acc = __builtin_amdgcn_mfma_f32_16x16x4f32(pw[sidx >> 2][sidx & 3], ps[sidx >> 2][sidx & 3] * wo[sidx], acc, 0, 0, 0);
                v2u o; o.x = pk2(acc[0], acc[1]); o.y = pk2(acc[2], acc[3]);
                *(v2u*)(Wout_t + (size_t)(n0 + rr) * D + k0 + 4 * q) = o;
                continue;
            } r -= I_FOLD;
            if (r < I_IN) { const int kb = r / 32, nb = r % 32, n0 = 64 * nb;
                const int jx = (n0 - 512) & 511, drow0 = n0 < 512 ? n0 : (n0 < 1024 ? 1024 + (jx >> 7) * 256 + (jx & 127) : (n0 < 1536 ? n0 - 512 : 1024 + (((n0 - 1536) >> 7) * 256) + 128 + ((n0 - 1536) & 127)));
                tr_item(a.in[I_WIN], DIN, 64 * kb, n0, Win_t, D, drow0, 64 * kb, scr, lane); continue; } r -= I_IN;
            if (r < I_OUT) { const int kb = r / 16, nb = r % 16; tr_item(a.in[I_WOUT] + (size_t)512 * D, D, 64 * kb, 64 * nb, Wout_t, D, 64 * nb, 512 + 64 * kb, scr, lane); continue; } r -= I_OUT;
            if (r < I_UP) { const int kb = r / 88, nb = r % 88, n0 = 64 * nb;
                const int drow0 = n0 < DFF ? (n0 / 128) * 256 + (n0 % 128) : ((n0 - DFF) / 128) * 256 + 128 + ((n0 - DFF) % 128);
                tr_item(a.in[I_WUP], DUP, 64 * kb, n0, Wup_t, D, drow0, 64 * kb, scr, lane); continue; } r -= I_UP;
            { const int kb = r / 16, nb = r % 16; tr_item(a.in[I_WDN], D, 64 * kb, 64 * nb, Wdn_t, DFF, 64 * nb, 64 * kb, scr, lane); }
        }
}

__device__ __forceinline__ void p1_norm(const Args& a, int lane, int wave) {
    bf16* H = (bf16*)(a.ws + WS_H); const float* mod = (const float*)(a.ws + WS_MOD);
    const int gw = blockIdx.x * NWAVES + wave, NGW = gridDim.x * NWAVES;
    for (int mb = gw; mb < M; mb += 4 * NGW) {
        f32x4 v[4][4];
#pragma unroll
        for (int r = 0; r < 4; ++r) { const int m = mb + r * NGW; const float* xr = xrow(a, m < M ? m : mb);
#pragma unroll
            for (int j = 0; j < 4; ++j) v[r][j] = *(const f32x4*)(xr + 4 * lane + 256 * j); }
        __builtin_amdgcn_sched_barrier(0);
#pragma unroll
        for (int r = 0; r < 4; ++r) {
            const int m = mb + r * NGW; if (m >= M) break;
            const float* md = mod + (size_t)batch_of(m) * NMOD;
            float ss = 0.f;
#pragma unroll
            for (int j = 0; j < 4; ++j) ss += (v[r][j].x * v[r][j].x + v[r][j].y * v[r][j].y) + (v[r][j].z * v[r][j].z + v[r][j].w * v[r][j].w);
            const float rstd = 1.0f / sqrtf(wave_sum(ss) * (1.0f / D) + EPS);
#pragma unroll
            for (int j = 0; j < 4; ++j) { const int col = 4 * lane + 256 * j;
                const f32x4 g = *(const f32x4*)(a.in[I_GPREMIX] + col), sc = *(const f32x4*)(md + 1024 + col), sh = *(const f32x4*)(md + col);
                const f32x4 o = v[r][j] * rstd * g * (1.0f + sc) + sh;
                v2u w; w.x = pk2(o.x, o.y); w.y = pk2(o.z, o.w); *(v2u*)(H + (size_t)m * D + col) = w; }
        }
    }
}

__device__ __forceinline__ void ldpart8(const float* part, size_t sstride, int nsl, size_t off, float (&v)[8]) {
    f32x4 a = (f32x4){0.f, 0.f, 0.f, 0.f}, b = a;
    for (int sl = 0; sl < nsl; ++sl) { a += *(const f32x4*)(part + sl * sstride + off); b += *(const f32x4*)(part + sl * sstride + off + 4); }
    v[0] = a.x; v[1] = a.y; v[2] = a.z; v[3] = a.w; v[4] = b.x; v[5] = b.y; v[6] = b.z; v[7] = b.w;
}
__device__ __forceinline__ void st8(float* o, const float (&v)[8]) { *(f32x4*)o = (f32x4){v[0], v[1], v[2], v[3]}; *(f32x4*)(o + 4) = (f32x4){v[4], v[5], v[6], v[7]}; }
__device__ __forceinline__ void ld8(const float* p, float (&v)[8]) { const f32x4 a = *(const f32x4*)p, b = *(const f32x4*)(p + 4); v[0] = a.x; v[1] = a.y; v[2] = a.z; v[3] = a.w; v[4] = b.x; v[5] = b.y; v[6] = b.z; v[7] = b.w; }
template <int W>
__device__ __forceinline__ void pool_pair(const bf16* PROJ, bf16* DY, float* npp, const int (&rows)[2], int j0, bool hasB) {
    v4u cv[2], hv[2][W - 1];
#pragma unroll
    for (int r = 0; r < 2; ++r) { const int t = rows[r] & 2047; const bf16* pr = PROJ + (size_t)rows[r] * PP + j0; cv[r] = *(const v4u*)pr;
#pragma unroll
        for (int i = 1; i < W; ++i) hv[r][i - 1] = *(const v4u*)(pr - (size_t)(i <= t ? i : 0) * PP); }
    __builtin_amdgcn_sched_barrier(0);
#pragma unroll
    for (int r = 0; r < 2; ++r) { if (r == 1 && !hasB) break;
        const int m = rows[r], b = m >> 11, t = m & 2047; float cur[8], s[8];
        unpack8(cv[r], cur);
#pragma unroll
        for (int e = 0; e < 8; ++e) s[e] = cur[e];
#pragma unroll
        for (int i = 1; i < W; ++i) { float tmp[8]; unpack8(hv[r][i - 1], tmp);
#pragma unroll
            for (int e = 0; e < 8; ++e) s[e] += (i <= t) ? tmp[e] : 0.f; }
        const float inv = 1.0f / (float)((t + 1) < W ? (t + 1) : W); float d[8];
        if (t >= 2033) st8(npp + (size_t)(b * 15 + (t - 2033)) * 512 + j0, cur);
#pragma unroll
        for (int e = 0; e < 8; ++e) d[e] = s[e] * inv - cur[e];
        *(v4u*)(DY + (size_t)m * D + j0) = pack8(d); }
}
template <int W>
__device__ __forceinline__ void pool_adj(const bf16* PROJ, bf16* DY, float* npp, int r0, int j0) {
    const int r3 = r0 + 3, t3 = r3 & 2047, b = r3 >> 11;
    const bf16* p3 = PROJ + (size_t)r3 * PP + j0;
    v4u hv[W + 3];
#pragma unroll
    for (int k = 0; k < W + 3; ++k) hv[k] = *(const v4u*)(p3 - (size_t)(k <= t3 ? k : 0) * PP);
    __builtin_amdgcn_sched_barrier(0);
    float v[W + 3][8];
#pragma unroll
    for (int k = 0; k < W + 3; ++k) { float tmp[8]; unpack8(hv[k], tmp);
#pragma unroll
        for (int e = 0; e < 8; ++e) v[k][e] = (k <= t3) ? tmp[e] : 0.f; }
    float sw[8];
#pragma unroll
    for (int e = 0; e < 8; ++e) { float acc = v[0][e];
#pragma unroll
        for (int k = 1; k < W; ++k) acc += v[k][e];
        sw[e] = acc; }
#pragma unroll
    for (int j = 3; j >= 0; --j) {
        const int tj = t3 - (3 - j); const float inv = 1.0f / (float)((tj + 1) < W ? (tj + 1) : W); float d[8];
#pragma unroll
        for (int e = 0; e < 8; ++e) d[e] = sw[e] * inv - v[3 - j][e];
        if (tj >= 2033) st8(npp + (size_t)(b * 15 + (tj - 2033)) * 512 + j0, v[3 - j]);
        *(v4u*)(DY + (size_t)(r0 + j) * D + j0) = pack8(d);
        if (j > 0) {
#pragma unroll
            for (int e = 0; e < 8; ++e) sw[e] += v[3 - j + W][e] - v[3 - j][e]; }
    }
}
__device__ __forceinline__ void p3_mixer(const Args& a, int tid) {
    const bf16* PROJ = (const bf16*)(a.ws + WS_PROJ); bf16* DY = (bf16*)(a.ws + WS_DY);
    const float* PART = (const float*)(a.ws + WS_PART); constexpr size_t PS = (size_t)MS * DIN;
    float* npp = a.out + O_NPP; float* ncp = a.out + O_NCP; float* nps = a.out + O_NPS; float* ncs = a.out + O_NCS;
    const long NT = (long)gridDim.x * 512;
    const int lane_ = tid & 63, gwv = blockIdx.x * NWAVES + (tid >> 6), NGWV = gridDim.x * NWAVES;
    for (int pw = gwv; pw < MP / 4; pw += NGWV) {
        const int g = pw & 3, r0 = (pw >> 2) * 16 + 4 * (lane_ >> 4), j0 = g * 128 + (lane_ & 15) * 8;
        if (g == 0) pool_adj<2>(PROJ, DY, npp, r0, j0);
        else if (g == 1) pool_adj<4>(PROJ, DY, npp, r0, j0);
        else if (g == 2) pool_adj<8>(PROJ, DY, npp, r0, j0);
        else pool_adj<16>(PROJ, DY, npp, r0, j0);
    }
    for (int cwi = gwv; cwi < MP / 2; cwi += NGWV) {
        const int m0 = 2 * cwi, m1 = m0 + 1, t1 = m1 & 2047, b = m1 >> 11, j0 = 8 * lane_;
        const bf16* p1 = PROJ + (size_t)m1 * PP + j0;
        const v4u rb1 = *(const v4u*)(p1 + 512), rb0 = *(const v4u*)(p1 - PP + 512);
        v4u rcx[4];
#pragma unroll
        for (int k = 0; k < 4; ++k) rcx[k] = *(const v4u*)(p1 - (size_t)(k <= t1 ? k : 0) * PP + 1024);
        const float* cwp = a.in[I_CONVW] + j0; float w0[8], w1[8], w2[8];
        ld8(cwp, w0); ld8(cwp + 512, w1); ld8(cwp + 1024, w2);
        __builtin_amdgcn_sched_barrier(0);
        float c[4][8], b0[8], b1[8], y0[8], y1[8];
        unpack8(rb0, b0); unpack8(rb1, b1);
#pragma unroll
        for (int k = 0; k < 4; ++k) { float tmp[8]; unpack8(rcx[k], tmp);
#pragma unroll
            for (int e = 0; e < 8; ++e) c[k][e] = (k <= t1) ? tmp[e] : 0.f; }
#pragma unroll
        for (int e = 0; e < 8; ++e) { y1[e] = b1[e] * (w0[e] * c[2][e] + w1[e] * c[1][e] + w2[e] * c[0][e]); y0[e] = b0[e] * (w0[e] * c[3][e] + w1[e] * c[2][e] + w2[e] * c[1][e]); }
        *(v4u*)(DY + (size_t)m0 * D + 512 + j0) = pack8(y0);
        *(v4u*)(DY + (size_t)m1 * D + 512 + j0) = pack8(y1);
        if (t1 == 2047) { st8(ncp + (size_t)(b * 2 + 0) * 512 + j0, c[1]); st8(ncp + (size_t)(b * 2 + 1) * 512 + j0, c[0]); }
    }
    for (long it = (long)MP * 128 + (long)blockIdx.x * 512 + tid; it < (long)M * 128; it += NT) {
        const int m = (int)(it >> 7), q = (int)(it & 127);
        {
            const int sr = m - MP, b = sr >> 2, t = sr & 3;
            if (q < 64) {
                const int j0 = 8 * q, w = 2 << (j0 >> 7);
                float cur[8], s[8];
                ldpart8(PART, PS, 4, (size_t)sr * DIN + j0, cur);
#pragma unroll
                for (int e = 0; e < 8; ++e) s[e] = cur[e];
                for (int i = 1; i < w; ++i) { float tmp[8];
                    if (t - i >= 0) ldpart8(PART, PS, 4, (size_t)(sr - i) * DIN + j0, tmp); else ld8(a.in[I_SPOOL] + (size_t)(b * 15 + 15 + t - i) * 512 + j0, tmp);
#pragma unroll
                    for (int e = 0; e < 8; ++e) s[e] += tmp[e]; }
                st8(nps + (size_t)(b * 15 + 11 + t) * 512 + j0, cur);
                for (int i = t; i < 11; i += 4) { float tmp[8]; ld8(a.in[I_SPOOL] + (size_t)(b * 15 + i + 4) * 512 + j0, tmp); st8(nps + (size_t)(b * 15 + i) * 512 + j0, tmp); }
                const float inv = 1.0f / (float)w; float d[8];
#pragma unroll
                for (int e = 0; e < 8; ++e) d[e] = s[e] * inv - cur[e];
                *(v4u*)(DY + (size_t)m * D + j0) = pack8(d);
            } else {
                const int j0 = 8 * (q - 64);
                float xv[8], bv[8], cv[8], cx[3][8];
                const int xcol = 1024 + (j0 >> 7) * 256 + (j0 & 127);
                ldpart8(PART, PS, 4, (size_t)sr * DIN + 512 + j0, bv);
#pragma unroll
                for (int k = 0; k < 3; ++k) {
                    if (t - k >= 0) { ldpart8(PART, PS, 4, (size_t)(sr - k) * DIN + xcol, xv); ldpart8(PART, PS, 4, (size_t)(sr - k) * DIN + xcol + 128, cv);
#pragma unroll
                        for (int e = 0; e < 8; ++e) cx[k][e] = cv[e] * xv[e]; }
                    else ld8(a.in[I_SCONV] + (size_t)(b * 2 + 2 + t - k) * 512 + j0, cx[k]);
                }
                const float* cwp = a.in[I_CONVW] + j0; float w0[8], w1[8], w2[8], y[8];
                ld8(cwp, w0); ld8(cwp + 512, w1); ld8(cwp + 1024, w2);
#pragma unroll
                for (int e = 0; e < 8; ++e) y[e] = bv[e] * (w0[e] * cx[2][e] + w1[e] * cx[1][e] + w2[e] * cx[0][e]);
                *(v4u*)(DY + (size_t)m * D + 512 + j0) = pack8(y);
                if (t >= 2) st8(ncs + (size_t)(b * 2 + t - 2) * 512 + j0, cx[0]);
            }
        }
    }
}

__device__ __forceinline__ void p5_rowwise1(const Args& a, int lane, int wave, unsigned* done_cnt) {
    const float* MIX = (const float*)(a.ws + WS_MIX); bf16* H = (bf16*)(a.ws + WS_H); const float* mod = (const float*)(a.ws + WS_MOD); float* Y = a.out + O_Y;
    const int gw = blockIdx.x * NWAVES + wave, NGW = gridDim.x * NWAVES;
    int m0 = MP + gw, mstep = NGW;
    if (gridDim.x == 256) { m0 = blockIdx.x >= 192 ? MP + ((int)blockIdx.x - 192) * NWAVES + wave : M; mstep = M; }
    for (int m = m0; m < M; m += mstep) {
        const float* xr = xrow(a, m); const float* md = mod + (size_t)batch_of(m) * NMOD; const float* mr = (const float*)(a.ws + WS_PART) + (size_t)(m - MP) * D;
        f32x4 v[4]; float ss = 0.f;
#pragma unroll
        for (int j = 0; j < 4; ++j) { v[j] = (*(const f32x4*)(mr + 4 * lane + 256 * j) + *(const f32x4*)(mr + (size_t)MS * D + 4 * lane + 256 * j)) + (*(const f32x4*)(mr + 2 * (size_t)MS * D + 4 * lane + 256 * j) + *(const f32x4*)(mr + 3 * (size_t)MS * D + 4 * lane + 256 * j)); ss += (v[j].x * v[j].x + v[j].y * v[j].y) + (v[j].z * v[j].z + v[j].w * v[j].w); }
        const float r1 = 1.0f / sqrtf(wave_sum(ss) * (1.0f / D) + EPS);
        float s2 = 0.f;
#pragma unroll
        for (int j = 0; j < 4; ++j) { const int col = 4 * lane + 256 * j;
            const f32x4 x = *(const f32x4*)(xr + col), g = *(const f32x4*)(a.in[I_GPOSTMIX] + col), gt = *(const f32x4*)(md + 2048 + col);
            v[j] = x + gt * (v[j] * r1 * g);
            *(f32x4*)(Y + (size_t)m * D + col) = v[j];
            s2 += (v[j].x * v[j].x + v[j].y * v[j].y) + (v[j].z * v[j].z + v[j].w * v[j].w); }
        const float r2 = 1.0f / sqrtf(wave_sum(s2) * (1.0f / D) + EPS);
#pragma unroll
        for (int j = 0; j < 4; ++j) { const int col = 4 * lane + 256 * j;
            const f32x4 g = *(const f32x4*)(a.in[I_GPREFFN] + col), sc = *(const f32x4*)(md + 4096 + col), sh = *(const f32x4*)(md + 3072 + col);
            const f32x4 o = v[j] * r2 * g * (1.0f + sc) + sh;
            v2u w; w.x = pk2(o.x, o.y); w.y = pk2(o.z, o.w); *(v2u*)(H + (size_t)m * D + col) = w; }
        __threadfence();
        if (lane == 0) __hip_atomic_fetch_add(done_cnt, 1u, __ATOMIC_RELAXED, __HIP_MEMORY_SCOPE_AGENT);
    }
}

__device__ __forceinline__ void fixup_tile(const Args& a, int pm, int tid) {
    if ((pm & 7) == 0 || pm >= 64) return;
    const float* edge = (const float*)(a.ws + WS_EDGE); bf16* Gb = (bf16*)(a.ws + WS_G); const float* cw = a.in[I_FCONVW];
    for (int idx = tid; idx < DFF; idx += 512) {
        const int pn = idx >> 7, rho = idx & 127;
        const float* et = edge + (size_t)(pm * 22 + pn) * 1024; const float* eb = edge + (size_t)((pm - 1) * 22 + pn) * 1024 + 512;
        float u0[2], u1[2];
#pragma unroll
        for (int h = 0; h < 2; ++h) { const int tc = rho + 128 * h, c = h * DFF + idx;
            const float pb0 = eb[tc], pb1 = eb[256 + tc], t0 = et[tc], t1 = et[256 + tc];
            const float w0 = cw[c], w1 = cw[DUP + c], w2 = cw[2 * DUP + c];
            u0[h] = w0 * pb0 + w1 * pb1 + w2 * t0; u1[h] = w0 * pb1 + w1 * t0 + w2 * t1; }
        Gb[(size_t)(pm * 256) * DFF + idx] = (bf16)f2bf(silu_f(u0[0]) * u0[1]);
        Gb[(size_t)(pm * 256 + 1) * DFF + idx] = (bf16)f2bf(silu_f(u1[0]) * u1[1]);
    }
}

__device__ __forceinline__ void p9_rows(const Args& a, int lane, int m0, int m1, int mstep) {
    const float* Fb = (const float*)(a.ws + WS_F); const float* mod = (const float*)(a.ws + WS_MOD); float* Y = a.out + O_Y;
    for (int m = m0; m < m1; m += mstep) {
        const float* md = mod + (size_t)batch_of(m) * NMOD; const float* fr = (const float*)(a.ws + WS_PART) + (size_t)(m - MP) * D;
        f32x4 v[4]; float ss = 0.f;
#pragma unroll
        for (int j = 0; j < 4; ++j) { v[j] = *(const f32x4*)(fr + 4 * lane + 256 * j);
#pragma unroll
            for (int sl = 1; sl < 11; ++sl) v[j] += *(const f32x4*)(fr + sl * (size_t)MS * D + 4 * lane + 256 * j); ss += (v[j].x * v[j].x + v[j].y * v[j].y) + (v[j].z * v[j].z + v[j].w * v[j].w); }
        const float r1 = 1.0f / sqrtf(wave_sum(ss) * (1.0f / D) + EPS);
#pragma unroll
        for (int j = 0; j < 4; ++j) { const int col = 4 * lane + 256 * j;
            const f32x4 x = *(const f32x4*)(Y + (size_t)m * D + col), g = *(const f32x4*)(a.in[I_GPOSTFFN] + col), gt = *(const f32x4*)(md + 5120 + col);
            *(f32x4*)(Y + (size_t)m * D + col) = x + gt * (v[j] * r1 * g); }
    }
}

template <int NI, int NJ, int U>
__device__ __forceinline__ void sgemm_block(f32x4 (&acc)[NI][NJ], const bf16* ap, const bf16* bp, int K) {
    bf16x8 af[U][NI], bfr[U][NJ];
#pragma unroll
    for (int u = 0; u < U; ++u) {
#pragma unroll
        for (int i = 0; i < NI; ++i) af[u][i] = *(const bf16x8*)(ap + (size_t)i * 16 * K + u * 32);
#pragma unroll
        for (int j = 0; j < NJ; ++j) bfr[u][j] = *(const bf16x8*)(bp + (size_t)j * 16 * K + u * 32);
    }
    __builtin_amdgcn_sched_barrier(0);
#pragma unroll
    for (int u = 0; u < U; ++u)
#pragma unroll
        for (int i = 0; i < NI; ++i)
#pragma unroll
            for (int j = 0; j < NJ; ++j) acc[i][j] = __builtin_amdgcn_mfma_f32_16x16x32_bf16(bfr[u][j], af[u][i], acc[i][j], 0, 0, 0);
    __builtin_amdgcn_sched_barrier(0);
}
template <int NI, int NJ, int U, int NKS, class Epi>
__device__ __forceinline__ void sgemm_tile(const bf16* A, const bf16* Bt, int K, LAS unsigned char* lds, int tid, int lane, int wave, const Epi& epi) {
    LAS float* red = (LAS float*)lds;
    for (int i = tid; i < NI * NJ * 256; i += 512) red[i] = 0.f;
    __syncthreads();
    const int fr = lane & 15, fq = lane >> 4, kw = K / 8;
    const bf16* ap = A + (size_t)fr * K + wave * kw + fq * 8; const bf16* bp = Bt + (size_t)fr * K + wave * kw + fq * 8;
    f32x4 acc[NI][NJ];
#pragma unroll
    for (int i = 0; i < NI; ++i)
#pragma unroll
        for (int j = 0; j < NJ; ++j) acc[i][j] = (f32x4){0.f, 0.f, 0.f, 0.f};
#pragma unroll 1
    for (int ks = 0; ks + U <= NKS; ks += U) sgemm_block<NI, NJ, U>(acc, ap + ks * 32, bp + ks * 32, K);
    if constexpr (NKS % U != 0) sgemm_block<NI, NJ, NKS % U>(acc, ap + (NKS - NKS % U) * 32, bp + (NKS - NKS % U) * 32, K);
#pragma unroll
    for (int i = 0; i < NI; ++i)
#pragma unroll
        for (int j = 0; j < NJ; ++j)
#pragma unroll
            for (int e = 0; e < 4; ++e) __hip_atomic_fetch_add(red + ((i * NJ + j) * 4 + e) * 64 + lane, acc[i][j][e], __ATOMIC_RELAXED, __HIP_MEMORY_SCOPE_WORKGROUP);
    __syncthreads();
    for (int blk = wave; blk < NI * NJ; blk += 8) { const int i = blk / NJ, j = blk % NJ; const LAS float* rp = red + blk * 256 + lane; epi(i * 16 + fr, j * 16 + 4 * fq, (f32x4){rp[0], rp[64], rp[128], rp[192]}); }
    __syncthreads();
}

#define XB_TMO      128
#define XB_XCNT(j)  (256  + 64 * (j))
#define XB_XSUB(j)  (1280 + 64 * (j))
#define XB_XGEN(j)  (2304 + 64 * (j))
#define XB_TOP      3328
#define XB_TOPGEN   3392
#define XCD_BAR_WORDS 3456
#define XB_SPIN_CAP (1u << 18)

__device__ __forceinline__ unsigned xb_ld(unsigned* p)              { return __hip_atomic_load(p, __ATOMIC_RELAXED, __HIP_MEMORY_SCOPE_AGENT); }
__device__ __forceinline__ unsigned xb_add(unsigned* p, unsigned v) { return __hip_atomic_fetch_add(p, v, __ATOMIC_RELAXED, __HIP_MEMORY_SCOPE_AGENT); }
__device__ __forceinline__ unsigned xb_xcc_id() { return (unsigned)__builtin_amdgcn_s_getreg((3 << 11) | 20) & 0xFu; }
#define XB_SPIN(cond, bar) do { unsigned _sp = 0; while (cond) { __builtin_amdgcn_s_sleep(1); \
    if ((++_sp & 255u) == 0u) { if (xb_ld(&(bar)[XB_TMO])) break; if (_sp > XB_SPIN_CAP) { atomicAdd(&(bar)[XB_TMO], 1u); break; } } } } while (0)

struct XcdBarrier {
    unsigned* bar; unsigned x;
    volatile LAS unsigned* st;
};

__device__ __forceinline__ XcdBarrier xcd_barrier_post(unsigned* bar, volatile LAS unsigned* st) {
    XcdBarrier b; b.bar = bar; b.x = xb_xcc_id(); b.st = st;
    if (threadIdx.x == 0) (void)xb_add(&bar[XB_XCNT(b.x)], 1u);
    return b;
}
__device__ __forceinline__ void xcd_barrier_complete(unsigned* bar, unsigned x, unsigned& nloc, unsigned& nx) {
    const unsigned G = gridDim.x * gridDim.y * gridDim.z;
    unsigned sum, cnt, mine, sp = 0u;
    for (;;) {
        sum = 0u; cnt = 0u; mine = 0u;
#pragma unroll
        for (unsigned j = 0; j < 16; ++j) { const unsigned c = xb_ld(&bar[XB_XCNT(j)]); sum += c; cnt += (c > 0u) ? 1u : 0u; mine = (j == x) ? c : mine; }
        if (sum == G) break;
        __builtin_amdgcn_s_sleep(1);
        if ((++sp & 255u) == 0u) { if (xb_ld(&bar[XB_TMO])) break; if (sp > XB_SPIN_CAP) { atomicAdd(&bar[XB_TMO], 1u); break; } }
    }
    nloc = mine > 0u ? mine : 1u; nx = cnt > 0u ? cnt : 1u;
}

__device__ __forceinline__ void xcd_barrier(const XcdBarrier& b) {
    asm volatile("s_waitcnt vmcnt(0)" ::: "memory");
    __syncthreads();
    if (threadIdx.x == 0) {
        unsigned* bar = b.bar;
        __builtin_amdgcn_s_waitcnt(0);
        unsigned nloc = b.st[0], nx = b.st[1];
        if (nloc == 0u) { xcd_barrier_complete(bar, b.x, nloc, nx); b.st[0] = nloc; b.st[1] = nx; }
        const unsigned old = xb_add(&bar[XB_XSUB(b.x)], 1u);
        const unsigned gen = old / nloc;
        if (old + 1u == (gen + 1u) * nloc) {
            __builtin_amdgcn_fence(__ATOMIC_RELEASE, "agent");
            asm volatile("s_waitcnt vmcnt(0)" ::: "memory");
            const unsigned og = xb_add(&bar[XB_TOP], 1u);
            const unsigned tg = og / nx;
            if (og + 1u == (tg + 1u) * nx) xb_add(&bar[XB_TOPGEN], 1u);
            else XB_SPIN(xb_ld(&bar[XB_TOPGEN]) == tg, bar);
            __builtin_amdgcn_fence(__ATOMIC_ACQUIRE, "agent");
            xb_add(&bar[XB_XGEN(b.x)], 1u);
            asm volatile("s_waitcnt vmcnt(0)" ::: "memory");
        } else {
            XB_SPIN(xb_ld(&bar[XB_XGEN(b.x)]) == gen, bar);
            __builtin_amdgcn_fence(__ATOMIC_ACQUIRE, "agent");
            asm volatile("s_waitcnt vmcnt(0)" ::: "memory");
        }
    }
    __syncthreads();
}

__global__ void __launch_bounds__(NWAVES * 64, 2) fwd_mk(Args args) {
    extern __shared__ __attribute__((aligned(16))) unsigned char lds_raw[];
    LAS unsigned char* lds = (LAS unsigned char*)lds_raw;
    const int tid = threadIdx.x, lane = tid & 63, wave = __builtin_amdgcn_readfirstlane(tid >> 6);
    const int lo = args.ph_lo, hi = args.ph_hi, G = gridDim.x;
    unsigned char* ws = args.ws;
#define IN(k) (lo <= (k) && (k) < hi)
#define REP(k) for (int rep_ = 0; rep_ <= ((REPMASK >> (k)) & 1); ++rep_)
#define SEAM(k) do { if (IN(k) && IN((k) + 1)) xcd_barrier(bar); } while (0)
    volatile LAS unsigned* MISC = (volatile LAS unsigned*)(lds + EB_OFF + 12288);
    if (tid < 2) MISC[tid] = 0u;
    __syncthreads();
    XcdBarrier bar; bar.bar = (unsigned*)(ws + WS_CTL) + 16384; bar.x = 0; bar.st = MISC;
    if (hi - lo > 1) bar = xcd_barrier_post((unsigned*)(ws + WS_CTL) + 16384, MISC);
    if (lo < -1) cg::this_grid().sync();
    if (IN(0)) { p0_prologue(args, lds, tid, lane, wave); } SEAM(0);
    if (IN(1)) { p1_norm(args, lane, wave); } SEAM(1);
    if (IN(2)) {
        pg8::Gemm g{(const bf16*)(ws + WS_H), (const bf16*)(ws + WS_WIN), MP, DIN, D}; pg8::StaticOrder S; S.init(MP, DIN, G, (int)blockIdx.x);
        pg8::EpiProj E{(bf16*)(ws + WS_PROJ)};
        pg8::gemm_phase<pg8::EpiProj, pg8::StaticOrder, true, true>(lds, g, S, E);
        { pg8::Gemm gs{(const bf16*)(ws + WS_H), (const bf16*)(ws + WS_WIN), M, DIN, 256, D}; pg8::SliceOrder Ss{DIN / 256, 4, (int)blockIdx.x};
          pg8::EpiF32Part Es{(float*)(ws + WS_PART), DIN, (size_t)MS * DIN};
          pg8::gemm_phase<pg8::EpiF32Part, pg8::SliceOrder, true, true>(lds, gs, Ss, Es); }
        if (G == 256 && blockIdx.x >= 64) weight_items(args, lds, lane, wave, 2688 + ((int)blockIdx.x - 64) * 8 + wave, 1536, 1, 4096);
    } SEAM(2);
    if (IN(3)) { p3_mixer(args, tid); } SEAM(3);
    if (IN(4)) {
        { pg8::Gemm g{(const bf16*)(ws + WS_DY), (const bf16*)(ws + WS_WOUT), MP, D, D}; pg8::StaticOrder S; S.init(MP, D, G, (int)blockIdx.x);
          unsigned* ctl = (unsigned*)(ws + WS_CTL); unsigned* xb = (unsigned*)(ws + WS_XB);
          pg8::PanelRms st1{xb, ctl, EPS}, st2{xb + 65536, ctl + CNT_BANK_WORDS, EPS};
          pg8::EpiMixNorm E{args.in[I_XP], (bf16*)(ws + WS_X1), (bf16*)(ws + WS_H), (const float*)(ws + WS_MOD), args.in[I_GPOSTMIX], args.in[I_GPREFFN], st1, st2};
          if (G == 256) pg8::gemm_phase<pg8::EpiMixNorm, pg8::StaticOrder, false, true>(lds, g, S, E); }
        __syncthreads();
        { pg8::Gemm gs{(const bf16*)(ws + WS_DY), (const bf16*)(ws + WS_WOUT), M, D, 256, D}; pg8::SliceOrder Ss{D / 256, 4, (int)blockIdx.x};
          pg8::EpiF32Part Es{(float*)(ws + WS_PART), D, (size_t)MS * D};
          pg8::gemm_phase<pg8::EpiF32Part, pg8::SliceOrder, true, true>(lds, gs, Ss, Es); }
        if (G == 256 && blockIdx.x >= 32) weight_items(args, lds, lane, wave, 4096 + ((int)blockIdx.x - 32) * 8 + wave, 1792, 1, 4800);
    } SEAM(4);
    if (IN(6)) {
        unsigned* cnt5 = (unsigned*)(ws + WS_CTL) + 3 * CNT_BANK_WORDS + 64;
        p5_rowwise1(args, lane, wave, cnt5);
        pg8::Gemm g{(const bf16*)(ws + WS_H), (const bf16*)(ws + WS_WUP), M, DUP, D}; pg8::UpOrder S; S.init(MP, DUP, G, (int)blockIdx.x); S.ready = cnt5; S.need = MS;
        pg8::EpiUpGate E{(bf16*)(ws + WS_G), args.in[I_FCONVW], args.in[I_SFFN], args.out + O_NFP, args.out + O_NFS, (float*)(ws + WS_EDGE), (LAS float*)(lds + EB_OFF)};
        pg8::gemm_phase<pg8::EpiUpGate, pg8::UpOrder, true, true>(lds, g, S, E);
    }
    if (IN(7)) {
        unsigned* cnt5 = (unsigned*)(ws + WS_CTL) + 3 * CNT_BANK_WORDS + 64;
        if (G == 256 && blockIdx.x >= 172) {
            if (wave == 0) { unsigned spins = 0;
                while ((unsigned)__builtin_amdgcn_readfirstlane(__hip_atomic_load(cnt5 + 256, __ATOMIC_RELAXED, __HIP_MEMORY_SCOPE_AGENT)) < 2u * (DUP / 256) * NWAVES) { if (++spins > (1u << 22)) break; __builtin_amdgcn_s_sleep(2); }
                __builtin_amdgcn_fence(__ATOMIC_ACQUIRE, "agent"); asm volatile("s_waitcnt vmcnt(0)" ::: "memory"); }
            __syncthreads();
            pg8::Gemm gs{(const bf16*)(ws + WS_G), (const bf16*)(ws + WS_WDN), M, D, 256, DFF}; pg8::SliceOrder Ss{D / 256, 11, (int)blockIdx.x - 172, 84};
            pg8::EpiF32Part Es{(float*)(ws + WS_PART), D, (size_t)MS * D};
            pg8::gemm_phase<pg8::EpiF32Part, pg8::SliceOrder, true, true>(lds, gs, Ss, Es);
        }
    } if (IN(6) && IN(7)) xcd_barrier(bar);
    if (IN(8)) {
        { pg8::Gemm g{(const bf16*)(ws + WS_G), (const bf16*)(ws + WS_WDN), MP, D, DFF}; pg8::StaticOrder S; S.init(MP, D, G, (int)blockIdx.x);
          { pg8::Unit u; for (int i = 0; S.next(i, u); ++i) fixup_tile(args, u.pm, tid); asm volatile("s_waitcnt vmcnt(0)" ::: "memory"); __syncthreads(); }
          pg8::PanelRms st{(unsigned*)(ws + WS_XB) + 131072, (unsigned*)(ws + WS_CTL) + 2 * CNT_BANK_WORDS, EPS};
          pg8::EpiFfnNorm E{(const bf16*)(ws + WS_X1), args.out + O_Y, (const float*)(ws + WS_MOD), args.in[I_GPOSTFFN], st};
          if (G == 256) pg8::gemm_phase<pg8::EpiFfnNorm, pg8::StaticOrder, false, true>(lds, g, S, E); }
        __syncthreads();
        { const int gw = blockIdx.x * NWAVES + wave; p9_rows(args, lane, MP + gw, M, G * NWAVES); }
    }
#undef IN
#undef SEAM
}

extern "C" void kernel_launch(void* const* d_in, const int* in_sizes, int n_in, void* d_out, int out_size, void* d_ws, size_t ws_size, hipStream_t stream) {
    static int grid = 0;
    if (grid == 0) {
        if (n_in != 21 || out_size != (int)O_END || ws_size < WS_END) { fprintf(stderr, "kernel_launch: unexpected shapes (n_in %d out %d ws %zu)\n", n_in, out_size, ws_size); grid = -1; return; }
        int dev = 0, cus = 0, per_cu = 0;
        hipGetDevice(&dev); hipDeviceGetAttribute(&cus, hipDeviceAttributeMultiprocessorCount, dev);
        if (hipFuncSetAttribute((const void*)fwd_mk, hipFuncAttributeMaxDynamicSharedMemorySize, LDS_BYTES) != hipSuccess) { fprintf(stderr, "kernel_launch: hipFuncSetAttribute failed\n"); grid = -1; return; }
        if (hipOccupancyMaxActiveBlocksPerMultiprocessor(&per_cu, (const void*)fwd_mk, NWAVES * 64, LDS_BYTES) != hipSuccess || per_cu < 1) { fprintf(stderr, "kernel_launch: occupancy query says %d\n", per_cu); per_cu = 1; }
        (void)hipGetLastError();
        grid = cus > 0 ? cus : 256;
    }
    if (grid < 0) return;
    if (hipMemsetAsync((char*)d_ws + WS_CTL + 65536, 0, 16384, stream) != hipSuccess) { fprintf(stderr, "kernel_launch: memset failed\n"); return; }
    Args a{};
    for (int i = 0; i < 21; ++i) a.in[i] = (const float*)d_in[i];
    a.out = (float*)d_out; a.ws = (unsigned char*)d_ws;
#if MK_COOP
    a.ph_lo = 0; a.ph_hi = NPHASE;
    void* kargs[] = {&a};
    hipError_t e = hipLaunchCooperativeKernel((const void*)fwd_mk, dim3(grid), dim3(NWAVES * 64), kargs, LDS_BYTES, stream);
    if (e != hipSuccess) fprintf(stderr, "kernel_launch: cooperative launch failed: %s (grid %d)\n", hipGetErrorString(e), grid);
#else
    for (int p = 0; p < NPHASE; ++p) for (int rep_ = 0; rep_ <= ((REPMASK >> p) & 1); ++rep_) { a.ph_lo = p; a.ph_hi = p + 1; hipLaunchKernelGGL(fwd_mk, dim3(grid), dim3(NWAVES * 64), LDS_BYTES, stream, a); }
#endif
}
```
